# Optimizing an MI355X kernel written in HIP

```python
import math
import jax, jax.numpy as jnp
from jax import lax
import numpy as np

D_MODEL = 1024
BATCH = 8
SEQ = 4096
DEPTH = 2

GRID_W = 64
CTX_LEN = 256
N_EVEN = (DEPTH + 1) // 2
N_ODD = DEPTH // 2
N_MOD = 6
EPS = 1e-6
CONV_WIDTH = 5
RWKV_HEADS = 8
RWKV_HEAD_DIM = 64
RWKV_WIDTH = RWKV_HEADS * RWKV_HEAD_DIM
RWKV_DECAY_RANK = 64
RWKV_A_RANK = 64
RWKV_GATE_RANK = 128
RWKV_GN_EPS = 64e-5
RWKV_PROJ = 3 * RWKV_WIDTH + 2 * RWKV_DECAY_RANK + 2 * RWKV_A_RANK + RWKV_GATE_RANK
HGRN_HEADS = 4
HGRN_DK = 128
HGRN_DV = 128
HGRN_KW = HGRN_HEADS * HGRN_DK
HGRN_VW = HGRN_HEADS * HGRN_DV
HGRN_CHUNK = 32
HGRN_PROJ = HGRN_KW + 2 * HGRN_KW + 2 * HGRN_VW
EVEN_PROJ = RWKV_PROJ + HGRN_PROJ
EVEN_OUT = RWKV_WIDTH + HGRN_VW
SSD_HEADS = 16
SSD_HEAD_DIM = 64
SSD_INNER = SSD_HEADS * SSD_HEAD_DIM
SSD_GROUPS = 2
SSD_STATE = 128
SSD_CHUNK = 64
SSD_CONV_CH = SSD_INNER + 2 * SSD_GROUPS * SSD_STATE
SSD_PROJ = SSD_INNER + SSD_CONV_CH + 2 * SSD_HEADS
MLSTM_HEADS = 4
MLSTM_DQK = 128
MLSTM_DV = 256
MLSTM_QK_W = MLSTM_HEADS * MLSTM_DQK
MLSTM_V_W = MLSTM_HEADS * MLSTM_DV
MLSTM_CHUNK = 64
MLSTM_M_INIT = -1e30
MLSTM_PROJ = 2 * MLSTM_QK_W + 2 * MLSTM_V_W + 4 * MLSTM_HEADS
ODD_PROJ = SSD_PROJ + MLSTM_PROJ
ODD_OUT = SSD_INNER + MLSTM_V_W
N_EXPERTS = 32
TOP_K = 4
D_FF_EXPERT = 1024
SWIGLU_LIMIT = 7.0
SWIGLU_ALPHA = 1.702
MOE_BLOCK = 256

kernel_name = 'bidir_hybrid_recurrent_moe_dit'

F32 = jnp.float32


def _split(t, sizes):
    return jnp.split(t, np.cumsum(sizes)[:-1].tolist(), axis=-1)


def rms_norm(x, gain):
    xf = x.astype(F32)
    y = xf * lax.rsqrt(jnp.mean(xf * xf, axis=-1, keepdims=True) + EPS)
    return (y * gain.astype(F32)).astype(x.dtype)


def head_layernorm(o, w, b, eps):
    mu = jnp.mean(o, axis=-1, keepdims=True)
    var = jnp.mean(jnp.square(o - mu), axis=-1, keepdims=True)
    return (o - mu) * lax.rsqrt(var + eps) * w + b


def centred_shift(p):
    pp = jnp.pad(p, ((0, 0), (1, 1), (0, 0)))
    return 0.5 * (pp[:, :-2] + pp[:, 2:])


def depthwise_conv_centred(u, w, b):
    ch = u.shape[-1]
    pad = w.shape[0] // 2
    y = lax.conv_general_dilated(u, w[:, None, :].astype(u.dtype), (1,), [(pad, pad)],
                                 dimension_numbers=('NWC', 'WIO', 'NWC'), feature_group_count=ch)
    return y + b


def to_col_major(t, rows):
    b, s, ch = t.shape
    return t.reshape(b, rows, GRID_W, ch).transpose(0, 2, 1, 3).reshape(b, s, ch)


def to_row_major(t, rows):
    b, s, ch = t.shape
    return t.reshape(b, GRID_W, rows, ch).transpose(0, 2, 1, 3).reshape(b, s, ch)


def dir_stack(tc, tl, per_dir):
    if per_dir:
        cf, cb, lf, lb = tc[:, :, 0], tc[:, :, 1], tl[:, :, 0], tl[:, :, 1]
    else:
        cf, cb, lf, lb = tc, tc, tl, tl
    fwd = jnp.concatenate([cf, lf], axis=1)
    bwd = jnp.concatenate([jnp.flip(cb, 1), jnp.flip(lb, 1)], axis=1)
    return jnp.stack([fwd, bwd], axis=0)


def dir_merge(y, lc, need_ctx):
    yl = y[0, :, lc:] + jnp.flip(y[1, :, lc:], 1)
    yc = (y[0, :, :lc] + jnp.flip(y[1, :, :lc], 1)) if need_ctx else None
    return yc, yl


def rwkv7_scan(r, w, k, v, kk, b):
    xs = tuple(jnp.moveaxis(t, 2, 0) for t in (r, w, k, v, kk, b))
    s0 = jnp.zeros(r.shape[:2] + r.shape[3:] + (r.shape[-1],), r.dtype)

    def step(S, inp):
        r_t, w_t, k_t, v_t, kk_t, b_t = inp
        sa = jnp.einsum('zbhvk,zbhk->zbhv', S, kk_t)
        S = S * w_t[..., None, :] - sa[..., :, None] * b_t[..., None, :] + v_t[..., :, None] * k_t[..., None, :]
        return S, jnp.einsum('zbhvk,zbhk->zbhv', S, r_t)

    _, o = lax.scan(step, s0, xs)
    return jnp.moveaxis(o, 0, 2)


def gla_chunked(q, k, v, log_f, chunk):
    z, L, h, dk = q.shape
    dv = v.shape[-1]
    n = L // chunk
    q, k, log_f = (t.reshape(z, n, chunk, h, dk) for t in (q, k, log_f))
    v = v.reshape(z, n, chunk, h, dv)
    b = jnp.cumsum(log_f, axis=2)
    q_in = q * jnp.exp(b)
    k_in = k * jnp.exp(-b)
    lower = jnp.tril(jnp.ones((chunk, chunk), bool))[:, :, None]
    A = jnp.where(lower, jnp.einsum('zcthd,zcshd->zctsh', q_in, k_in), 0.0)
    o_intra = jnp.einsum('zctsh,zcshv->zcthv', A, v)
    b_last = b[:, :, -1:]
    k_end = k * jnp.exp(b_last - b)
    chunk_decay = jnp.exp(b_last[:, :, 0])

    def step(S, inp):
        q_c, k_c, v_c, d_c = inp
        o_c = jnp.einsum('zthd,zhdv->zthv', q_c, S)
        S = d_c[..., None] * S + jnp.einsum('zshd,zshv->zhdv', k_c, v_c)
        return S, o_c

    s0 = jnp.zeros((z, h, dk, dv), q.dtype)
    _, o_inter = lax.scan(step, s0, tuple(jnp.moveaxis(t, 1, 0) for t in (q_in, k_end, v, chunk_decay)))
    return (o_intra + jnp.moveaxis(o_inter, 0, 1)).reshape(z, L, h, dv)


def ssd_chunked(x, log_a, Bm, Cm, chunk):
    z, L, g, hg, p = x.shape
    nst = Bm.shape[-1]
    n = L // chunk
    x = x.reshape(z, n, chunk, g, hg, p)
    log_a = log_a.reshape(z, n, chunk, g, hg)
    Bm = Bm.reshape(z, n, chunk, g, nst)
    Cm = Cm.reshape(z, n, chunk, g, nst)
    a_cum = jnp.cumsum(log_a, axis=2)
    lower = jnp.tril(jnp.ones((chunk, chunk), bool))[:, :, None, None]
    seg = a_cum[:, :, :, None] - a_cum[:, :, None, :]
    decay = jnp.exp(jnp.where(lower, seg, -jnp.inf))
    cb = jnp.einsum('zctgn,zcsgn->zctsg', Cm, Bm)
    y_intra = jnp.einsum('zctsg,zctsgh,zcsghp->zctghp', cb, decay, x)
    decay_end = jnp.exp(a_cum[:, :, -1:] - a_cum)
    decay_in = jnp.exp(a_cum)
    chunk_decay = jnp.exp(a_cum[:, :, -1])

    def step(hs, inp):
        c_c, b_c, x_c, din, dend, dch = inp
        y_c = jnp.einsum('ztgn,zghpn,ztgh->ztghp', c_c, hs, din)
        hs = dch[..., None, None] * hs + jnp.einsum('zsgn,zsgh,zsghp->zghpn', b_c, dend, x_c)
        return hs, y_c

    h0 = jnp.zeros((z, g, hg, p, nst), x.dtype)
    _, y_inter = lax.scan(step, h0, tuple(jnp.moveaxis(t, 1, 0) for t in (Cm, Bm, x, decay_in, decay_end, chunk_decay)))
    return (y_intra + jnp.moveaxis(y_inter, 0, 1)).reshape(z, L, g, hg, p)


def mlstm_chunked(q, k, v, log_i, log_f, chunk):
    z, L, h, dk = q.shape
    dv = v.shape[-1]
    n = L // chunk
    q = q.reshape(z, n, chunk, h, dk)
    k = k.reshape(z, n, chunk, h, dk)
    v = v.reshape(z, n, chunk, h, dv)
    log_i = log_i.reshape(z, n, chunk, h)
    F = jnp.cumsum(log_f.reshape(z, n, chunk, h), axis=2)
    F_last = F[:, :, -1]
    logw_end = F_last[:, :, None] - F + log_i
    m_end = jnp.max(logw_end, axis=2)
    w_end = jnp.exp(logw_end - m_end[:, :, None])
    lower = jnp.tril(jnp.ones((chunk, chunk), bool))[:, :, None]

    def step(carry, inp):
        Cs, ns, m = carry
        q_c, k_c, v_c, F_c, li_c, Fl_c, me_c, we_c = inp
        logw = jnp.where(lower, F_c[:, :, None] - F_c[:, None, :] + li_c[:, None, :], -jnp.inf)
        m_t = jnp.maximum(jnp.max(logw, axis=2), F_c + m[:, None])
        w_inter = jnp.exp(F_c + m[:, None] - m_t)
        scores = jnp.einsum('zthd,zshd->ztsh', q_c, k_c) * jnp.exp(logw - m_t[:, :, None])
        num = jnp.einsum('ztsh,zshv->zthv', scores, v_c) + w_inter[..., None] * jnp.einsum('zthd,zhdv->zthv', q_c, Cs)
        den = jnp.sum(scores, axis=2) + w_inter * jnp.einsum('zthd,zhd->zth', q_c, ns)
        h_c = num / jnp.maximum(jnp.abs(den), jnp.exp(-m_t))[..., None]
        m_new = jnp.maximum(Fl_c + m, me_c)
        s_old = jnp.exp(Fl_c + m - m_new)
        s_loc = jnp.exp(me_c - m_new)
        Cs = s_old[..., None, None] * Cs + s_loc[..., None, None] * jnp.einsum('zsh,zshd,zshv->zhdv', we_c, k_c, v_c)
        ns = s_old[..., None] * ns + s_loc[..., None] * jnp.einsum('zsh,zshd->zhd', we_c, k_c)
        return (Cs, ns, m_new), h_c

    init = (jnp.zeros((z, h, dk, dv), q.dtype), jnp.zeros((z, h, dk), q.dtype), jnp.full((z, h), MLSTM_M_INIT, q.dtype))
    _, hs = lax.scan(step, init, tuple(jnp.moveaxis(t, 1, 0) for t in (q, k, v, F, log_i, F_last, m_end, w_end)))
    return jnp.moveaxis(hs, 0, 1).reshape(z, L, h, dv)


def rwkv7_group(pc, pl, mu, w0, w2, a0, a2, g2, k_k, k_a, r_k, ln_w, ln_b, need_ctx):
    H, N = RWKV_HEADS, RWKV_HEAD_DIM
    kk_gain = k_k.astype(F32).reshape(H, N)
    ka_gain = k_a.astype(F32).reshape(H, N)

    def prep(p):
        bsz, L = p.shape[:2]
        p = p + (centred_shift(p) - p) * mu
        r, k, v, wd, ad, gd = _split(p, [RWKV_WIDTH] * 3 + [2 * RWKV_DECAY_RANK, 2 * RWKV_A_RANK, RWKV_GATE_RANK])
        w_pre = w0 + jnp.einsum('bldr,drc->bldc', jnp.tanh(wd.reshape(bsz, L, 2, RWKV_DECAY_RANK)), w2)
        decay = jnp.exp(-jnp.exp(-jax.nn.softplus(-w_pre.astype(F32)) - 0.5)).reshape(bsz, L, 2, H, N)
        a = jax.nn.sigmoid((a0 + jnp.einsum('bldr,drc->bldc', ad.reshape(bsz, L, 2, RWKV_A_RANK), a2)).astype(F32))
        a = a.reshape(bsz, L, 2, H, N)
        g = jax.nn.sigmoid(gd) @ g2
        r, k, v = (t.astype(F32).reshape(bsz, L, H, N) for t in (r, k, v))
        kk = k * kk_gain
        kk = kk * lax.rsqrt(jnp.sum(kk * kk, axis=-1, keepdims=True) + 1e-12)
        k_mod = k[:, :, None] * (1.0 + (a - 1.0) * ka_gain)
        return r, v, kk, decay, k_mod, kk[:, :, None] * a, g

    rc, vc, kkc, dc, kmc, bc, gc = prep(pc)
    rl, vl, kkl, dl, kml, bl, gl = prep(pl)
    o = rwkv7_scan(dir_stack(rc, rl, False), dir_stack(dc, dl, True), dir_stack(kmc, kml, True),
                   dir_stack(vc, vl, False), dir_stack(kkc, kkl, False), dir_stack(bc, bl, True))
    oc, ol = dir_merge(o, pc.shape[1], need_ctx)

    def finish(o, r, v, k_mod, g):
        o = head_layernorm(o, ln_w.astype(F32).reshape(H, N), ln_b.astype(F32).reshape(H, N), RWKV_GN_EPS)
        bonus = jnp.sum(r[:, :, None] * k_mod * r_k.astype(F32).reshape(H, N), axis=(2, 4))
        o = (o + bonus[..., None] * v).reshape(o.shape[0], o.shape[1], RWKV_WIDTH)
        return (o * g.astype(F32)).astype(g.dtype)

    yl = finish(ol, rl, vl, kml, gl)
    yc = finish(oc, rc, vc, kmc, gc) if need_ctx else None
    return yc, yl


def hgrn2_group(pc, pl, lb, norm_w, need_ctx):
    H, DK, DV = HGRN_HEADS, HGRN_DK, HGRN_DV
    lb = lb.astype(F32)

    def prep(p):
        bsz, L = p.shape[:2]
        q, f, i, g = _split(p, [HGRN_KW, 2 * HGRN_KW, HGRN_VW, HGRN_VW])
        q = (jax.nn.silu(q.astype(F32)) * DK ** -0.5).reshape(bsz, L, H, DK)
        f = f.astype(F32).reshape(bsz, L, 2, HGRN_KW)
        log_f = jnp.log(lb + (1.0 - lb) * jax.nn.sigmoid(f)).reshape(bsz, L, 2, H, DK)
        k = ((1.0 - lb) * jax.nn.sigmoid(-f)).reshape(bsz, L, 2, H, DK)
        return q, k, log_f, i.astype(F32).reshape(bsz, L, H, DV), g

    qc, kc, lfc, vc, gc = prep(pc)
    ql, kl, lfl, vl, gl = prep(pl)
    bsz, lc = pl.shape[0], pc.shape[1]
    L = lc + pl.shape[1]
    q = dir_stack(qc, ql, False).reshape(2 * bsz, L, H, DK)
    k = dir_stack(kc, kl, True).reshape(2 * bsz, L, H, DK)
    log_f = dir_stack(lfc, lfl, True).reshape(2 * bsz, L, H, DK)
    v = dir_stack(vc, vl, False).reshape(2 * bsz, L, H, DV)
    o = gla_chunked(q, k, v, log_f, HGRN_CHUNK).reshape(2, bsz, L, H, DV)
    oc, ol = dir_merge(o, lc, need_ctx)

    def finish(o, g):
        o = rms_norm(o, norm_w.reshape(H, DV)).reshape(o.shape[0], o.shape[1], HGRN_VW)
        return (o * jax.nn.silu(g.astype(F32))).astype(g.dtype)

    yl = finish(ol, gl)
    yc = finish(oc, gc) if need_ctx else None
    return yc, yl


def ssd_group(pc, pl, conv_w, conv_b, dt_bias, a_log, d_skip, norm_w, need_ctx):
    H, P, G, N = SSD_HEADS, SSD_HEAD_DIM, SSD_GROUPS, SSD_STATE
    hg = H // G

    def prep(p):
        bsz, L = p.shape[:2]
        zg, xbc, dt = _split(p, [SSD_INNER, SSD_CONV_CH, 2 * H])
        xbc = jax.nn.silu(depthwise_conv_centred(xbc, conv_w, conv_b))
        x, Bm, Cm = _split(xbc, [SSD_INNER, G * N, G * N])
        dt = jax.nn.softplus((dt.reshape(bsz, L, 2, H) + dt_bias).astype(F32))
        log_a = dt * -jnp.exp(a_log.astype(F32))
        x = x.astype(F32).reshape(bsz, L, H, P)
        x_dt = x[:, :, None] * dt[..., None]
        return zg, x, x_dt, log_a, Bm.astype(F32).reshape(bsz, L, G, N), Cm.astype(F32).reshape(bsz, L, G, N)

    zc, xc, xdc, lac, Bc, Cc = prep(pc)
    zl, xl, xdl, lal, Bl, Cl = prep(pl)
    bsz, lc = pl.shape[0], pc.shape[1]
    L = lc + pl.shape[1]
    y = ssd_chunked(dir_stack(xdc, xdl, True).reshape(2 * bsz, L, G, hg, P),
                    dir_stack(lac, lal, True).reshape(2 * bsz, L, G, hg),
                    dir_stack(Bc, Bl, False).reshape(2 * bsz, L, G, N),
                    dir_stack(Cc, Cl, False).reshape(2 * bsz, L, G, N), SSD_CHUNK)
    yc, yl = dir_merge(y.reshape(2, bsz, L, H, P), lc, need_ctx)

    def finish(y, x, zg):
        b_, l_ = y.shape[:2]
        y = (y + d_skip.astype(F32)[:, None] * x).reshape(b_, l_, SSD_INNER) * jax.nn.silu(zg.astype(F32))
        y = rms_norm(y.reshape(b_, l_, G, SSD_INNER // G), norm_w.reshape(G, SSD_INNER // G))
        return y.reshape(b_, l_, SSD_INNER).astype(zg.dtype)

    out_l = finish(yl, xl, zl)
    out_c = finish(yc, xc, zc) if need_ctx else None
    return out_c, out_l


def mlstm_group(pc, pl, conv_w, conv_b, i_bias, f_bias, norm_w, need_ctx):
    H, DK, DV = MLSTM_HEADS, MLSTM_DQK, MLSTM_DV

    def prep(p):
        bsz, L = p.shape[:2]
        qk, v, og, ig, fg = _split(p, [2 * MLSTM_QK_W, MLSTM_V_W, MLSTM_V_W, 2 * H, 2 * H])
        qk = jax.nn.silu(depthwise_conv_centred(qk, conv_w, conv_b)).astype(F32)
        q, k = jnp.split(qk, 2, axis=-1)
        q = q.reshape(bsz, L, H, DK)
        k = k.reshape(bsz, L, H, DK) * DK ** -0.5
        v = v.astype(F32).reshape(bsz, L, H, DV)
        log_i = ig.astype(F32).reshape(bsz, L, 2, H) + i_bias.astype(F32)
        log_f = jax.nn.log_sigmoid(fg.astype(F32).reshape(bsz, L, 2, H) + f_bias.astype(F32))
        return q, k, v, og, log_i, log_f

    qc, kc, vc, oc_g, lic, lfc = prep(pc)
    ql, kl, vl, ol_g, lil, lfl = prep(pl)
    bsz, lc = pl.shape[0], pc.shape[1]
    L = lc + pl.shape[1]
    h = mlstm_chunked(dir_stack(qc, ql, False).reshape(2 * bsz, L, H, DK),
                      dir_stack(kc, kl, False).reshape(2 * bsz, L, H, DK),
                      dir_stack(vc, vl, False).reshape(2 * bsz, L, H, DV),
                      dir_stack(lic, lil, True).reshape(2 * bsz, L, H),
                      dir_stack(lfc, lfl, True).reshape(2 * bsz, L, H), MLSTM_CHUNK)
    hc, hl = dir_merge(h.reshape(2, bsz, L, H, DV), lc, need_ctx)

    def finish(h, og):
        h = rms_norm(h, norm_w.reshape(H, DV)).reshape(h.shape[0], h.shape[1], MLSTM_V_W)
        return (h * jax.nn.sigmoid(og.astype(F32))).astype(og.dtype)

    yl = finish(hl, ol_g)
    yc = finish(hc, oc_g) if need_ctx else None
    return yc, yl


def moe_ffn(h, router_w, router_b, w_gate, b_gate, w_up, b_up, w_down, b_down):
    T, D = h.shape
    logits = (h @ router_w).astype(F32) + router_b.astype(F32)
    top_val, top_idx = lax.top_k(logits, TOP_K)
    probs = jax.nn.softmax(top_val, axis=-1)
    TK = T * TOP_K
    flat_e = top_idx.reshape(-1)
    order = jnp.argsort(flat_e)
    sorted_e = flat_e[order]
    sorted_tok = order // TOP_K
    sorted_w = probs.reshape(-1)[order].astype(h.dtype)
    counts = jnp.bincount(flat_e, length=N_EXPERTS)
    padded = (counts + MOE_BLOCK - 1) // MOE_BLOCK * MOE_BLOCK
    start = jnp.cumsum(counts) - counts
    ends = jnp.cumsum(padded)
    pstart = ends - padded
    dest = pstart[sorted_e] + jnp.arange(TK) - start[sorted_e]
    n_blocks = -(-TK // MOE_BLOCK) + N_EXPERTS
    block_expert = jnp.clip(jnp.searchsorted(ends, jnp.arange(n_blocks) * MOE_BLOCK, side='right'), 0, N_EXPERTS - 1)
    x_buf = jnp.zeros((n_blocks * MOE_BLOCK, D), h.dtype).at[dest].set(h[sorted_tok])

    def expert_block(args):
        xb, e = args
        g = xb @ w_gate[e] + b_gate[e]
        u = xb @ w_up[e] + b_up[e]
        g = jnp.minimum(g, SWIGLU_LIMIT)
        u = jnp.clip(u, -SWIGLU_LIMIT, SWIGLU_LIMIT)
        return (g * jax.nn.sigmoid(SWIGLU_ALPHA * g) * (u + 1.0)) @ w_down[e] + b_down[e]

    y_blocks = lax.map(expert_block, (x_buf.reshape(n_blocks, MOE_BLOCK, D), block_expert))
    y_sorted = y_blocks.reshape(n_blocks * MOE_BLOCK, D)[dest]
    return jnp.zeros((T, D), h.dtype).at[sorted_tok].add(y_sorted * sorted_w[:, None])


def setup_inputs(seed: int = 0) -> dict:
    key = jax.random.key(seed)
    keys = iter(jax.random.split(key, 64))
    D = D_MODEL

    def normal(shape, scale):
        return jax.random.normal(next(keys), shape, F32) * scale

    def gain(shape):
        return 1.0 + normal(shape, 0.05)

    def uniform(shape, lo, hi):
        return jax.random.uniform(next(keys), shape, F32, lo, hi)

    dt = jnp.exp(uniform((N_ODD, 2, SSD_HEADS), math.log(1e-3), math.log(1e-1)))
    return {
        'x': normal((BATCH, SEQ, D), 1.0),
        'c': normal((BATCH, D), 1.0),
        'ctx': normal((BATCH, CTX_LEN, D), 1.0),
        'c_ctx': normal((D,), 1.0),
        'ada_w': normal((DEPTH, D, N_MOD * D), 0.5 * D ** -0.5),
        'ada_b': normal((DEPTH, N_MOD * D), 0.02),
        'norm1_w': gain((DEPTH, D)),
        'norm2_w': gain((DEPTH, D)),
        'even_w_in': normal((N_EVEN, D, EVEN_PROJ), D ** -0.5),
        'even_w_out': normal((N_EVEN, EVEN_OUT, D), EVEN_OUT ** -0.5),
        'rwkv_mu': uniform((N_EVEN, RWKV_PROJ), 0.0, 1.0),
        'rwkv_w0': uniform((N_EVEN, 2, RWKV_WIDTH), -6.0, 0.0),
        'rwkv_w2': normal((N_EVEN, 2, RWKV_DECAY_RANK, RWKV_WIDTH), 0.5 * RWKV_DECAY_RANK ** -0.5),
        'rwkv_a0': normal((N_EVEN, 2, RWKV_WIDTH), 0.1),
        'rwkv_a2': normal((N_EVEN, 2, RWKV_A_RANK, RWKV_WIDTH), 0.5 * RWKV_A_RANK ** -0.5),
        'rwkv_g2': normal((N_EVEN, RWKV_GATE_RANK, RWKV_WIDTH), RWKV_GATE_RANK ** -0.5),
        'rwkv_k_k': 0.85 + normal((N_EVEN, RWKV_WIDTH), 0.05),
        'rwkv_k_a': gain((N_EVEN, RWKV_WIDTH)),
        'rwkv_r_k': normal((N_EVEN, RWKV_WIDTH), 0.1),
        'rwkv_ln_w': gain((N_EVEN, RWKV_WIDTH)),
        'rwkv_ln_b': normal((N_EVEN, RWKV_WIDTH), 0.02),
        'hgrn_lower_bounds': normal((DEPTH + 1, HGRN_KW), 0.1),
        'hgrn_norm_w': gain((N_EVEN, HGRN_VW)),
        'odd_w_in': normal((N_ODD, D, ODD_PROJ), D ** -0.5),
        'odd_w_out': normal((N_ODD, ODD_OUT, D), ODD_OUT ** -0.5),
        'ssd_conv_w': normal((N_ODD, CONV_WIDTH, SSD_CONV_CH), CONV_WIDTH ** -0.5),
        'ssd_conv_b': normal((N_ODD, SSD_CONV_CH), 0.02),
        'ssd_dt_bias': dt + jnp.log(-jnp.expm1(-dt)),
        'ssd_a_log': jnp.log(uniform((N_ODD, 2, SSD_HEADS), 1.0, 16.0)),
        'ssd_d': gain((N_ODD, SSD_HEADS)),
        'ssd_norm_w': gain((N_ODD, SSD_INNER)),
        'mlstm_conv_w': normal((N_ODD, CONV_WIDTH, 2 * MLSTM_QK_W), CONV_WIDTH ** -0.5),
        'mlstm_conv_b': normal((N_ODD, 2 * MLSTM_QK_W), 0.02),
        'mlstm_i_bias': normal((N_ODD, 2, MLSTM_HEADS), 0.1),
        'mlstm_f_bias': uniform((N_ODD, 2, MLSTM_HEADS), 3.0, 6.0),
        'mlstm_norm_w': gain((N_ODD, MLSTM_V_W)),
        'router_w': normal((DEPTH, D, N_EXPERTS), D ** -0.5),
        'router_b': normal((DEPTH, N_EXPERTS), 0.01),
        'exp_w_gate': normal((DEPTH, N_EXPERTS, D, D_FF_EXPERT), D ** -0.5),
        'exp_b_gate': normal((DEPTH, N_EXPERTS, D_FF_EXPERT), 0.02),
        'exp_w_up': normal((DEPTH, N_EXPERTS, D, D_FF_EXPERT), D ** -0.5),
        'exp_b_up': normal((DEPTH, N_EXPERTS, D_FF_EXPERT), 0.02),
        'exp_w_down': normal((DEPTH, N_EXPERTS, D_FF_EXPERT, D), D_FF_EXPERT ** -0.5),
        'exp_b_down': normal((DEPTH, N_EXPERTS, D), 0.02),
        'final_norm_w': gain((D,)),
    }


def reference(x, c, ctx, c_ctx, ada_w, ada_b, norm1_w, norm2_w, even_w_in, even_w_out, rwkv_mu, rwkv_w0,
              rwkv_w2, rwkv_a0, rwkv_a2, rwkv_g2, rwkv_k_k, rwkv_k_a, rwkv_r_k, rwkv_ln_w, rwkv_ln_b,
              hgrn_lower_bounds, hgrn_norm_w, odd_w_in, odd_w_out, ssd_conv_w, ssd_conv_b, ssd_dt_bias,
              ssd_a_log, ssd_d, ssd_norm_w, mlstm_conv_w, mlstm_conv_b, mlstm_i_bias, mlstm_f_bias,
              mlstm_norm_w, router_w, router_b, exp_w_gate, exp_b_gate, exp_w_up, exp_b_up, exp_w_down,
              exp_b_down, final_norm_w):
    bsz, seq, _ = x.shape
    rows = seq // GRID_W
    lc = ctx.shape[1]
    lower_bounds = jnp.cumsum(jax.nn.softmax(hgrn_lower_bounds.astype(F32), axis=0), axis=0)
    xl, xc = x, ctx
    for l in range(DEPTH):
        need_ctx = l < DEPTH - 1
        mod = (jax.nn.silu(c) @ ada_w[l] + ada_b[l]).reshape(bsz, N_MOD, 1, D_MODEL)
        mod_c = (jax.nn.silu(c_ctx) @ ada_w[l] + ada_b[l]).reshape(N_MOD, D_MODEL)
        hl = rms_norm(xl, norm1_w[l]) * (1.0 + mod[:, 1]) + mod[:, 0]
        hc = rms_norm(xc, norm1_w[l]) * (1.0 + mod_c[1]) + mod_c[0]
        if l % 2 == 0:
            e = l // 2
            pc_r, pc_h = _split(hc @ even_w_in[e], [RWKV_PROJ, HGRN_PROJ])
            pl_r, pl_h = _split(hl @ even_w_in[e], [RWKV_PROJ, HGRN_PROJ])
            rc, rl = rwkv7_group(pc_r, pl_r, rwkv_mu[e], rwkv_w0[e], rwkv_w2[e], rwkv_a0[e], rwkv_a2[e],
                                 rwkv_g2[e], rwkv_k_k[e], rwkv_k_a[e], rwkv_r_k[e], rwkv_ln_w[e], rwkv_ln_b[e], need_ctx)
            gc_, gl_ = hgrn2_group(pc_h, pl_h, lower_bounds[l], hgrn_norm_w[e], need_ctx)
            yl = jnp.concatenate([rl, gl_], axis=-1) @ even_w_out[e]
            yc = (jnp.concatenate([rc, gc_], axis=-1) @ even_w_out[e]) if need_ctx else None
        else:
            o = l // 2
            hl_cm = to_col_major(hl, rows)
            pc_s, pc_m = _split(hc @ odd_w_in[o], [SSD_PROJ, MLSTM_PROJ])
            pl_s, pl_m = _split(hl_cm @ odd_w_in[o], [SSD_PROJ, MLSTM_PROJ])
            sc, sl = ssd_group(pc_s, pl_s, ssd_conv_w[o], ssd_conv_b[o], ssd_dt_bias[o], ssd_a_log[o], ssd_d[o],
                               ssd_norm_w[o], need_ctx)
            mc, ml = mlstm_group(pc_m, pl_m, mlstm_conv_w[o], mlstm_conv_b[o], mlstm_i_bias[o], mlstm_f_bias[o],
                                 mlstm_norm_w[o], need_ctx)
            yl = to_row_major(jnp.concatenate([sl, ml], axis=-1) @ odd_w_out[o], rows)
            yc = (jnp.concatenate([sc, mc], axis=-1) @ odd_w_out[o]) if need_ctx else None
        xl = xl + mod[:, 2] * yl
        hl = rms_norm(xl, norm2_w[l]) * (1.0 + mod[:, 4]) + mod[:, 3]
        moe_args = (router_w[l], router_b[l], exp_w_gate[l], exp_b_gate[l], exp_w_up[l], exp_b_up[l],
                    exp_w_down[l], exp_b_down[l])
        if need_ctx:
            xc = xc + mod_c[2] * yc
            hc = rms_norm(xc, norm2_w[l]) * (1.0 + mod_c[4]) + mod_c[3]
            tokens = jnp.concatenate([hc.reshape(-1, D_MODEL), hl.reshape(-1, D_MODEL)], axis=0)
            f_out = moe_ffn(tokens, *moe_args)
            xc = xc + mod_c[5] * f_out[:bsz * lc].reshape(bsz, lc, D_MODEL)
            xl = xl + mod[:, 5] * f_out[bsz * lc:].reshape(bsz, seq, D_MODEL)
        else:
            f_out = moe_ffn(hl.reshape(-1, D_MODEL), *moe_args)
            xl = xl + mod[:, 5] * f_out.reshape(bsz, seq, D_MODEL)
    return rms_norm(xl, final_norm_w)
```

```cpp
#ifdef EMU
#include "hipemu.h"
#else
#include <hip/hip_runtime.h>
#include <cstdio>
#include <cstdint>
#endif

#ifdef SMALL_CFG
constexpr int D_MODEL = 256, BATCH = 2, SEQ = 256, GRID_W = 16, CTX_LEN = 128;
constexpr int RWKV_HEADS = 2, HGRN_HEADS = 1, SSD_HEADS = 4, MLSTM_HEADS = 1, N_EXPERTS = 8, D_FF = 256;
#else
constexpr int D_MODEL = 1024, BATCH = 8, SEQ = 4096, GRID_W = 64, CTX_LEN = 256;
constexpr int RWKV_HEADS = 8, HGRN_HEADS = 4, SSD_HEADS = 16, MLSTM_HEADS = 4, N_EXPERTS = 32, D_FF = 1024;
#endif
constexpr int DEPTH = 2, N_MOD = 6;
constexpr float EPS = 1e-6f;
constexpr int GRID_ROWS = SEQ / GRID_W;
constexpr int LSEQ = CTX_LEN + SEQ;
constexpr int T_CTX = BATCH * CTX_LEN, T_LAT = BATCH * SEQ, T_ALL = BATCH * LSEQ;
constexpr int RWKV_N = 64, RWKV_W = RWKV_HEADS * RWKV_N, RWKV_DR = 64, RWKV_AR = 64, RWKV_GR = 128;
constexpr float RWKV_GN_EPS = 64e-5f;
constexpr int RWKV_PROJ = 3 * RWKV_W + 2 * RWKV_DR + 2 * RWKV_AR + RWKV_GR;
constexpr int HG_DK = 128, HG_DV = 128, HG_KW = HGRN_HEADS * HG_DK, HG_VW = HGRN_HEADS * HG_DV, HG_CH = 32;
constexpr int HGRN_PROJ = HG_KW + 2 * HG_KW + 2 * HG_VW;
constexpr int EVEN_PROJ = RWKV_PROJ + HGRN_PROJ, EVEN_OUT = RWKV_W + HG_VW;
constexpr int SSD_P = 64, SSD_INNER = SSD_HEADS * SSD_P, SSD_G = 2, SSD_N = 128, SSD_CH = 64, SSD_HG = SSD_HEADS / SSD_G;
constexpr int SSD_CONV_CH = SSD_INNER + 2 * SSD_G * SSD_N, SSD_PROJ = SSD_INNER + SSD_CONV_CH + 2 * SSD_HEADS;
constexpr int ML_DK = 128, ML_DV = 256, ML_QKW = MLSTM_HEADS * ML_DK, ML_VW = MLSTM_HEADS * ML_DV, ML_CH = 64;
constexpr float ML_M_INIT = -1e30f;
constexpr int MLSTM_PROJ = 2 * ML_QKW + 2 * ML_VW + 4 * MLSTM_HEADS;
constexpr int ODD_PROJ = SSD_PROJ + MLSTM_PROJ, ODD_OUT = SSD_INNER + ML_VW;
constexpr int TOP_K = 4;
constexpr float SWIGLU_LIMIT = 7.0f, SWIGLU_ALPHA = 1.702f;

constexpr int NT = 512;
constexpr int BM = 256, BN = 128, BK = 32;
constexpr int rup(int a, int b) { return (a + b - 1) / b * b; }
constexpr int EVEN_PROJ_PAD = rup(EVEN_PROJ, BN), ODD_PROJ_PAD = rup(ODD_PROJ, BN);
constexpr int PROJ_PAD_MAX = EVEN_PROJ_PAD > ODD_PROJ_PAD ? EVEN_PROJ_PAD : ODD_PROJ_PAD;
constexpr int AUX0_W = 8 * RWKV_W;
constexpr int XC_W = SSD_CONV_CH + 2 * ML_QKW;
constexpr int OW0 = EVEN_OUT, OW1 = ODD_OUT, OW_MAX = OW0 > OW1 ? OW0 : OW1;
constexpr int T_MOE0 = T_ALL, T_MOE1 = T_LAT;
constexpr int MOE_ROWS_MAX = T_MOE0 * TOP_K + N_EXPERTS * BM;
constexpr int MAX_MTILES = MOE_ROWS_MAX / BM;
static_assert(T_ALL % BM == 0 && T_LAT % BM == 0, "row tiles");
static_assert(CTX_LEN % 64 == 0 && SEQ % 64 == 0, "chunk alignment");
static_assert(D_MODEL % BN == 0 && D_FF % 64 == 0 && D_MODEL % BK == 0 && D_FF % BK == 0, "tiles");

typedef unsigned short bf16_t;
#ifndef EMU
typedef short bf16x8 __attribute__((ext_vector_type(8)));
typedef float f32x4 __attribute__((ext_vector_type(4)));
#define mfma16(a, b, c) __builtin_amdgcn_mfma_f32_16x16x32_bf16(a, b, c, 0, 0, 0)
#define SMEM_DECL extern __shared__ __attribute__((aligned(16))) unsigned char smem[]
#else
#define mfma16(a, b, c) emu_mfma_16x16x32_bf16(a, b, c)
#define SMEM_DECL unsigned char* smem = emu_cur->blk->smem
#endif

constexpr size_t al256(size_t x) { return (x + 255) / 256 * 256; }
constexpr size_t WS_BAR = 0;
constexpr size_t WS_CNT = 16384;
constexpr size_t WS_MOD = WS_CNT + 4096;
constexpr size_t WS_LB = al256(WS_MOD + sizeof(float) * 2 * (BATCH + 1) * N_MOD * D_MODEL);
constexpr size_t WS_WIN0 = al256(WS_LB + sizeof(float) * HG_KW);
constexpr size_t WS_WIN1 = al256(WS_WIN0 + 2ull * EVEN_PROJ_PAD * D_MODEL);
constexpr size_t WS_WOUT0 = al256(WS_WIN1 + 2ull * ODD_PROJ_PAD * D_MODEL);
constexpr size_t WS_WOUT1 = al256(WS_WOUT0 + 2ull * D_MODEL * EVEN_OUT);
constexpr size_t WS_XC = al256(WS_WOUT1 + 2ull * D_MODEL * ODD_OUT);
constexpr size_t WS_TOPE = al256(WS_XC + 4ull * T_CTX * D_MODEL);
constexpr size_t WS_TOPP = al256(WS_TOPE + 4ull * T_MOE0 * TOP_K);
constexpr size_t WS_RANK = al256(WS_TOPP + 4ull * T_MOE0 * TOP_K);
constexpr size_t WS_POSOF = al256(WS_RANK + 4ull * T_MOE0 * TOP_K);
constexpr size_t WS_TOKOF = al256(WS_POSOF + 4ull * T_MOE0 * TOP_K);
constexpr size_t WS_H = al256(WS_TOKOF + 4ull * MOE_ROWS_MAX);
constexpr size_t WS_BIG = al256(WS_H + 2ull * T_ALL * D_MODEL);
constexpr size_t WS_P = WS_BIG;
constexpr size_t WS_AUX0 = al256(WS_P + 2ull * T_ALL * EVEN_PROJ_PAD);
constexpr size_t WS_O0 = al256(WS_AUX0 + 2ull * T_ALL * AUX0_W);
constexpr size_t WS_END0 = al256(WS_O0 + 2ull * 2 * T_ALL * OW0);
constexpr size_t WS_AUX1 = al256(WS_P + 2ull * T_ALL * ODD_PROJ_PAD);
constexpr size_t WS_O1 = al256(WS_AUX1 + 2ull * T_ALL * XC_W);
constexpr size_t WS_END1 = al256(WS_O1 + 2ull * 2 * T_ALL * OW1);
constexpr size_t WS_END_MIX = WS_END0 > WS_END1 ? WS_END0 : WS_END1;
constexpr size_t WS_WGU = WS_BIG;
constexpr size_t WS_WDN = al256(WS_WGU + 2ull * N_EXPERTS * 2 * D_FF * D_MODEL);
constexpr size_t WS_H1 = al256(WS_WDN + 2ull * N_EXPERTS * D_MODEL * D_FF);
constexpr size_t WS_Y = al256(WS_H1 + 2ull * MOE_ROWS_MAX * D_FF);
constexpr size_t WS_END_MOE = al256(WS_Y + 2ull * MOE_ROWS_MAX * D_MODEL);
constexpr size_t WS_TOTAL = WS_END_MIX > WS_END_MOE ? WS_END_MIX : WS_END_MOE;
#ifndef SMALL_CFG
static_assert(WS_TOTAL <= (1ull << 30), "workspace exceeds 1 GiB");
#endif

struct Params {
    const float *x, *c, *ctx, *c_ctx, *ada_w, *ada_b, *norm1_w, *norm2_w, *even_w_in, *even_w_out, *rwkv_mu, *rwkv_w0,
        *rwkv_w2, *rwkv_a0, *rwkv_a2, *rwkv_g2, *rwkv_k_k, *rwkv_k_a, *rwkv_r_k, *rwkv_ln_w, *rwkv_ln_b,
        *hgrn_lower_bounds, *hgrn_norm_w, *odd_w_in, *odd_w_out, *ssd_conv_w, *ssd_conv_b, *ssd_dt_bias,
        *ssd_a_log, *ssd_d, *ssd_norm_w, *mlstm_conv_w, *mlstm_conv_b, *mlstm_i_bias, *mlstm_f_bias,
        *mlstm_norm_w, *router_w, *router_b, *exp_w_gate, *exp_b_gate, *exp_w_up, *exp_b_up, *exp_w_down,
        *exp_b_down, *final_norm_w;
    float* out;
    unsigned char* ws;
};

__device__ __forceinline__ bf16_t f2bf(float f) {
    unsigned u = __builtin_bit_cast(unsigned, f);
    u += 0x7FFFu + ((u >> 16) & 1u);
    return (bf16_t)(u >> 16);
}
__device__ __forceinline__ float bf2f(bf16_t h) { return __builtin_bit_cast(float, ((unsigned)h) << 16); }
__device__ __forceinline__ unsigned pack2(float a, float b) { return (unsigned)f2bf(a) | ((unsigned)f2bf(b) << 16); }
__device__ __forceinline__ float lo2f(unsigned u) { return __builtin_bit_cast(float, u << 16); }
__device__ __forceinline__ float hi2f(unsigned u) { return __builtin_bit_cast(float, u & 0xFFFF0000u); }
__device__ __forceinline__ float sigmoidf_(float x) { return 1.0f / (1.0f + expf(-x)); }
__device__ __forceinline__ float siluf_(float x) { return x / (1.0f + expf(-x)); }
__device__ __forceinline__ float softplusf_(float x) { return x > 20.f ? x : log1pf(expf(x)); }
__device__ __forceinline__ float wave_sum(float v) {
#pragma unroll
    for (int m = 32; m >= 1; m >>= 1) v += __shfl_xor(v, m, 64);
    return v;
}
#ifdef EMU
__device__ __forceinline__ void wave_sync() { int z = 0; (void)emu_wave_exchange(&z, 4); }
#else
__device__ __forceinline__ void wave_sync() { __builtin_amdgcn_fence(__ATOMIC_RELEASE, "wavefront"); __builtin_amdgcn_wave_barrier(); __builtin_amdgcn_fence(__ATOMIC_ACQUIRE, "wavefront"); }
#endif
struct alignas(16) U4 { unsigned x, y, z, w; };
__device__ __forceinline__ U4 ld16(const void* p) { return *reinterpret_cast<const U4*>(p); }
__device__ __forceinline__ void st16(void* p, U4 v) { *reinterpret_cast<U4*>(p) = v; }
struct alignas(16) F4 { float x, y, z, w; };
__device__ __forceinline__ F4 ldf4(const float* p) { return *reinterpret_cast<const F4*>(p); }

template <int LAYER> __device__ __forceinline__ int lat_nat(int j) {
    if (LAYER == 0) return j;
    int w = j / GRID_ROWS, r = j - w * GRID_ROWS;
    return r * GRID_W + w;
}
__device__ __forceinline__ int step_pos(int dir, int j) {
    if (dir == 0) return j;
    return j < CTX_LEN ? CTX_LEN - 1 - j : LSEQ + CTX_LEN - 1 - j;
}

#ifndef EMU
#define XB_TMO      128
#define XB_XCNT(j)  (256  + 64 * (j))
#define XB_XSUB(j)  (1280 + 64 * (j))
#define XB_XGEN(j)  (2304 + 64 * (j))
#define XB_TOP      3328
#define XB_TOPGEN   3392
#define XCD_BAR_WORDS 3456
#define XB_SPIN_CAP (1u << 22)
#define LAS __attribute__((address_space(3)))
__device__ __forceinline__ unsigned xb_ld(unsigned* p)              { return __hip_atomic_load(p, __ATOMIC_RELAXED, __HIP_MEMORY_SCOPE_AGENT); }
__device__ __forceinline__ unsigned xb_add(unsigned* p, unsigned v) { return __hip_atomic_fetch_add(p, v, __ATOMIC_RELAXED, __HIP_MEMORY_SCOPE_AGENT); }
__device__ __forceinline__ unsigned xb_xcc_id() { return (unsigned)__builtin_amdgcn_s_getreg((3 << 11) | 20) & 0xFu; }
#define XB_SPIN(cond, bar) do { unsigned _sp = 0; while (cond) { __builtin_amdgcn_s_sleep(1); \
    if ((++_sp & 255u) == 0u) { if (xb_ld(&(bar)[XB_TMO])) break; if (_sp > XB_SPIN_CAP) { atomicAdd(&(bar)[XB_TMO], 1u); break; } } } } while (0)
struct XcdBarrier { unsigned* bar; unsigned x; volatile LAS unsigned* st; };
__device__ __forceinline__ XcdBarrier xcd_barrier_post(unsigned* bar, volatile LAS unsigned* st) {
    XcdBarrier b; b.bar = bar; b.x = xb_xcc_id(); b.st = st;
    if (threadIdx.x == 0) (void)xb_add(&bar[XB_XCNT(b.x)], 1u);
    return b;
}
__device__ __forceinline__ void xcd_barrier_complete(unsigned* bar, unsigned x, unsigned& nloc, unsigned& nx) {
    const unsigned G = gridDim.x * gridDim.y * gridDim.z;
    unsigned sum, cnt, mine, sp = 0u;
    for (;;) {
        sum = 0u; cnt = 0u; mine = 0u;
#pragma unroll
        for (unsigned j = 0; j < 16; ++j) { const unsigned c = xb_ld(&bar[XB_XCNT(j)]); sum += c; cnt += (c > 0u) ? 1u : 0u; mine = (j == x) ? c : mine; }
        if (sum == G) break;
        __builtin_amdgcn_s_sleep(1);
        if ((++sp & 255u) == 0u) { if (xb_ld(&bar[XB_TMO])) break; if (sp > XB_SPIN_CAP) { atomicAdd(&bar[XB_TMO], 1u); break; } }
    }
    nloc = mine > 0u ? mine : 1u; nx = cnt > 0u ? cnt : 1u;
}
__device__ __forceinline__ void xcd_barrier(const XcdBarrier& b) {
    asm volatile("s_waitcnt vmcnt(0)" ::: "memory");
    __syncthreads();
    if (threadIdx.x == 0) {
        unsigned* bar = b.bar;
        __builtin_amdgcn_s_waitcnt(0);
        unsigned nloc = b.st[0], nx = b.st[1];
        if (nloc == 0u) { xcd_barrier_complete(bar, b.x, nloc, nx); b.st[0] = nloc; b.st[1] = nx; }
        const unsigned old = xb_add(&bar[XB_XSUB(b.x)], 1u);
        const unsigned gen = old / nloc;
        if (old + 1u == (gen + 1u) * nloc) {
            __builtin_amdgcn_fence(__ATOMIC_RELEASE, "agent");
            asm volatile("s_waitcnt vmcnt(0)" ::: "memory");
            const unsigned og = xb_add(&bar[XB_TOP], 1u);
            const unsigned tg = og / nx;
            if (og + 1u == (tg + 1u) * nx) xb_add(&bar[XB_TOPGEN], 1u);
            else XB_SPIN(xb_ld(&bar[XB_TOPGEN]) == tg, bar);
            __builtin_amdgcn_fence(__ATOMIC_ACQUIRE, "agent");
            xb_add(&bar[XB_XGEN(b.x)], 1u);
            asm volatile("s_waitcnt vmcnt(0)" ::: "memory");
        } else {
            XB_SPIN(xb_ld(&bar[XB_XGEN(b.x)]) == gen, bar);
            __builtin_amdgcn_fence(__ATOMIC_ACQUIRE, "agent");
            asm volatile("s_waitcnt vmcnt(0)" ::: "memory");
        }
    }
    __syncthreads();
}
#endif

constexpr int GEMM_SMEM = 2 * (BM * BK + BN * BK) * 2;
__device__ __forceinline__ void gemm_core(const bf16_t* pa0, const bf16_t* pa1, const bf16_t* pb, int K,
                                          unsigned char* smem, f32x4 (&acc)[4][4]) {
    const int tid = threadIdx.x, wid = tid >> 6, lane = tid & 63, wr = wid >> 1, wc = wid & 1, fr = lane & 15, fq = lane >> 4;
    bf16_t* As = reinterpret_cast<bf16_t*>(smem);
    bf16_t* Bs = As + 2 * BM * BK;
    const int wa0 = (tid >> 2) * BK + (tid & 3) * 8, wa1 = wa0 + 128 * BK, wb = wa0;
#pragma unroll
    for (int m = 0; m < 4; ++m)
#pragma unroll
        for (int n = 0; n < 4; ++n) acc[m][n] = f32x4{0.f, 0.f, 0.f, 0.f};
    U4 ra0 = ld16(pa0), ra1 = ld16(pa1), rb = (tid < 512) ? ld16(pb) : U4{};
    st16(As + wa0, ra0); st16(As + wa1, ra1); st16(Bs + wb, rb);
    __syncthreads();
    const int nt = K / BK;
    for (int t = 0; t < nt; ++t) {
        const int cur = t & 1;
        if (t + 1 < nt) { ra0 = ld16(pa0 + (t + 1) * BK); ra1 = ld16(pa1 + (t + 1) * BK); rb = ld16(pb + (t + 1) * BK); }
        const bf16_t* Ac = As + cur * BM * BK; const bf16_t* Bc = Bs + cur * BN * BK;
        bf16x8 af[4], bfr[4];
#pragma unroll
        for (int m = 0; m < 4; ++m) af[m] = *reinterpret_cast<const bf16x8*>(Ac + (wr * 64 + m * 16 + fr) * BK + fq * 8);
#pragma unroll
        for (int n = 0; n < 4; ++n) bfr[n] = *reinterpret_cast<const bf16x8*>(Bc + (wc * 64 + n * 16 + fr) * BK + fq * 8);
#pragma unroll
        for (int m = 0; m < 4; ++m)
#pragma unroll
            for (int n = 0; n < 4; ++n) acc[m][n] = mfma16(af[m], bfr[n], acc[m][n]);
        if (t + 1 < nt) {
            const int nx = cur ^ 1;
            st16(As + nx * BM * BK + wa0, ra0); st16(As + nx * BM * BK + wa1, ra1); st16(Bs + nx * BN * BK + wb, rb);
        }
        __syncthreads();
    }
}

template <class RowMap>
__device__ __forceinline__ void cvt_tile(const float* src, int N, int K, int k0, int n0, bf16_t* dst, RowMap dst_row, int n_valid) {
    const int tid = threadIdx.x, n = n0 + (tid & 63), kg = tid >> 6;
    float v[8];
#pragma unroll
    for (int j = 0; j < 8; ++j) v[j] = (n < n_valid) ? src[(size_t)(k0 + kg * 8 + j) * N + n] : 0.f;
    U4 o; o.x = pack2(v[0], v[1]); o.y = pack2(v[2], v[3]); o.z = pack2(v[4], v[5]); o.w = pack2(v[6], v[7]);
    st16(dst + (size_t)dst_row(n) * K + k0 + kg * 8, o);
}
__device__ __forceinline__ int gu_row(int col, int is_up) { return (col >> 6) * 128 + ((col >> 4) & 3) * 32 + is_up * 16 + (col & 15); }

template <int LAYER> __device__ void convert_expert_weights(const Params& p, int unit_begin, int unit_stride) {
    bf16_t* wgu = reinterpret_cast<bf16_t*>(p.ws + WS_WGU); bf16_t* wdn = reinterpret_cast<bf16_t*>(p.ws + WS_WDN);
    constexpr int T1 = (D_MODEL / 64) * (D_FF / 64);
    constexpr int T2 = (D_FF / 64) * (D_MODEL / 64);
    constexpr int PER_E = 2 * T1 + T2;
    for (int u = unit_begin; u < N_EXPERTS * PER_E; u += unit_stride) {
        const int e = u / PER_E, r = u - e * PER_E;
        if (r < 2 * T1) {
            const int is_up = r / T1, t = r - is_up * T1, kt = t / (D_FF / 64), nt_ = t - kt * (D_FF / 64);
            const float* src = (is_up ? p.exp_w_up : p.exp_w_gate) + ((size_t)LAYER * N_EXPERTS + e) * D_MODEL * D_FF;
            cvt_tile(src, D_FF, D_MODEL, kt * 64, nt_ * 64, wgu + (size_t)e * 2 * D_FF * D_MODEL,
                     [=](int n) { return gu_row(n, is_up); }, D_FF);
        } else {
            const int t = r - 2 * T1, kt = t / (D_MODEL / 64), nt_ = t - kt * (D_MODEL / 64);
            const float* src = p.exp_w_down + ((size_t)LAYER * N_EXPERTS + e) * D_FF * D_MODEL;
            cvt_tile(src, D_MODEL, D_FF, kt * 64, nt_ * 64, wdn + (size_t)e * D_MODEL * D_FF, [](int n) { return n; }, D_MODEL);
        }
    }
}

__device__ void phase_prologue(const Params& p, unsigned char* smem) {
    const int tid = threadIdx.x, bid = blockIdx.x, nb = gridDim.x;
    if (bid == 0) { int* cnt = reinterpret_cast<int*>(p.ws + WS_CNT); if (tid < 2 * N_EXPERTS) cnt[tid] = 0; }
    if (bid == (1 % nb)) {
        float* lb = reinterpret_cast<float*>(p.ws + WS_LB);
        for (int i = tid; i < HG_KW; i += NT) {
            float a0 = p.hgrn_lower_bounds[i], a1 = p.hgrn_lower_bounds[HG_KW + i], a2 = p.hgrn_lower_bounds[2 * HG_KW + i];
            float m = fmaxf(a0, fmaxf(a1, a2));
            float e0 = expf(a0 - m), e1 = expf(a1 - m), e2 = expf(a2 - m);
            lb[i] = e0 / (e0 + e1 + e2);
        }
    }
    {
        float* mod = reinterpret_cast<float*>(p.ws + WS_MOD);
        float* sc = reinterpret_cast<float*>(smem);
        for (int i = tid; i < (BATCH + 1) * D_MODEL; i += NT) {
            int bb = i / D_MODEL, d = i - bb * D_MODEL;
            float v = bb < BATCH ? p.c[bb * D_MODEL + d] : p.c_ctx[d];
            sc[i] = siluf_(v);
        }
        __syncthreads();
        constexpr int NCOL = DEPTH * N_MOD * D_MODEL;
        for (int col = bid * NT + tid; col < NCOL; col += nb * NT) {
            const int l = col / (N_MOD * D_MODEL), j = col - l * (N_MOD * D_MODEL);
            const float* w = p.ada_w + (size_t)l * D_MODEL * N_MOD * D_MODEL + j;
            float acc[BATCH + 1];
#pragma unroll
            for (int bb = 0; bb <= BATCH; ++bb) acc[bb] = 0.f;
            for (int i = 0; i < D_MODEL; ++i) {
                float wv = w[(size_t)i * (N_MOD * D_MODEL)];
#pragma unroll
                for (int bb = 0; bb <= BATCH; ++bb) acc[bb] += sc[bb * D_MODEL + i] * wv;
            }
            float bias = p.ada_b[l * N_MOD * D_MODEL + j];
#pragma unroll
            for (int bb = 0; bb <= BATCH; ++bb) mod[((size_t)l * (BATCH + 1) + bb) * (N_MOD * D_MODEL) + j] = acc[bb] + bias;
        }
        __syncthreads();
    }
    {
        constexpr int KT = D_MODEL / 64;
        constexpr int U0 = KT * (EVEN_PROJ_PAD / 64), U1 = KT * (ODD_PROJ_PAD / 64);
        constexpr int U2 = (EVEN_OUT / 64) * (D_MODEL / 64), U3 = (ODD_OUT / 64) * (D_MODEL / 64);
        for (int u = bid; u < U0 + U1 + U2 + U3; u += nb) {
            if (u < U0) { int kt = u % KT, nt_ = u / KT; cvt_tile(p.even_w_in, EVEN_PROJ, D_MODEL, kt * 64, nt_ * 64, reinterpret_cast<bf16_t*>(p.ws + WS_WIN0), [](int n) { return n; }, EVEN_PROJ); }
            else if (u < U0 + U1) { int v = u - U0; int kt = v % KT, nt_ = v / KT; cvt_tile(p.odd_w_in, ODD_PROJ, D_MODEL, kt * 64, nt_ * 64, reinterpret_cast<bf16_t*>(p.ws + WS_WIN1), [](int n) { return n; }, ODD_PROJ); }
            else if (u < U0 + U1 + U2) { int v = u - U0 - U1; int kt = v % (EVEN_OUT / 64), nt_ = v / (EVEN_OUT / 64); cvt_tile(p.even_w_out, D_MODEL, EVEN_OUT, kt * 64, nt_ * 64, reinterpret_cast<bf16_t*>(p.ws + WS_WOUT0), [](int n) { return n; }, D_MODEL); }
            else { int v = u - U0 - U1 - U2; int kt = v % (ODD_OUT / 64), nt_ = v / (ODD_OUT / 64); cvt_tile(p.odd_w_out, D_MODEL, ODD_OUT, kt * 64, nt_ * 64, reinterpret_cast<bf16_t*>(p.ws + WS_WOUT1), [](int n) { return n; }, D_MODEL); }
        }
    }
}

template <int LAYER> __device__ void phase_norm1(const Params& p) {
    const int tid = threadIdx.x, lane = tid & 63, wv = (blockIdx.x * NT + tid) >> 6, nwv = gridDim.x * (NT / 64);
    const float* mod = reinterpret_cast<const float*>(p.ws + WS_MOD) + (size_t)LAYER * (BATCH + 1) * N_MOD * D_MODEL;
    const float* xc = LAYER == 0 ? p.ctx : reinterpret_cast<const float*>(p.ws + WS_XC);
    const float* xl = LAYER == 0 ? p.x : p.out;
    bf16_t* h = reinterpret_cast<bf16_t*>(p.ws + WS_H);
    const float* g = p.norm1_w + LAYER * D_MODEL;
    constexpr int NV = D_MODEL / 256;
    for (int row = wv; row < T_ALL; row += nwv) {
        const int b = row / LSEQ, s = row - b * LSEQ;
        const float* src; const float* md;
        if (s < CTX_LEN) { src = xc + ((size_t)b * CTX_LEN + s) * D_MODEL; md = mod + (size_t)BATCH * N_MOD * D_MODEL; }
        else { src = xl + ((size_t)b * SEQ + lat_nat<LAYER>(s - CTX_LEN)) * D_MODEL; md = mod + (size_t)b * N_MOD * D_MODEL; }
        F4 v[NV]; float ss = 0.f;
#pragma unroll
        for (int i = 0; i < NV; ++i) { v[i] = ldf4(src + i * 256 + lane * 4); ss += v[i].x * v[i].x + v[i].y * v[i].y + v[i].z * v[i].z + v[i].w * v[i].w; }
        ss = wave_sum(ss);
        const float rs = rsqrtf(ss * (1.0f / D_MODEL) + EPS);
#pragma unroll
        for (int i = 0; i < NV; ++i) {
            const int c = i * 256 + lane * 4;
            F4 gg = ldf4(g + c), m0 = ldf4(md + c), m1 = ldf4(md + D_MODEL + c);
            float o0 = v[i].x * rs * gg.x * (1.f + m1.x) + m0.x, o1 = v[i].y * rs * gg.y * (1.f + m1.y) + m0.y;
            float o2 = v[i].z * rs * gg.z * (1.f + m1.z) + m0.z, o3 = v[i].w * rs * gg.w * (1.f + m1.w) + m0.w;
            unsigned* dst = reinterpret_cast<unsigned*>(h + (size_t)row * D_MODEL + c);
            dst[0] = pack2(o0, o1); dst[1] = pack2(o2, o3);
        }
    }
}

template <int LAYER> __device__ void phase_inproj(const Params& p, unsigned char* smem) {
    constexpr int NP = LAYER == 0 ? EVEN_PROJ_PAD : ODD_PROJ_PAD;
    constexpr int MT = T_ALL / BM, NTL = NP / BN;
    const bf16_t* h = reinterpret_cast<const bf16_t*>(p.ws + WS_H);
    const bf16_t* wt = reinterpret_cast<const bf16_t*>(p.ws + (LAYER == 0 ? WS_WIN0 : WS_WIN1));
    bf16_t* P = reinterpret_cast<bf16_t*>(p.ws + WS_P);
    const int tid = threadIdx.x, wid = tid >> 6, lane = tid & 63, wr = wid >> 1, wc = wid & 1, fr = lane & 15, fq = lane >> 4;
    for (int t = blockIdx.x; t < MT * NTL; t += gridDim.x) {
        const int mt = t % MT, nt_ = t / MT;
        const int r0 = mt * BM + (tid >> 2), kc = (tid & 3) * 8;
        f32x4 acc[4][4];
        gemm_core(h + (size_t)r0 * D_MODEL + kc, h + (size_t)(r0 + 128) * D_MODEL + kc, wt + (size_t)(nt_ * BN + (tid >> 2)) * D_MODEL + kc, D_MODEL, smem, acc);
#pragma unroll
        for (int m = 0; m < 4; ++m)
#pragma unroll
            for (int n = 0; n < 4; ++n)
#pragma unroll
                for (int j = 0; j < 4; ++j) {
                    const int row = mt * BM + wr * 64 + m * 16 + fq * 4 + j, col = nt_ * BN + wc * 64 + n * 16 + fr;
                    P[(size_t)row * NP + col] = f2bf(acc[m][n][j]);
                }
    }
}

constexpr int PREP_TOK = 16;
__device__ void phase_prep0(const Params& p, unsigned char* smem) {
    constexpr int W = RWKV_W, NP = EVEN_PROJ_PAD, NACT = 2 * RWKV_DR + 2 * RWKV_AR + RWKV_GR;
    constexpr int TPT = PREP_TOK * W / NT;
    static_assert(TPT >= 1 && NT % W == 0 || W % NT == 0, "prep mapping");
    const bf16_t* P = reinterpret_cast<const bf16_t*>(p.ws + WS_P);
    bf16_t* AUX = reinterpret_cast<bf16_t*>(p.ws + WS_AUX0);
    float* act = reinterpret_cast<float*>(smem);
    const int tid = threadIdx.x;
    for (int u = blockIdx.x; u < T_ALL / PREP_TOK; u += gridDim.x) {
        const int row0 = u * PREP_TOK;
        for (int idx = tid; idx < PREP_TOK * RWKV_PROJ; idx += NT) {
            const int t = idx / RWKV_PROJ, col = idx - t * RWKV_PROJ, row = row0 + t;
            const int s = row % LSEQ;
            const bool has_prev = (s != 0) && (s != CTX_LEN), has_next = (s != CTX_LEN - 1) && (s != LSEQ - 1);
            const float cur = bf2f(P[(size_t)row * NP + col]);
            const float pv = has_prev ? bf2f(P[(size_t)(row - 1) * NP + col]) : 0.f;
            const float nx = has_next ? bf2f(P[(size_t)(row + 1) * NP + col]) : 0.f;
            const float mixed = cur + (0.5f * (pv + nx) - cur) * p.rwkv_mu[col];
            if (col < 3 * W) AUX[(size_t)row * AUX0_W + col] = f2bf(mixed);
            else {
                const int a = col - 3 * W;
                float v = mixed;
                if (a < 2 * RWKV_DR) v = tanhf(mixed);
                else if (a >= 2 * RWKV_DR + 2 * RWKV_AR) v = sigmoidf_(mixed);
                act[t * NACT + a] = v;
            }
        }
        __syncthreads();
        {
            const int c = tid % W, t0 = (tid / W) * TPT;
            float acc[TPT];
#pragma unroll
            for (int kind = 0; kind < 5; ++kind) {
                const int rank = kind < 2 ? RWKV_DR : (kind < 4 ? RWKV_AR : RWKV_GR);
                const int aoff = kind < 2 ? kind * RWKV_DR : (kind < 4 ? 2 * RWKV_DR + (kind - 2) * RWKV_AR : 2 * RWKV_DR + 2 * RWKV_AR);
                const float* wm = kind < 2 ? p.rwkv_w2 + (size_t)kind * RWKV_DR * W : (kind < 4 ? p.rwkv_a2 + (size_t)(kind - 2) * RWKV_AR * W : p.rwkv_g2);
#pragma unroll
                for (int t = 0; t < TPT; ++t) acc[t] = 0.f;
                for (int r = 0; r < rank; ++r) {
                    const float wv = wm[(size_t)r * W + c];
#pragma unroll
                    for (int t = 0; t < TPT; ++t) acc[t] += act[(t0 + t) * NACT + aoff + r] * wv;
                }
#pragma unroll
                for (int t = 0; t < TPT; ++t) {
                    float o;
                    if (kind < 2) { const float wp = p.rwkv_w0[kind * W + c] + acc[t]; o = -expf(-softplusf_(-wp) - 0.5f); }
                    else if (kind < 4) o = sigmoidf_(p.rwkv_a0[(kind - 2) * W + c] + acc[t]);
                    else o = acc[t];
                    AUX[(size_t)(row0 + t0 + t) * AUX0_W + (3 + kind) * W + c] = f2bf(o);
                }
            }
        }
        __syncthreads();
    }
}

constexpr int RW_TB = 32;
__device__ void rwkv_unit(const Params& p, unsigned char* smem, int u) {
    constexpr int W = RWKV_W;
    const int dir = u / (BATCH * RWKV_HEADS), b = (u / RWKV_HEADS) % BATCH, h = u % RWKV_HEADS;
    const int tid = threadIdx.x, row = tid >> 3, kq = tid & 7;
    const bf16_t* AUX = reinterpret_cast<const bf16_t*>(p.ws + WS_AUX0);
    bf16_t* O = reinterpret_cast<bf16_t*>(p.ws + WS_O0) + (size_t)dir * T_ALL * OW0;
    float* sw = reinterpret_cast<float*>(smem);
    float* sk = sw + RW_TB * 64; float* skk = sk + RW_TB * 64; float* sb = skk + RW_TB * 64;
    float* sr = sb + RW_TB * 64; float* sv = sr + RW_TB * 64; float* so = sv + RW_TB * 64;
    float S[8];
#pragma unroll
    for (int j = 0; j < 8; ++j) S[j] = 0.f;
    for (int j0 = 0; j0 < LSEQ; j0 += RW_TB) {
        for (int idx = tid; idx < RW_TB * 64; idx += NT) {
            const int i = idx >> 6, n = idx & 63, ch = h * 64 + n;
            const size_t rowg = (size_t)b * LSEQ + step_pos(dir, j0 + i);
            const bf16_t* a = AUX + rowg * AUX0_W;
            const float r = bf2f(a[ch]), k = bf2f(a[W + ch]), v = bf2f(a[2 * W + ch]);
            const float lw = bf2f(a[(3 + dir) * W + ch]), av = bf2f(a[(5 + dir) * W + ch]);
            float kk = k * p.rwkv_k_k[ch];
            const float nrm = wave_sum(kk * kk);
            kk *= rsqrtf(nrm + 1e-12f);
            sw[idx] = expf(lw); sk[idx] = k * (1.f + (av - 1.f) * p.rwkv_k_a[ch]); skk[idx] = kk; sb[idx] = kk * av; sr[idx] = r; sv[idx] = v;
        }
        __syncthreads();
        for (int i = 0; i < RW_TB; ++i) {
            const int base = i * 64 + kq * 8;
            float sa = 0.f;
#pragma unroll
            for (int j = 0; j < 8; ++j) sa += S[j] * skk[base + j];
            sa += __shfl_xor(sa, 1, 64); sa += __shfl_xor(sa, 2, 64); sa += __shfl_xor(sa, 4, 64);
            const float vv = sv[i * 64 + row];
            float o = 0.f;
#pragma unroll
            for (int j = 0; j < 8; ++j) {
                S[j] = S[j] * sw[base + j] - sa * sb[base + j] + vv * sk[base + j];
                o += S[j] * sr[base + j];
            }
            o += __shfl_xor(o, 1, 64); o += __shfl_xor(o, 2, 64); o += __shfl_xor(o, 4, 64);
            if (kq == 0) so[i * 64 + row] = o;
        }
        __syncthreads();
        for (int idx = tid; idx < RW_TB * 64; idx += NT) {
            const int i = idx >> 6, n = idx & 63;
            const size_t rowg = (size_t)b * LSEQ + step_pos(dir, j0 + i);
            O[rowg * OW0 + h * 64 + n] = f2bf(so[idx]);
        }
    }
    __syncthreads();
}

__device__ void hgrn_unit(const Params& p, unsigned char* smem, int u) {
    constexpr int NP = EVEN_PROJ_PAD, CH = HG_CH;
    const int dir = u / (BATCH * HGRN_HEADS), b = (u / HGRN_HEADS) % BATCH, h = u % HGRN_HEADS;
    const int tid = threadIdx.x, wid = tid >> 6, lane = tid & 63, fr = lane & 15, fq = lane >> 4;
    const bf16_t* P = reinterpret_cast<const bf16_t*>(p.ws + WS_P);
    const float* lb = reinterpret_cast<const float*>(p.ws + WS_LB);
    bf16_t* O = reinterpret_cast<bf16_t*>(p.ws + WS_O0) + (size_t)dir * T_ALL * OW0;
    bf16_t* qin = reinterpret_cast<bf16_t*>(smem);
    bf16_t* kin = qin + CH * 128;
    bf16_t* kendT = kin + CH * 128;
    bf16_t* vT = kendT + 128 * CH;
    bf16_t* Al = vT + 128 * CH;
    bf16_t* StL = Al + CH * CH;
    float* tot = reinterpret_cast<float*>(StL + 128 * 128);
    float* eblast = tot + 4 * 128;
    f32x4 S[8];
#pragma unroll
    for (int n = 0; n < 8; ++n) S[n] = f32x4{0.f, 0.f, 0.f, 0.f};
    const int g = tid >> 7, d = tid & 127;
    const float lbv = lb[h * 128 + d];
    for (int j0 = 0; j0 < LSEQ; j0 += CH) {
        float cs[8], kf[8], qs[8], vv[8];
        float run = 0.f;
#pragma unroll
        for (int tt = 0; tt < 8; ++tt) {
            const int t = g * 8 + tt;
            const bf16_t* pr = P + ((size_t)b * LSEQ + step_pos(dir, j0 + t)) * NP + RWKV_PROJ;
            const float qraw = bf2f(pr[h * 128 + d]), fraw = bf2f(pr[HG_KW + dir * HG_KW + h * 128 + d]);
            vv[tt] = bf2f(pr[3 * HG_KW + h * 128 + d]);
            const float sg = sigmoidf_(fraw);
            run += logf(lbv + (1.f - lbv) * sg);
            cs[tt] = run; kf[tt] = (1.f - lbv) * (1.f - sg);
            qs[tt] = siluf_(qraw) * 0.08838834764831845f;
        }
        tot[g * 128 + d] = run;
        __syncthreads();
        float off = 0.f, bl = 0.f;
#pragma unroll
        for (int gg = 0; gg < 4; ++gg) { const float tv = tot[gg * 128 + d]; bl += tv; if (gg < g) off += tv; }
#pragma unroll
        for (int tt = 0; tt < 8; ++tt) {
            const int t = g * 8 + tt; const float bc = off + cs[tt];
            qin[t * 128 + d] = f2bf(qs[tt] * expf(bc));
            kin[t * 128 + d] = f2bf(kf[tt] * expf(-bc));
            kendT[d * CH + t] = f2bf(kf[tt] * expf(bl - bc));
            vT[d * CH + t] = f2bf(vv[tt]);
        }
        if (g == 0) eblast[d] = expf(bl);
#pragma unroll
        for (int n = 0; n < 8; ++n)
#pragma unroll
            for (int j = 0; j < 4; ++j) StL[(wid * 16 + fq * 4 + j) * 128 + n * 16 + fr] = f2bf(S[n][j]);
        __syncthreads();
        if (wid < 4) {
            const int ti = wid >> 1, si = wid & 1;
            f32x4 a = f32x4{0.f, 0.f, 0.f, 0.f};
#pragma unroll
            for (int ks = 0; ks < 4; ++ks) {
                bf16x8 fa = *reinterpret_cast<const bf16x8*>(qin + (ti * 16 + fr) * 128 + ks * 32 + fq * 8);
                bf16x8 fb = *reinterpret_cast<const bf16x8*>(kin + (si * 16 + fr) * 128 + ks * 32 + fq * 8);
                a = mfma16(fa, fb, a);
            }
#pragma unroll
            for (int j = 0; j < 4; ++j) {
                const int t = ti * 16 + fq * 4 + j, s = si * 16 + fr;
                Al[t * CH + s] = f2bf(s <= t ? a[j] : 0.f);
            }
        }
        __syncthreads();
#pragma unroll
        for (int ti = 0; ti < 2; ++ti) {
            f32x4 oa = f32x4{0.f, 0.f, 0.f, 0.f};
            {
                bf16x8 fa = *reinterpret_cast<const bf16x8*>(Al + (ti * 16 + fr) * CH + fq * 8);
                bf16x8 fb = *reinterpret_cast<const bf16x8*>(vT + (wid * 16 + fr) * CH + fq * 8);
                oa = mfma16(fa, fb, oa);
            }
#pragma unroll
            for (int ks = 0; ks < 4; ++ks) {
                bf16x8 fa = *reinterpret_cast<const bf16x8*>(qin + (ti * 16 + fr) * 128 + ks * 32 + fq * 8);
                bf16x8 fb = *reinterpret_cast<const bf16x8*>(StL + (wid * 16 + fr) * 128 + ks * 32 + fq * 8);
                oa = mfma16(fa, fb, oa);
            }
#pragma unroll
            for (int j = 0; j < 4; ++j) {
                const int t = ti * 16 + fq * 4 + j;
                const size_t rowg = (size_t)b * LSEQ + step_pos(dir, j0 + t);
                O[rowg * OW0 + RWKV_W + h * 128 + wid * 16 + fr] = f2bf(oa[j]);
            }
        }
        {
            bf16x8 fa = *reinterpret_cast<const bf16x8*>(vT + (wid * 16 + fr) * CH + fq * 8);
#pragma unroll
            for (int n = 0; n < 8; ++n) {
                const float e = eblast[n * 16 + fr];
                f32x4 c = S[n]; c[0] *= e; c[1] *= e; c[2] *= e; c[3] *= e;
                bf16x8 fb = *reinterpret_cast<const bf16x8*>(kendT + (n * 16 + fr) * CH + fq * 8);
                S[n] = mfma16(fa, fb, c);
            }
        }
        __syncthreads();
    }
}

__device__ void phase_scan0(const Params& p, unsigned char* smem) {
    constexpr int NU_R = 2 * BATCH * RWKV_HEADS, NU_H = 2 * BATCH * HGRN_HEADS;
    for (int u = blockIdx.x; u < NU_R + NU_H; u += gridDim.x) {
        if (u < NU_R) rwkv_unit(p, smem, u); else hgrn_unit(p, smem, u - NU_R);
        __syncthreads();
    }
}

template <int HL> __device__ __forceinline__ float group_sum(float v) {
#pragma unroll
    for (int m = HL / 2; m >= 1; m >>= 1) v += __shfl_xor(v, m, 64);
    return v;
}
__device__ void phase_finish0(const Params& p) {
    constexpr int W = RWKV_W, NP = EVEN_PROJ_PAD;
    constexpr int CR = W / 64, HLR = 64 / CR;
    constexpr int CHH = HG_VW / 64, HLH = HG_DV / CHH;
    const int tid = threadIdx.x, lane = tid & 63, wv = (blockIdx.x * NT + tid) >> 6, nwv = gridDim.x * (NT / 64);
    const bf16_t* P = reinterpret_cast<const bf16_t*>(p.ws + WS_P);
    const bf16_t* AUX = reinterpret_cast<const bf16_t*>(p.ws + WS_AUX0);
    bf16_t* O0 = reinterpret_cast<bf16_t*>(p.ws + WS_O0);
    const bf16_t* O1 = O0 + (size_t)T_ALL * OW0;
    for (int row = wv; row < T_ALL; row += nwv) {
        bf16_t* o0 = O0 + (size_t)row * OW0; const bf16_t* o1 = O1 + (size_t)row * OW0;
        const bf16_t* a = AUX + (size_t)row * AUX0_W;
        {
            float o[CR], r[CR], k[CR], v[CR], a0[CR], a1[CR], g[CR];
            float sum = 0.f, bon = 0.f;
#pragma unroll
            for (int i = 0; i < CR; ++i) {
                const int c = lane * CR + i;
                o[i] = bf2f(o0[c]) + bf2f(o1[c]); sum += o[i];
                r[i] = bf2f(a[c]); k[i] = bf2f(a[W + c]); v[i] = bf2f(a[2 * W + c]);
                a0[i] = bf2f(a[5 * W + c]); a1[i] = bf2f(a[6 * W + c]); g[i] = bf2f(a[7 * W + c]);
                const float ka = p.rwkv_k_a[c];
                const float km = k[i] * (1.f + (a0[i] - 1.f) * ka) + k[i] * (1.f + (a1[i] - 1.f) * ka);
                bon += r[i] * km * p.rwkv_r_k[c];
            }
            const float mu = group_sum<HLR>(sum) * (1.f / 64.f);
            bon = group_sum<HLR>(bon);
            float var = 0.f;
#pragma unroll
            for (int i = 0; i < CR; ++i) { const float dd = o[i] - mu; var += dd * dd; }
            var = group_sum<HLR>(var) * (1.f / 64.f);
            const float rs = rsqrtf(var + RWKV_GN_EPS);
#pragma unroll
            for (int i = 0; i < CR; ++i) {
                const int c = lane * CR + i;
                const float y = ((o[i] - mu) * rs * p.rwkv_ln_w[c] + p.rwkv_ln_b[c] + bon * v[i]) * g[i];
                o0[c] = f2bf(y);
            }
        }
        {
            const bf16_t* pr = P + (size_t)row * NP + RWKV_PROJ + 3 * HG_KW + HG_VW;
            float o[CHH]; float ss = 0.f;
#pragma unroll
            for (int i = 0; i < CHH; ++i) { const int c = lane * CHH + i; o[i] = bf2f(o0[W + c]) + bf2f(o1[W + c]); ss += o[i] * o[i]; }
            ss = group_sum<HLH>(ss) * (1.f / HG_DV);
            const float rs = rsqrtf(ss + EPS);
#pragma unroll
            for (int i = 0; i < CHH; ++i) {
                const int c = lane * CHH + i;
                o0[W + c] = f2bf(o[i] * rs * p.hgrn_norm_w[c] * siluf_(bf2f(pr[c])));
            }
        }
    }
}

template <int LAYER> __device__ void phase_outproj(const Params& p, unsigned char* smem) {
    constexpr int KD = LAYER == 0 ? EVEN_OUT : ODD_OUT, OWL = LAYER == 0 ? OW0 : OW1;
    constexpr int MROWS = LAYER == 0 ? T_ALL : T_LAT, MT = MROWS / BM, NTL = D_MODEL / BN;
    const bf16_t* A = reinterpret_cast<const bf16_t*>(p.ws + (LAYER == 0 ? WS_O0 : WS_O1));
    const bf16_t* wt = reinterpret_cast<const bf16_t*>(p.ws + (LAYER == 0 ? WS_WOUT0 : WS_WOUT1));
    const float* mod = reinterpret_cast<const float*>(p.ws + WS_MOD) + (size_t)LAYER * (BATCH + 1) * N_MOD * D_MODEL;
    float* xcw = reinterpret_cast<float*>(p.ws + WS_XC);
    const int tid = threadIdx.x, wid = tid >> 6, lane = tid & 63, wr = wid >> 1, wc = wid & 1, fr = lane & 15, fq = lane >> 4;
    auto arow = [](int m) -> size_t {
        if (LAYER == 0) return (size_t)m;
        const int b = m / SEQ, j = m - b * SEQ; return (size_t)b * LSEQ + CTX_LEN + j;
    };
    for (int t = blockIdx.x; t < MT * NTL; t += gridDim.x) {
        const int mt = t % MT, nt_ = t / MT;
        const int r0 = mt * BM + (tid >> 2), kc = (tid & 3) * 8;
        f32x4 acc[4][4];
        gemm_core(A + arow(r0) * OWL + kc, A + arow(r0 + 128) * OWL + kc, wt + (size_t)(nt_ * BN + (tid >> 2)) * KD + kc, KD, smem, acc);
#pragma unroll
        for (int m = 0; m < 4; ++m)
#pragma unroll
            for (int j = 0; j < 4; ++j) {
                const int row = mt * BM + wr * 64 + m * 16 + fq * 4 + j;
                const float* src; float* dst; const float* md;
                if (LAYER == 0) {
                    const int b = row / LSEQ, s = row - b * LSEQ;
                    if (s < CTX_LEN) { const size_t o = ((size_t)b * CTX_LEN + s) * D_MODEL; src = p.ctx + o; dst = xcw + o; md = mod + ((size_t)BATCH * N_MOD + 2) * D_MODEL; }
                    else { const size_t o = ((size_t)b * SEQ + (s - CTX_LEN)) * D_MODEL; src = p.x + o; dst = p.out + o; md = mod + ((size_t)b * N_MOD + 2) * D_MODEL; }
                } else {
                    const int b = row / SEQ, jj = row - b * SEQ;
                    const size_t o = ((size_t)b * SEQ + lat_nat<1>(jj)) * D_MODEL; src = p.out + o; dst = p.out + o; md = mod + ((size_t)b * N_MOD + 2) * D_MODEL;
                }
#pragma unroll
                for (int n = 0; n < 4; ++n) {
                    const int col = nt_ * BN + wc * 64 + n * 16 + fr;
                    dst[col] = src[col] + md[col] * acc[m][n][j];
                }
            }
    }
}

template <int LAYER> __device__ void phase_router(const Params& p, unsigned char* smem) {
    constexpr int TM = LAYER == 0 ? T_MOE0 : T_MOE1;
    constexpr int NG = 64 / N_EXPERTS, DG = D_MODEL / NG;
    const int tid = threadIdx.x, lane = tid & 63, wl = tid >> 6, wv = (blockIdx.x * NT + tid) >> 6, nwv = gridDim.x * (NT / 64);
    const float* mod = reinterpret_cast<const float*>(p.ws + WS_MOD) + (size_t)LAYER * (BATCH + 1) * N_MOD * D_MODEL;
    const float* xcw = reinterpret_cast<const float*>(p.ws + WS_XC);
    bf16_t* h2 = reinterpret_cast<bf16_t*>(p.ws + WS_H);
    int* tope = reinterpret_cast<int*>(p.ws + WS_TOPE); float* topp = reinterpret_cast<float*>(p.ws + WS_TOPP);
    int* rank = reinterpret_cast<int*>(p.ws + WS_RANK); int* cnt = reinterpret_cast<int*>(p.ws + WS_CNT) + LAYER * N_EXPERTS;
    float* hrow = reinterpret_cast<float*>(smem) + wl * D_MODEL;
    const float* g = p.norm2_w + LAYER * D_MODEL;
    const float* rw = p.router_w + (size_t)LAYER * D_MODEL * N_EXPERTS;
    constexpr int NV = D_MODEL / 256;
    for (int tok = wv; tok < TM; tok += nwv) {
        const float* src; const float* md;
        if (LAYER == 0 && tok < T_CTX) { src = xcw + (size_t)tok * D_MODEL; md = mod + (size_t)BATCH * N_MOD * D_MODEL; }
        else { const int n = LAYER == 0 ? tok - T_CTX : tok; src = p.out + (size_t)n * D_MODEL; md = mod + (size_t)(n / SEQ) * N_MOD * D_MODEL; }
        F4 v[NV]; float ss = 0.f;
#pragma unroll
        for (int i = 0; i < NV; ++i) { v[i] = ldf4(src + i * 256 + lane * 4); ss += v[i].x * v[i].x + v[i].y * v[i].y + v[i].z * v[i].z + v[i].w * v[i].w; }
        ss = wave_sum(ss);
        const float rs = rsqrtf(ss * (1.0f / D_MODEL) + EPS);
#pragma unroll
        for (int i = 0; i < NV; ++i) {
            const int c = i * 256 + lane * 4;
            F4 gg = ldf4(g + c), m3 = ldf4(md + 3 * D_MODEL + c), m4 = ldf4(md + 4 * D_MODEL + c);
            const float o0 = v[i].x * rs * gg.x * (1.f + m4.x) + m3.x, o1 = v[i].y * rs * gg.y * (1.f + m4.y) + m3.y;
            const float o2 = v[i].z * rs * gg.z * (1.f + m4.z) + m3.z, o3 = v[i].w * rs * gg.w * (1.f + m4.w) + m3.w;
            unsigned* dst = reinterpret_cast<unsigned*>(h2 + (size_t)tok * D_MODEL + c);
            dst[0] = pack2(o0, o1); dst[1] = pack2(o2, o3);
            hrow[c] = o0; hrow[c + 1] = o1; hrow[c + 2] = o2; hrow[c + 3] = o3;
        }
        wave_sync();
        const int e = lane % N_EXPERTS, dg = lane / N_EXPERTS;
        float lg = 0.f;
        for (int dd = 0; dd < DG; ++dd) { const int di = dg * DG + dd; lg += hrow[di] * rw[(size_t)di * N_EXPERTS + e]; }
#pragma unroll
        for (int m = N_EXPERTS; m < 64; m <<= 1) lg += __shfl_xor(lg, m, 64);
        lg += p.router_b[LAYER * N_EXPERTS + e];
        float tv[TOP_K]; int ti[TOP_K];
#pragma unroll
        for (int k = 0; k < TOP_K; ++k) {
            float bv = lg; int bi = e;
#pragma unroll
            for (int m = 32; m >= 1; m >>= 1) {
                const float ov = __shfl_xor(bv, m, 64); const int oi = __shfl_xor(bi, m, 64);
                if (ov > bv || (ov == bv && oi < bi)) { bv = ov; bi = oi; }
            }
            tv[k] = bv; ti[k] = bi;
            if (e == bi) lg = -INFINITY;
        }
        if (lane == 0) {
            float s = 0.f, pe[TOP_K];
#pragma unroll
            for (int k = 0; k < TOP_K; ++k) { pe[k] = expf(tv[k] - tv[0]); s += pe[k]; }
#pragma unroll
            for (int k = 0; k < TOP_K; ++k) {
                tope[(size_t)tok * TOP_K + k] = ti[k]; topp[(size_t)tok * TOP_K + k] = pe[k] / s;
                rank[(size_t)tok * TOP_K + k] = atomicAdd(&cnt[ti[k]], 1);
            }
        }
    }
}

struct MoeTab { int poff[N_EXPERTS + 1]; int cnt[N_EXPERTS]; int tile_e[MAX_MTILES]; int ntiles; };
template <int LAYER> __device__ __forceinline__ void build_moe_tab(const Params& p, MoeTab* tab) {
    const int* cnt = reinterpret_cast<const int*>(p.ws + WS_CNT) + LAYER * N_EXPERTS;
    if (threadIdx.x == 0) {
        int off = 0, nt = 0;
        for (int e = 0; e < N_EXPERTS; ++e) {
            const int c = cnt[e]; tab->cnt[e] = c; tab->poff[e] = off;
            const int tl = (c + BM - 1) / BM;
            for (int i = 0; i < tl; ++i) tab->tile_e[nt++] = e;
            off += tl * BM;
        }
        tab->poff[N_EXPERTS] = off; tab->ntiles = nt;
    }
    __syncthreads();
}

template <int LAYER> __device__ void phase_scatter(const Params& p, unsigned char* smem) {
    constexpr int TM = LAYER == 0 ? T_MOE0 : T_MOE1;
    MoeTab* tab = reinterpret_cast<MoeTab*>(smem);
    build_moe_tab<LAYER>(p, tab);
    const int* tope = reinterpret_cast<const int*>(p.ws + WS_TOPE); const int* rank = reinterpret_cast<const int*>(p.ws + WS_RANK);
    int* posof = reinterpret_cast<int*>(p.ws + WS_POSOF); int* tokof = reinterpret_cast<int*>(p.ws + WS_TOKOF);
    for (int i = blockIdx.x * NT + threadIdx.x; i < TM * TOP_K; i += gridDim.x * NT) {
        const int pos = tab->poff[tope[i]] + rank[i];
        posof[i] = pos; tokof[pos] = i / TOP_K;
    }
    __syncthreads();
    convert_expert_weights<LAYER>(p, blockIdx.x, gridDim.x);
}

template <int LAYER> __device__ void phase_moe1(const Params& p, unsigned char* smem) {
    MoeTab* tab = reinterpret_cast<MoeTab*>(smem + GEMM_SMEM);
    build_moe_tab<LAYER>(p, tab);
    constexpr int NTL = 2 * D_FF / BN;
    const bf16_t* h2 = reinterpret_cast<const bf16_t*>(p.ws + WS_H);
    const bf16_t* wgu = reinterpret_cast<const bf16_t*>(p.ws + WS_WGU);
    const int* tokof = reinterpret_cast<const int*>(p.ws + WS_TOKOF);
    bf16_t* H1 = reinterpret_cast<bf16_t*>(p.ws + WS_H1);
    const int tid = threadIdx.x, wid = tid >> 6, lane = tid & 63, wr = wid >> 1, wc = wid & 1, fr = lane & 15, fq = lane >> 4;
    const int ntiles = tab->ntiles;
    for (int t = blockIdx.x; t < ntiles * NTL; t += gridDim.x) {
        const int mi = t % ntiles, ni = t / ntiles;
        const int e = tab->tile_e[mi], pbase = tab->poff[e], ce = tab->cnt[e];
        const int r0 = mi * BM + (tid >> 2), kc = (tid & 3) * 8;
        const int tok0 = tokof[(r0 - pbase < ce) ? r0 : pbase], tok1 = tokof[(r0 + 128 - pbase < ce) ? r0 + 128 : pbase];
        f32x4 acc[4][4];
        gemm_core(h2 + (size_t)tok0 * D_MODEL + kc, h2 + (size_t)tok1 * D_MODEL + kc,
                  wgu + ((size_t)e * 2 * D_FF + ni * BN + (tid >> 2)) * D_MODEL + kc, D_MODEL, smem, acc);
        const float* bg = p.exp_b_gate + ((size_t)LAYER * N_EXPERTS + e) * D_FF;
        const float* bu = p.exp_b_up + ((size_t)LAYER * N_EXPERTS + e) * D_FF;
#pragma unroll
        for (int n2 = 0; n2 < 2; ++n2) {
            const int col = ni * 64 + wc * 32 + n2 * 16 + fr;
            const float bgv = bg[col], buv = bu[col];
#pragma unroll
            for (int m = 0; m < 4; ++m)
#pragma unroll
                for (int j = 0; j < 4; ++j) {
                    const int row = mi * BM + wr * 64 + m * 16 + fq * 4 + j;
                    float gv = fminf(acc[m][2 * n2][j] + bgv, SWIGLU_LIMIT);
                    float uv = fminf(fmaxf(acc[m][2 * n2 + 1][j] + buv, -SWIGLU_LIMIT), SWIGLU_LIMIT);
                    H1[(size_t)row * D_FF + col] = f2bf(gv * sigmoidf_(SWIGLU_ALPHA * gv) * (uv + 1.f));
                }
        }
    }
}

template <int LAYER> __device__ void phase_moe2(const Params& p, unsigned char* smem) {
    MoeTab* tab = reinterpret_cast<MoeTab*>(smem + GEMM_SMEM);
    build_moe_tab<LAYER>(p, tab);
    constexpr int NTL = D_MODEL / BN;
    const bf16_t* H1 = reinterpret_cast<const bf16_t*>(p.ws + WS_H1);
    const bf16_t* wdn = reinterpret_cast<const bf16_t*>(p.ws + WS_WDN);
    bf16_t* Y = reinterpret_cast<bf16_t*>(p.ws + WS_Y);
    const int tid = threadIdx.x, wid = tid >> 6, lane = tid & 63, wr = wid >> 1, wc = wid & 1, fr = lane & 15, fq = lane >> 4;
    const int ntiles = tab->ntiles;
    for (int t = blockIdx.x; t < ntiles * NTL; t += gridDim.x) {
        const int mi = t % ntiles, ni = t / ntiles;
        const int e = tab->tile_e[mi];
        const int r0 = mi * BM + (tid >> 2), kc = (tid & 3) * 8;
        f32x4 acc[4][4];
        gemm_core(H1 + (size_t)r0 * D_FF + kc, H1 + (size_t)(r0 + 128) * D_FF + kc,
                  wdn + ((size_t)e * D_MODEL + ni * BN + (tid >> 2)) * D_FF + kc, D_FF, smem, acc);
        const float* bd = p.exp_b_down + ((size_t)LAYER * N_EXPERTS + e) * D_MODEL;
#pragma unroll
        for (int n = 0; n < 4; ++n) {
            const int col = ni * BN + wc * 64 + n * 16 + fr; const float bv = bd[col];
#pragma unroll
            for (int m = 0; m < 4; ++m)
#pragma unroll
                for (int j = 0; j < 4; ++j) {
                    const int row = mi * BM + wr * 64 + m * 16 + fq * 4 + j;
                    Y[(size_t)row * D_MODEL + col] = f2bf(acc[m][n][j] + bv);
                }
        }
    }
}

template <int LAYER> __device__ void phase_combine(const Params& p) {
    constexpr int TM = LAYER == 0 ? T_MOE0 : T_MOE1;
    const int tid = threadIdx.x, lane = tid & 63, wv = (blockIdx.x * NT + tid) >> 6, nwv = gridDim.x * (NT / 64);
    const float* mod = reinterpret_cast<const float*>(p.ws + WS_MOD) + (size_t)LAYER * (BATCH + 1) * N_MOD * D_MODEL;
    float* xcw = reinterpret_cast<float*>(p.ws + WS_XC);
    const bf16_t* Y = reinterpret_cast<const bf16_t*>(p.ws + WS_Y);
    const int* posof = reinterpret_cast<const int*>(p.ws + WS_POSOF); const float* topp = reinterpret_cast<const float*>(p.ws + WS_TOPP);
    constexpr int NV = D_MODEL / 256;
    for (int tok = wv; tok < TM; tok += nwv) {
        float* xr; const float* md;
        if (LAYER == 0 && tok < T_CTX) { xr = xcw + (size_t)tok * D_MODEL; md = mod + ((size_t)BATCH * N_MOD + 5) * D_MODEL; }
        else { const int n = LAYER == 0 ? tok - T_CTX : tok; xr = p.out + (size_t)n * D_MODEL; md = mod + ((size_t)(n / SEQ) * N_MOD + 5) * D_MODEL; }
        int pos[TOP_K]; float pr[TOP_K];
#pragma unroll
        for (int k = 0; k < TOP_K; ++k) { pos[k] = posof[(size_t)tok * TOP_K + k]; pr[k] = topp[(size_t)tok * TOP_K + k]; }
        F4 xo[NV]; float ss = 0.f;
#pragma unroll
        for (int i = 0; i < NV; ++i) {
            const int c = i * 256 + lane * 4;
            float f0 = 0.f, f1 = 0.f, f2 = 0.f, f3 = 0.f;
#pragma unroll
            for (int k = 0; k < TOP_K; ++k) {
                const unsigned* yp = reinterpret_cast<const unsigned*>(Y + (size_t)pos[k] * D_MODEL + c);
                const unsigned u0 = yp[0], u1 = yp[1];
                f0 += pr[k] * lo2f(u0); f1 += pr[k] * hi2f(u0); f2 += pr[k] * lo2f(u1); f3 += pr[k] * hi2f(u1);
            }
            F4 xv = ldf4(xr + c), m5 = ldf4(md + c);
            xv.x += m5.x * f0; xv.y += m5.y * f1; xv.z += m5.z * f2; xv.w += m5.w * f3;
            xo[i] = xv; ss += xv.x * xv.x + xv.y * xv.y + xv.z * xv.z + xv.w * xv.w;
        }
        if (LAYER == 1) {
            ss = wave_sum(ss);
            const float rs = rsqrtf(ss * (1.0f / D_MODEL) + EPS);
#pragma unroll
            for (int i = 0; i < NV; ++i) {
                const int c = i * 256 + lane * 4; F4 gg = ldf4(p.final_norm_w + c);
                xo[i].x *= rs * gg.x; xo[i].y *= rs * gg.y; xo[i].z *= rs * gg.z; xo[i].w *= rs * gg.w;
            }
        }
#pragma unroll
        for (int i = 0; i < NV; ++i) *reinterpret_cast<F4*>(xr + i * 256 + lane * 4) = xo[i];
    }
}
__device__ void phase_prep1(const Params& p) {
    constexpr int NP = ODD_PROJ_PAD;
    const bf16_t* P = reinterpret_cast<const bf16_t*>(p.ws + WS_P);
    bf16_t* XC = reinterpret_cast<bf16_t*>(p.ws + WS_AUX1);
    constexpr int CP = XC_W / 2;
    for (size_t i = (size_t)blockIdx.x * NT + threadIdx.x; i < (size_t)T_ALL * CP; i += (size_t)gridDim.x * NT) {
        const int row = (int)(i / CP), c = (int)(i - (size_t)row * CP) * 2;
        const int s = row % LSEQ;
        const int lo = s < CTX_LEN ? 0 : CTX_LEN, hi = s < CTX_LEN ? CTX_LEN : LSEQ;
        int pc; const float* cw; const float* cb; int cc, cwid;
        if (c < SSD_CONV_CH) { pc = SSD_INNER + c; cw = p.ssd_conv_w; cb = p.ssd_conv_b; cc = c; cwid = SSD_CONV_CH; }
        else { cc = c - SSD_CONV_CH; pc = SSD_PROJ + cc; cw = p.mlstm_conv_w; cb = p.mlstm_conv_b; cwid = 2 * ML_QKW; }
        float a0 = cb[cc], a1 = cb[cc + 1];
#pragma unroll
        for (int j = 0; j < 5; ++j) {
            const int ss = s + j - 2;
            if (ss >= lo && ss < hi) {
                const unsigned u = *reinterpret_cast<const unsigned*>(P + (size_t)(row + j - 2) * NP + pc);
                a0 += lo2f(u) * cw[j * cwid + cc]; a1 += hi2f(u) * cw[j * cwid + cc + 1];
            }
        }
        *reinterpret_cast<unsigned*>(XC + (size_t)row * XC_W + c) = pack2(siluf_(a0), siluf_(a1));
    }
}

__device__ __forceinline__ float wave_incl_scan_add(float v, int lane) {
#pragma unroll
    for (int d = 1; d < 64; d <<= 1) { const float o = __shfl_up(v, d, 64); if (lane >= d) v += o; }
    return v;
}
__device__ __forceinline__ float wave_incl_scan_max(float v, int lane) {
#pragma unroll
    for (int d = 1; d < 64; d <<= 1) { const float o = __shfl_up(v, d, 64); if (lane >= d) v = fmaxf(v, o); }
    return v;
}

__device__ void ssd_unit(const Params& p, unsigned char* smem, int u) {
    constexpr int NP = ODD_PROJ_PAD, CH = SSD_CH, HP = SSD_HG / 2;
    const int dir = u / (BATCH * SSD_G * HP), b = (u / (SSD_G * HP)) % BATCH, g = (u / HP) % SSD_G, hp = u % HP;
    const int tid = threadIdx.x, wid = tid >> 6, lane = tid & 63, fr = lane & 15, fq = lane >> 4;
    const int hh = wid >> 2, wq = wid & 3, head = g * SSD_HG + hp * 2 + hh, th = tid & 255;
    const bf16_t* P = reinterpret_cast<const bf16_t*>(p.ws + WS_P);
    const bf16_t* XC = reinterpret_cast<const bf16_t*>(p.ws + WS_AUX1);
    bf16_t* O = reinterpret_cast<bf16_t*>(p.ws + WS_O1) + (size_t)dir * T_ALL * OW1;
    bf16_t* Cm = reinterpret_cast<bf16_t*>(smem);
    bf16_t* Bm = Cm + CH * 128;
    bf16_t* BT = Bm + CH * 128;
    float* CB = reinterpret_cast<float*>(BT + 128 * CH);
    bf16_t* Gm = reinterpret_cast<bf16_t*>(CB + CH * CH) + hh * (CH * CH);
    bf16_t* xdtT = reinterpret_cast<bf16_t*>(CB + CH * CH) + 2 * CH * CH + hh * (64 * CH);
    bf16_t* xdtET = reinterpret_cast<bf16_t*>(CB + CH * CH) + 4 * CH * CH + hh * (64 * CH);
    bf16_t* hsL = reinterpret_cast<bf16_t*>(CB + CH * CH) + 6 * CH * CH + hh * (64 * 128);
    float* acum = reinterpret_cast<float*>(reinterpret_cast<bf16_t*>(CB + CH * CH) + 6 * CH * CH + 2 * 64 * 128) + hh * 128;
    float* dtv = acum + 64;
    f32x4 hs[8];
#pragma unroll
    for (int n = 0; n < 8; ++n) hs[n] = f32x4{0.f, 0.f, 0.f, 0.f};
    const float dtb = p.ssd_dt_bias[dir * SSD_HEADS + head], aneg = -expf(p.ssd_a_log[dir * SSD_HEADS + head]);
    for (int j0 = 0; j0 < LSEQ; j0 += CH) {
        for (int idx = tid; idx < CH * 128; idx += NT) {
            const int t = idx >> 7, n = idx & 127;
            const bf16_t* xr = XC + ((size_t)b * LSEQ + step_pos(dir, j0 + t)) * XC_W + SSD_INNER;
            const bf16_t bv = xr[g * SSD_N + n], cv = xr[SSD_G * SSD_N + g * SSD_N + n];
            Bm[t * 128 + n] = bv; BT[n * CH + t] = bv; Cm[t * 128 + n] = cv;
        }
        if (wq == 0) {
            const size_t rowg = (size_t)b * LSEQ + step_pos(dir, j0 + lane);
            const float dt = softplusf_(bf2f(P[rowg * NP + SSD_INNER + SSD_CONV_CH + dir * SSD_HEADS + head]) + dtb);
            const float ac = wave_incl_scan_add(dt * aneg, lane);
            acum[lane] = ac; dtv[lane] = dt;
        }
#pragma unroll
        for (int n = 0; n < 8; ++n)
#pragma unroll
            for (int j = 0; j < 4; ++j) hsL[(wq * 16 + fq * 4 + j) * 128 + n * 16 + fr] = f2bf(hs[n][j]);
        __syncthreads();
        const float alast = acum[63];
        for (int idx = th; idx < CH * 64; idx += 256) {
            const int t = idx >> 6, pp = idx & 63;
            const float xv = bf2f(XC[((size_t)b * LSEQ + step_pos(dir, j0 + t)) * XC_W + head * SSD_P + pp]) * dtv[t];
            xdtT[pp * CH + t] = f2bf(xv); xdtET[pp * CH + t] = f2bf(xv * expf(alast - acum[t]));
        }
#pragma unroll
        for (int q = 0; q < 2; ++q) {
            const int tile = wid * 2 + q, ti = tile >> 2, si = tile & 3;
            f32x4 a = f32x4{0.f, 0.f, 0.f, 0.f};
#pragma unroll
            for (int ks = 0; ks < 4; ++ks) {
                bf16x8 fa = *reinterpret_cast<const bf16x8*>(Cm + (ti * 16 + fr) * 128 + ks * 32 + fq * 8);
                bf16x8 fb = *reinterpret_cast<const bf16x8*>(Bm + (si * 16 + fr) * 128 + ks * 32 + fq * 8);
                a = mfma16(fa, fb, a);
            }
#pragma unroll
            for (int j = 0; j < 4; ++j) CB[(ti * 16 + fq * 4 + j) * CH + si * 16 + fr] = a[j];
        }
        __syncthreads();
        for (int idx = th; idx < CH * CH; idx += 256) {
            const int t = idx >> 6, s = idx & 63;
            Gm[idx] = f2bf(s <= t ? CB[idx] * expf(acum[t] - acum[s]) : 0.f);
        }
        __syncthreads();
#pragma unroll
        for (int ti = 0; ti < 4; ++ti) {
            f32x4 a1 = f32x4{0.f, 0.f, 0.f, 0.f}, a2 = f32x4{0.f, 0.f, 0.f, 0.f};
#pragma unroll
            for (int ks = 0; ks < 2; ++ks) {
                bf16x8 fa = *reinterpret_cast<const bf16x8*>(Gm + (ti * 16 + fr) * CH + ks * 32 + fq * 8);
                bf16x8 fb = *reinterpret_cast<const bf16x8*>(xdtT + (wq * 16 + fr) * CH + ks * 32 + fq * 8);
                a1 = mfma16(fa, fb, a1);
            }
#pragma unroll
            for (int ks = 0; ks < 4; ++ks) {
                bf16x8 fa = *reinterpret_cast<const bf16x8*>(Cm + (ti * 16 + fr) * 128 + ks * 32 + fq * 8);
                bf16x8 fb = *reinterpret_cast<const bf16x8*>(hsL + (wq * 16 + fr) * 128 + ks * 32 + fq * 8);
                a2 = mfma16(fa, fb, a2);
            }
#pragma unroll
            for (int j = 0; j < 4; ++j) {
                const int t = ti * 16 + fq * 4 + j;
                const size_t rowg = (size_t)b * LSEQ + step_pos(dir, j0 + t);
                O[rowg * OW1 + head * SSD_P + wq * 16 + fr] = f2bf(a1[j] + expf(acum[t]) * a2[j]);
            }
        }
        {
            const float ea = expf(alast);
            bf16x8 fa0 = *reinterpret_cast<const bf16x8*>(xdtET + (wq * 16 + fr) * CH + fq * 8);
            bf16x8 fa1 = *reinterpret_cast<const bf16x8*>(xdtET + (wq * 16 + fr) * CH + 32 + fq * 8);
#pragma unroll
            for (int n = 0; n < 8; ++n) {
                f32x4 c = hs[n]; c[0] *= ea; c[1] *= ea; c[2] *= ea; c[3] *= ea;
                bf16x8 fb0 = *reinterpret_cast<const bf16x8*>(BT + (n * 16 + fr) * CH + fq * 8);
                bf16x8 fb1 = *reinterpret_cast<const bf16x8*>(BT + (n * 16 + fr) * CH + 32 + fq * 8);
                c = mfma16(fa0, fb0, c);
                hs[n] = mfma16(fa1, fb1, c);
            }
        }
        __syncthreads();
    }
}

__device__ void mlstm_unit(const Params& p, unsigned char* smem, int u) {
    constexpr int NP = ODD_PROJ_PAD, CH = ML_CH, VH = ML_DV / 2;
    const int dir = u / (BATCH * MLSTM_HEADS * 2), b = (u / (MLSTM_HEADS * 2)) % BATCH, h = (u >> 1) % MLSTM_HEADS, half = u & 1;
    const int tid = threadIdx.x, wid = tid >> 6, lane = tid & 63, fr = lane & 15, fq = lane >> 4;
    const bf16_t* P = reinterpret_cast<const bf16_t*>(p.ws + WS_P);
    const bf16_t* XC = reinterpret_cast<const bf16_t*>(p.ws + WS_AUX1);
    bf16_t* O = reinterpret_cast<bf16_t*>(p.ws + WS_O1) + (size_t)dir * T_ALL * OW1;
    bf16_t* qL = reinterpret_cast<bf16_t*>(smem);
    bf16_t* kL = qL + CH * 128;
    bf16_t* vT = kL + CH * 128;
    bf16_t* kET = vT + VH * CH;
    bf16_t* Sc = kET + 128 * CH;
    bf16_t* CtL = Sc + CH * CH;
    float* Fv = reinterpret_cast<float*>(CtL + VH * 128);
    float* gv = Fv + 64; float* Mv = gv + 64; float* wint = Mv + 64; float* coef = wint + 64; float* den = coef + 64;
    float* nsv = den + 64;
    float* scal = nsv + 128;
    f32x4 Ct[8];
#pragma unroll
    for (int n = 0; n < 8; ++n) Ct[n] = f32x4{0.f, 0.f, 0.f, 0.f};
    if (tid < 128) nsv[tid] = 0.f;
    if (tid == 0) scal[0] = ML_M_INIT;
    const float ib = p.mlstm_i_bias[dir * MLSTM_HEADS + h], fb_ = p.mlstm_f_bias[dir * MLSTM_HEADS + h];
    __syncthreads();
    for (int j0 = 0; j0 < LSEQ; j0 += CH) {
        for (int idx = tid; idx < CH * 128; idx += NT) {
            const int t = idx >> 7, d = idx & 127;
            const size_t rowg = (size_t)b * LSEQ + step_pos(dir, j0 + t);
            const bf16_t* xr = XC + rowg * XC_W + SSD_CONV_CH;
            qL[idx] = xr[h * ML_DK + d];
            kL[idx] = f2bf(bf2f(xr[ML_QKW + h * ML_DK + d]) * 0.08838834764831845f);
            vT[d * CH + t] = P[rowg * NP + SSD_PROJ + 2 * ML_QKW + h * ML_DV + half * VH + d];
        }
        if (wid == 0) {
            const size_t rowg = (size_t)b * LSEQ + step_pos(dir, j0 + lane);
            const bf16_t* gr = P + rowg * NP + SSD_PROJ + 2 * ML_QKW + 2 * ML_VW;
            const float li = bf2f(gr[dir * MLSTM_HEADS + h]) + ib;
            const float fx = bf2f(gr[2 * MLSTM_HEADS + dir * MLSTM_HEADS + h]) + fb_;
            const float lf = -softplusf_(-fx);
            const float F = wave_incl_scan_add(lf, lane);
            const float gg = li - F;
            const float pm = wave_incl_scan_max(gg, lane);
            const float mc = scal[0];
            const float M = fmaxf(pm, mc);
            const float F63 = __shfl(F, 63, 64), pm63 = __shfl(pm, 63, 64);
            const float m_end = F63 + pm63, m_new = fmaxf(F63 + mc, m_end);
            Fv[lane] = F; gv[lane] = gg; Mv[lane] = M; wint[lane] = expf(mc - M);
            coef[lane] = expf(gg + F63 - m_new);
            if (lane == 0) { scal[1] = expf(F63 + mc - m_new); scal[2] = m_new; }
        }
#pragma unroll
        for (int n = 0; n < 8; ++n)
#pragma unroll
            for (int j = 0; j < 4; ++j) CtL[(wid * 16 + fq * 4 + j) * 128 + n * 16 + fr] = f2bf(Ct[n][j]);
        __syncthreads();
        for (int idx = tid; idx < CH * 128; idx += NT) {
            const int s = idx >> 7, d = idx & 127;
            kET[d * CH + s] = f2bf(bf2f(kL[idx]) * coef[s]);
        }
#pragma unroll
        for (int q = 0; q < 2; ++q) {
            const int tile = wid * 2 + q, ti = tile >> 2, si = tile & 3;
            f32x4 a = f32x4{0.f, 0.f, 0.f, 0.f};
#pragma unroll
            for (int ks = 0; ks < 4; ++ks) {
                bf16x8 fa = *reinterpret_cast<const bf16x8*>(qL + (ti * 16 + fr) * 128 + ks * 32 + fq * 8);
                bf16x8 fb = *reinterpret_cast<const bf16x8*>(kL + (si * 16 + fr) * 128 + ks * 32 + fq * 8);
                a = mfma16(fa, fb, a);
            }
#pragma unroll
            for (int j = 0; j < 4; ++j) {
                const int t = ti * 16 + fq * 4 + j, s = si * 16 + fr;
                Sc[t * CH + s] = f2bf(s <= t ? a[j] * expf(gv[s] - Mv[t]) : 0.f);
            }
        }
        __syncthreads();
        float nsnew = 0.f;
        if (tid < 64) {
            float rsum = 0.f, qn = 0.f;
            for (int s = 0; s < CH; ++s) rsum += bf2f(Sc[tid * CH + s]);
            for (int d = 0; d < 128; ++d) qn += bf2f(qL[tid * 128 + d]) * nsv[d];
            den[tid] = rsum + wint[tid] * qn;
        } else if (tid < 192) {
            const int d = tid - 64; float acc = 0.f;
            for (int s = 0; s < CH; ++s) acc += bf2f(kET[d * CH + s]);
            nsnew = scal[1] * nsv[d] + acc;
        }
        f32x4 num[4];
#pragma unroll
        for (int ti = 0; ti < 4; ++ti) {
            f32x4 a1 = f32x4{0.f, 0.f, 0.f, 0.f}, a2 = f32x4{0.f, 0.f, 0.f, 0.f};
#pragma unroll
            for (int ks = 0; ks < 2; ++ks) {
                bf16x8 fa = *reinterpret_cast<const bf16x8*>(Sc + (ti * 16 + fr) * CH + ks * 32 + fq * 8);
                bf16x8 fb = *reinterpret_cast<const bf16x8*>(vT + (wid * 16 + fr) * CH + ks * 32 + fq * 8);
                a1 = mfma16(fa, fb, a1);
            }
#pragma unroll
            for (int ks = 0; ks < 4; ++ks) {
                bf16x8 fa = *reinterpret_cast<const bf16x8*>(qL + (ti * 16 + fr) * 128 + ks * 32 + fq * 8);
                bf16x8 fb = *reinterpret_cast<const bf16x8*>(CtL + (wid * 16 + fr) * 128 + ks * 32 + fq * 8);
                a2 = mfma16(fa, fb, a2);
            }
#pragma unroll
            for (int j = 0; j < 4; ++j) num[ti][j] = a1[j] + wint[ti * 16 + fq * 4 + j] * a2[j];
        }
        __syncthreads();
        if (tid >= 64 && tid < 192) nsv[tid - 64] = nsnew;
        if (tid == 0) scal[0] = scal[2];
#pragma unroll
        for (int ti = 0; ti < 4; ++ti)
#pragma unroll
            for (int j = 0; j < 4; ++j) {
                const int t = ti * 16 + fq * 4 + j;
                const size_t rowg = (size_t)b * LSEQ + step_pos(dir, j0 + t);
                const float dn = fmaxf(fabsf(den[t]), expf(-(Mv[t] + Fv[t])));
                O[rowg * OW1 + SSD_INNER + h * ML_DV + half * VH + wid * 16 + fr] = f2bf(num[ti][j] / dn);
            }
        {
            const float so = scal[1];
            bf16x8 fa0 = *reinterpret_cast<const bf16x8*>(vT + (wid * 16 + fr) * CH + fq * 8);
            bf16x8 fa1 = *reinterpret_cast<const bf16x8*>(vT + (wid * 16 + fr) * CH + 32 + fq * 8);
#pragma unroll
            for (int n = 0; n < 8; ++n) {
                f32x4 c = Ct[n]; c[0] *= so; c[1] *= so; c[2] *= so; c[3] *= so;
                bf16x8 fb0 = *reinterpret_cast<const bf16x8*>(kET + (n * 16 + fr) * CH + fq * 8);
                bf16x8 fb1 = *reinterpret_cast<const bf16x8*>(kET + (n * 16 + fr) * CH + 32 + fq * 8);
                c = mfma16(fa0, fb0, c);
                Ct[n] = mfma16(fa1, fb1, c);
            }
        }
        __syncthreads();
    }
}

__device__ void phase_scan1(const Params& p, unsigned char* smem) {
    constexpr int NU_S = 2 * BATCH * SSD_G * (SSD_HG / 2), NU_M = 2 * BATCH * MLSTM_HEADS * 2;
    for (int u = blockIdx.x; u < NU_S + NU_M; u += gridDim.x) {
        if (u < NU_M) mlstm_unit(p, smem, u); else ssd_unit(p, smem, u - NU_M);
        __syncthreads();
    }
}

__device__ void phase_finish1(const Params& p) {
    constexpr int NP = ODD_PROJ_PAD;
    constexpr int CS = SSD_INNER / 64, GLS = (SSD_INNER / SSD_G) / CS;
    constexpr int CM = ML_VW / 64, GLM = ML_DV / CM;
    const int tid = threadIdx.x, lane = tid & 63, wv = (blockIdx.x * NT + tid) >> 6, nwv = gridDim.x * (NT / 64);
    const bf16_t* P = reinterpret_cast<const bf16_t*>(p.ws + WS_P);
    const bf16_t* XC = reinterpret_cast<const bf16_t*>(p.ws + WS_AUX1);
    bf16_t* O0 = reinterpret_cast<bf16_t*>(p.ws + WS_O1);
    const bf16_t* O1 = O0 + (size_t)T_ALL * OW1;
    for (int m = wv; m < T_LAT; m += nwv) {
        const int b = m / SEQ, j = m - b * SEQ;
        const size_t row = (size_t)b * LSEQ + CTX_LEN + j;
        bf16_t* o0 = O0 + row * OW1; const bf16_t* o1 = O1 + row * OW1;
        const bf16_t* pr = P + row * NP; const bf16_t* xr = XC + row * XC_W;
        {
            float y[CS]; float ss = 0.f;
#pragma unroll
            for (int i = 0; i < CS; ++i) {
                const int c = lane * CS + i;
                const float yy = bf2f(o0[c]) + bf2f(o1[c]) + p.ssd_d[c / SSD_P] * bf2f(xr[c]);
                y[i] = yy * siluf_(bf2f(pr[c])); ss += y[i] * y[i];
            }
            ss = group_sum<GLS>(ss) * (1.f / (SSD_INNER / SSD_G));
            const float rs = rsqrtf(ss + EPS);
#pragma unroll
            for (int i = 0; i < CS; ++i) { const int c = lane * CS + i; o0[c] = f2bf(y[i] * rs * p.ssd_norm_w[c]); }
        }
        {
            float y[CM]; float ss = 0.f;
#pragma unroll
            for (int i = 0; i < CM; ++i) { const int c = lane * CM + i; y[i] = bf2f(o0[SSD_INNER + c]) + bf2f(o1[SSD_INNER + c]); ss += y[i] * y[i]; }
            ss = group_sum<GLM>(ss) * (1.f / ML_DV);
            const float rs = rsqrtf(ss + EPS);
#pragma unroll
            for (int i = 0; i < CM; ++i) {
                const int c = lane * CM + i;
                const float og = bf2f(pr[SSD_PROJ + 2 * ML_QKW + ML_VW + c]);
                o0[SSD_INNER + c] = f2bf(y[i] * rs * p.mlstm_norm_w[c] * sigmoidf_(og));
            }
        }
    }
}

enum { PH_PRO = 0,
       PH_NORM1_0, PH_INPROJ_0, PH_PREP_0, PH_SCAN_0, PH_FIN_0, PH_OUTPROJ_0, PH_ROUTER_0, PH_SCATTER_0, PH_MOE1_0, PH_MOE2_0, PH_COMBINE_0,
       PH_NORM1_1, PH_INPROJ_1, PH_PREP_1, PH_SCAN_1, PH_FIN_1, PH_OUTPROJ_1, PH_ROUTER_1, PH_SCATTER_1, PH_MOE1_1, PH_MOE2_1, PH_COMBINE_1,
       PH_COUNT };

template <int PH> __device__ __forceinline__ void run_phase(const Params& p, unsigned char* smem) {
    if (PH == PH_PRO) phase_prologue(p, smem);
    else if (PH == PH_NORM1_0) phase_norm1<0>(p);
    else if (PH == PH_INPROJ_0) phase_inproj<0>(p, smem);
    else if (PH == PH_PREP_0) phase_prep0(p, smem);
    else if (PH == PH_SCAN_0) phase_scan0(p, smem);
    else if (PH == PH_FIN_0) phase_finish0(p);
    else if (PH == PH_OUTPROJ_0) phase_outproj<0>(p, smem);
    else if (PH == PH_ROUTER_0) phase_router<0>(p, smem);
    else if (PH == PH_SCATTER_0) phase_scatter<0>(p, smem);
    else if (PH == PH_MOE1_0) phase_moe1<0>(p, smem);
    else if (PH == PH_MOE2_0) phase_moe2<0>(p, smem);
    else if (PH == PH_COMBINE_0) phase_combine<0>(p);
    else if (PH == PH_NORM1_1) phase_norm1<1>(p);
    else if (PH == PH_INPROJ_1) phase_inproj<1>(p, smem);
    else if (PH == PH_PREP_1) phase_prep1(p);
    else if (PH == PH_SCAN_1) phase_scan1(p, smem);
    else if (PH == PH_FIN_1) phase_finish1(p);
    else if (PH == PH_OUTPROJ_1) phase_outproj<1>(p, smem);
    else if (PH == PH_ROUTER_1) phase_router<1>(p, smem);
    else if (PH == PH_SCATTER_1) phase_scatter<1>(p, smem);
    else if (PH == PH_MOE1_1) phase_moe1<1>(p, smem);
    else if (PH == PH_MOE2_1) phase_moe2<1>(p, smem);
    else if (PH == PH_COMBINE_1) phase_combine<1>(p);
}

template <int PH> __global__ void __launch_bounds__(NT, 2) k_phase(Params p) {
    SMEM_DECL;
    run_phase<PH>(p, smem);
}

constexpr int SMEM_BYTES = 150 * 1024;

static Params make_params(void* const* d_in, void* d_out, void* d_ws) {
    Params p{};
    const float** f = reinterpret_cast<const float**>(&p);
    for (int i = 0; i < 45; ++i) f[i] = (const float*)d_in[i];
    p.out = (float*)d_out; p.ws = (unsigned char*)d_ws;
    return p;
}

#ifdef EMU
int emu_last_phase = PH_COUNT;
#endif
template <int PH> static void launch_phases(const Params& p, int grid, hipStream_t stream) {
    if constexpr (PH < PH_COUNT) {
#ifdef EMU
        if (PH >= emu_last_phase) return;
#else
        (void)hipFuncSetAttribute((const void*)k_phase<PH>, hipFuncAttributeMaxDynamicSharedMemorySize, SMEM_BYTES);
#endif
        hipLaunchKernelGGL(k_phase<PH>, dim3(grid), dim3(NT), SMEM_BYTES, stream, p);
        launch_phases<PH + 1>(p, grid, stream);
    }
}

extern "C" void kernel_launch(void* const* d_in, const int* in_sizes, int n_in, void* d_out, int out_size, void* d_ws, size_t ws_size,
                              hipStream_t stream) {
    Params p = make_params(d_in, d_out, d_ws);
#ifdef EMU
    int grid = 4;
#else
    int grid = 256;
#endif
    launch_phases<0>(p, grid, stream);
}
```

```cpp
#ifdef EMU
#include "hipemu.h"
#else
#include <hip/hip_runtime.h>
#include <cstdio>
#include <cstdint>
#endif

#ifdef SMALL_CFG
constexpr int D_MODEL = 256, BATCH = 2, SEQ = 256, GRID_W = 16, CTX_LEN = 128;
constexpr int RWKV_HEADS = 2, HGRN_HEADS = 1, SSD_HEADS = 4, MLSTM_HEADS = 1, N_EXPERTS = 8, D_FF = 256;
#else
constexpr int D_MODEL = 1024, BATCH = 8, SEQ = 4096, GRID_W = 64, CTX_LEN = 256;
constexpr int RWKV_HEADS = 8, HGRN_HEADS = 4, SSD_HEADS = 16, MLSTM_HEADS = 4, N_EXPERTS = 32, D_FF = 1024;
#endif
#ifndef PROBE_PREP0
#define PROBE_PREP0 1
#endif
#ifndef PROBE_HG_C
#define PROBE_HG_C 1
#endif
#ifndef PROBE_HG_A
#define PROBE_HG_A 1
#define PROBE_HG_B 1
#endif
#ifndef PROBE_REPS_A
#define PROBE_REPS_A 1
#define PROBE_REPS_B 1
#endif
constexpr int DEPTH = 2, N_MOD = 6;
constexpr float EPS = 1e-6f;
constexpr int GRID_ROWS = SEQ / GRID_W;
constexpr int LSEQ = CTX_LEN + SEQ;
constexpr int T_CTX = BATCH * CTX_LEN, T_LAT = BATCH * SEQ, T_ALL = BATCH * LSEQ;
constexpr int RWKV_N = 64, RWKV_W = RWKV_HEADS * RWKV_N, RWKV_DR = 64, RWKV_AR = 64, RWKV_GR = 128;
constexpr float RWKV_GN_EPS = 64e-5f;
constexpr int RWKV_PROJ = 3 * RWKV_W + 2 * RWKV_DR + 2 * RWKV_AR + RWKV_GR;
constexpr int HG_DK = 128, HG_DV = 128, HG_KW = HGRN_HEADS * HG_DK, HG_VW = HGRN_HEADS * HG_DV, HG_CH = 32;
constexpr int HGRN_PROJ = HG_KW + 2 * HG_KW + 2 * HG_VW;
constexpr int EVEN_PROJ = RWKV_PROJ + HGRN_PROJ, EVEN_OUT = RWKV_W + HG_VW;
constexpr int SSD_P = 64, SSD_INNER = SSD_HEADS * SSD_P, SSD_G = 2, SSD_N = 128, SSD_CH = 64, SSD_HG = SSD_HEADS / SSD_G;
constexpr int SSD_CONV_CH = SSD_INNER + 2 * SSD_G * SSD_N, SSD_PROJ = SSD_INNER + SSD_CONV_CH + 2 * SSD_HEADS;
constexpr int ML_DK = 128, ML_DV = 256, ML_QKW = MLSTM_HEADS * ML_DK, ML_VW = MLSTM_HEADS * ML_DV, ML_CH = 64;
constexpr float ML_M_INIT = -1e30f;
constexpr int MLSTM_PROJ = 2 * ML_QKW + 2 * ML_VW + 4 * MLSTM_HEADS;
constexpr int ODD_PROJ = SSD_PROJ + MLSTM_PROJ, ODD_OUT = SSD_INNER + ML_VW;
constexpr int TOP_K = 4;
constexpr float SWIGLU_LIMIT = 7.0f, SWIGLU_ALPHA = 1.702f;

constexpr int NT = 512;
constexpr int BM = 256, BN = 256;
constexpr int rup(int a, int b) { return (a + b - 1) / b * b; }
constexpr int EVEN_PROJ_PAD = rup(EVEN_PROJ, BN), ODD_PROJ_PAD = rup(ODD_PROJ, BN);
constexpr int PROJ_PAD_MAX = EVEN_PROJ_PAD > ODD_PROJ_PAD ? EVEN_PROJ_PAD : ODD_PROJ_PAD;
constexpr int AUX0_W = 8 * RWKV_W;
constexpr int XC_W = SSD_CONV_CH + 2 * ML_QKW;
constexpr int OW0 = EVEN_OUT, OW1 = ODD_OUT, OW_MAX = OW0 > OW1 ? OW0 : OW1;
constexpr int T_MOE0 = T_ALL, T_MOE1 = T_LAT;
constexpr int MOE_ROWS_MAX = T_MOE0 * TOP_K + N_EXPERTS * BM;
constexpr int MAX_MTILES = MOE_ROWS_MAX / BM;
static_assert(T_ALL % BM == 0 && T_LAT % BM == 0, "row tiles");
static_assert(CTX_LEN % 64 == 0 && SEQ % 64 == 0, "chunk alignment");
static_assert(D_MODEL % BN == 0 && (2 * D_FF) % BN == 0 && D_MODEL % 128 == 0 && D_FF % 128 == 0, "tiles");

typedef unsigned short bf16_t;
#ifndef EMU
typedef short bf16x8 __attribute__((ext_vector_type(8)));
typedef float f32x4 __attribute__((ext_vector_type(4)));
#define mfma16(a, b, c) __builtin_amdgcn_mfma_f32_16x16x32_bf16(a, b, c, 0, 0, 0)
#define SMEM_DECL extern __shared__ __attribute__((aligned(16))) unsigned char smem[]
#else
#define mfma16(a, b, c) emu_mfma_16x16x32_bf16(a, b, c)
#define SMEM_DECL unsigned char* smem = emu_cur->blk->smem
#endif

constexpr size_t al256(size_t x) { return (x + 255) / 256 * 256; }
constexpr size_t WS_BAR = 0;
constexpr size_t WS_CNT = 16384;
constexpr size_t WS_MOD = WS_CNT + 4096;
constexpr size_t WS_LB = al256(WS_MOD + sizeof(float) * 2 * (BATCH + 1) * N_MOD * D_MODEL);
constexpr size_t WS_WIN0 = al256(WS_LB + sizeof(float) * HG_KW);
constexpr size_t WS_WIN1 = al256(WS_WIN0 + 2ull * EVEN_PROJ_PAD * D_MODEL);
constexpr size_t WS_WOUT0 = al256(WS_WIN1 + 2ull * ODD_PROJ_PAD * D_MODEL);
constexpr size_t WS_WOUT1 = al256(WS_WOUT0 + 2ull * D_MODEL * EVEN_OUT);
constexpr size_t WS_XC = al256(WS_WOUT1 + 2ull * D_MODEL * ODD_OUT);
constexpr size_t WS_LRW = al256(WS_XC + 4ull * T_CTX * D_MODEL);
constexpr size_t WS_TOPE = al256(WS_LRW + 2ull * RWKV_W * (2 * RWKV_DR + 2 * RWKV_AR + RWKV_GR));
constexpr size_t WS_TOPP = al256(WS_TOPE + 4ull * T_MOE0 * TOP_K);
constexpr size_t WS_RANK = al256(WS_TOPP + 4ull * T_MOE0 * TOP_K);
constexpr size_t WS_POSOF = al256(WS_RANK + 4ull * T_MOE0 * TOP_K);
constexpr size_t WS_TOKOF = al256(WS_POSOF + 4ull * T_MOE0 * TOP_K);
constexpr size_t WS_H = al256(WS_TOKOF + 4ull * MOE_ROWS_MAX);
constexpr size_t WS_BIG = al256(WS_H + 2ull * T_ALL * D_MODEL);
constexpr size_t WS_P = WS_BIG;
constexpr size_t WS_AUX0 = al256(WS_P + 2ull * T_ALL * EVEN_PROJ_PAD);
constexpr size_t WS_O0 = al256(WS_AUX0 + 2ull * T_ALL * AUX0_W);
constexpr size_t WS_END0 = al256(WS_O0 + 2ull * 2 * T_ALL * OW0);
constexpr size_t WS_AUX1 = al256(WS_P + 2ull * T_ALL * ODD_PROJ_PAD);
constexpr size_t WS_O1 = al256(WS_AUX1 + 2ull * T_ALL * XC_W);
constexpr size_t WS_END1 = al256(WS_O1 + 2ull * 2 * T_ALL * OW1);
constexpr size_t WS_END_MIX = WS_END0 > WS_END1 ? WS_END0 : WS_END1;
constexpr size_t WS_H1 = WS_BIG;
constexpr size_t WS_Y = al256(WS_H1 + 2ull * MOE_ROWS_MAX * D_FF);
constexpr size_t WS_YEND = al256(WS_Y + 2ull * MOE_ROWS_MAX * D_MODEL);
constexpr size_t WS_WGU = WS_END0 > WS_YEND ? WS_END0 : WS_YEND;
constexpr size_t WS_WDN = al256(WS_WGU + 2ull * N_EXPERTS * 2 * D_FF * D_MODEL);
constexpr size_t WS_END_MOE = al256(WS_WDN + 2ull * N_EXPERTS * D_MODEL * D_FF);
constexpr size_t WS_TOTAL = WS_END_MIX > WS_END_MOE ? WS_END_MIX : WS_END_MOE;
#ifndef SMALL_CFG
static_assert(WS_TOTAL <= (1ull << 30), "workspace exceeds 1 GiB");
#endif

struct Params {
    const float *x, *c, *ctx, *c_ctx, *ada_w, *ada_b, *norm1_w, *norm2_w, *even_w_in, *even_w_out, *rwkv_mu, *rwkv_w0,
        *rwkv_w2, *rwkv_a0, *rwkv_a2, *rwkv_g2, *rwkv_k_k, *rwkv_k_a, *rwkv_r_k, *rwkv_ln_w, *rwkv_ln_b,
        *hgrn_lower_bounds, *hgrn_norm_w, *odd_w_in, *odd_w_out, *ssd_conv_w, *ssd_conv_b, *ssd_dt_bias,
        *ssd_a_log, *ssd_d, *ssd_norm_w, *mlstm_conv_w, *mlstm_conv_b, *mlstm_i_bias, *mlstm_f_bias,
        *mlstm_norm_w, *router_w, *router_b, *exp_w_gate, *exp_b_gate, *exp_w_up, *exp_b_up, *exp_w_down,
        *exp_b_down, *final_norm_w;
    float* out;
    unsigned char* ws;
};

#ifdef EMU
__device__ __forceinline__ bf16_t f2bf(float f) {
    unsigned u = __builtin_bit_cast(unsigned, f);
    u += 0x7FFFu + ((u >> 16) & 1u);
    return (bf16_t)(u >> 16);
}
#else
__device__ __forceinline__ bf16_t f2bf(float f) { return __builtin_bit_cast(bf16_t, (__bf16)f); }
#endif
__device__ __forceinline__ float bf2f(bf16_t h) { return __builtin_bit_cast(float, ((unsigned)h) << 16); }
#ifdef EMU
__device__ __forceinline__ unsigned pack2(float a, float b) { return (unsigned)f2bf(a) | ((unsigned)f2bf(b) << 16); }
__device__ __forceinline__ float flog(float x) { return logf(x); }
#else
typedef __bf16 bf16x2_hw __attribute__((ext_vector_type(2)));
typedef float f32x2_hw __attribute__((ext_vector_type(2)));
__device__ __forceinline__ unsigned pack2(float a, float b) {
    return __builtin_bit_cast(unsigned, __builtin_convertvector(f32x2_hw{a, b}, bf16x2_hw));
}
__device__ __forceinline__ float flog(float x) { return __builtin_amdgcn_logf(x) * 0.6931471805599453f; }
#endif
__device__ __forceinline__ float lo2f(unsigned u) { return __builtin_bit_cast(float, u << 16); }
__device__ __forceinline__ float hi2f(unsigned u) { return __builtin_bit_cast(float, u & 0xFFFF0000u); }
#ifdef EMU
__device__ __forceinline__ float fexp(float x) { return expf(x); }
__device__ __forceinline__ float frcp(float x) { return 1.0f / x; }
#else
__device__ __forceinline__ float fexp(float x) { return __builtin_amdgcn_exp2f(x * 1.4426950408889634f); }
__device__ __forceinline__ float frcp(float x) { return __builtin_amdgcn_rcpf(x); }
#endif
__device__ __forceinline__ float sigmoidf_(float x) { return frcp(1.0f + fexp(-x)); }
__device__ __forceinline__ float siluf_(float x) { return x * frcp(1.0f + fexp(-x)); }
__device__ __forceinline__ float softplusf_(float x) { return x > 20.f ? x : log1pf(expf(x)); }
__device__ __forceinline__ float wave_sum(float v) {
#pragma unroll
    for (int m = 32; m >= 1; m >>= 1) v += __shfl_xor(v, m, 64);
    return v;
}
#ifdef EMU
__device__ __forceinline__ void wave_sync() { int z = 0; (void)emu_wave_exchange(&z, 4); }
#else
__device__ __forceinline__ void wave_sync() { __builtin_amdgcn_fence(__ATOMIC_RELEASE, "wavefront"); __builtin_amdgcn_wave_barrier(); __builtin_amdgcn_fence(__ATOMIC_ACQUIRE, "wavefront"); }
#endif
__device__ __forceinline__ int opaque_tid() {
    int t = threadIdx.x;
#ifndef EMU
    asm volatile("" : "+v"(t));
#endif
    return t;
}
template <class T> __device__ __forceinline__ void sink(T v) {
#ifndef EMU
    asm volatile("" :: "v"(v));
#endif
}
__device__ __forceinline__ void lds_barrier() {
#ifdef EMU
    __syncthreads();
#else
    asm volatile("s_waitcnt lgkmcnt(0)" ::: "memory");
    __builtin_amdgcn_s_barrier();
    asm volatile("" ::: "memory");
#endif
}
struct alignas(16) U4 { unsigned x, y, z, w; };
__device__ __forceinline__ U4 ld16(const void* p) { return *reinterpret_cast<const U4*>(p); }
__device__ __forceinline__ void st16(void* p, U4 v) { *reinterpret_cast<U4*>(p) = v; }
struct alignas(16) F4 { float x, y, z, w; };
__device__ __forceinline__ F4 ldf4(const float* p) { return *reinterpret_cast<const F4*>(p); }

__device__ __forceinline__ void unpack8(const U4& u, float (&f)[8]) {
    f[0] = lo2f(u.x); f[1] = hi2f(u.x); f[2] = lo2f(u.y); f[3] = hi2f(u.y); f[4] = lo2f(u.z); f[5] = hi2f(u.z); f[6] = lo2f(u.w); f[7] = hi2f(u.w);
}
__device__ __forceinline__ void ldf8(const float* p, float (&f)[8]) {
    const F4 a = ldf4(p), b = ldf4(p + 4); f[0] = a.x; f[1] = a.y; f[2] = a.z; f[3] = a.w; f[4] = b.x; f[5] = b.y; f[6] = b.z; f[7] = b.w;
}
__device__ __forceinline__ U4 pack8f(const float (&f)[8]) { U4 o; o.x = pack2(f[0], f[1]); o.y = pack2(f[2], f[3]); o.z = pack2(f[4], f[5]); o.w = pack2(f[6], f[7]); return o; }

template <int LAYER> __device__ __forceinline__ int lat_nat(int j) {
    if (LAYER == 0) return j;
    int w = j / GRID_ROWS, r = j - w * GRID_ROWS;
    return r * GRID_W + w;
}
__device__ __forceinline__ int step_pos(int dir, int j) {
    if (dir == 0) return j;
    return j < CTX_LEN ? CTX_LEN - 1 - j : LSEQ + CTX_LEN - 1 - j;
}

#ifndef EMU
#define XB_TMO      128
#define XB_XCNT(j)  (256  + 64 * (j))
#define XB_XSUB(j)  (1280 + 64 * (j))
#define XB_XGEN(j)  (2304 + 64 * (j))
#define XB_TOP      3328
#define XB_TOPGEN   3392
#define XCD_BAR_WORDS 3456
#define XB_SPIN_CAP (1u << 22)
#define LAS __attribute__((address_space(3)))
__device__ __forceinline__ unsigned xb_ld(unsigned* p)              { return __hip_atomic_load(p, __ATOMIC_RELAXED, __HIP_MEMORY_SCOPE_AGENT); }
__device__ __forceinline__ unsigned xb_add(unsigned* p, unsigned v) { return __hip_atomic_fetch_add(p, v, __ATOMIC_RELAXED, __HIP_MEMORY_SCOPE_AGENT); }
__device__ __forceinline__ unsigned xb_xcc_id() { return (unsigned)__builtin_amdgcn_s_getreg((3 << 11) | 20) & 0xFu; }
#define XB_SPIN(cond, bar) do { unsigned _sp = 0; while (cond) { __builtin_amdgcn_s_sleep(1); \
    if ((++_sp & 255u) == 0u) { if (xb_ld(&(bar)[XB_TMO])) break; if (_sp > XB_SPIN_CAP) { atomicAdd(&(bar)[XB_TMO], 1u); break; } } } } while (0)
struct XcdBarrier { unsigned* bar; unsigned x; volatile LAS unsigned* st; };
__device__ __forceinline__ XcdBarrier xcd_barrier_post(unsigned* bar, volatile LAS unsigned* st) {
    XcdBarrier b; b.bar = bar; b.x = xb_xcc_id(); b.st = st;
    if (threadIdx.x == 0) (void)xb_add(&bar[XB_XCNT(b.x)], 1u);
    return b;
}
__device__ __forceinline__ void xcd_barrier_complete(unsigned* bar, unsigned x, unsigned& nloc, unsigned& nx) {
    const unsigned G = gridDim.x * gridDim.y * gridDim.z;
    unsigned sum, cnt, mine, sp = 0u;
    for (;;) {
        sum = 0u; cnt = 0u; mine = 0u;
#pragma unroll
        for (unsigned j = 0; j < 16; ++j) { const unsigned c = xb_ld(&bar[XB_XCNT(j)]); sum += c; cnt += (c > 0u) ? 1u : 0u; mine = (j == x) ? c : mine; }
        if (sum == G) break;
        __builtin_amdgcn_s_sleep(1);
        if ((++sp & 255u) == 0u) { if (xb_ld(&bar[XB_TMO])) break; if (sp > XB_SPIN_CAP) { atomicAdd(&bar[XB_TMO], 1u); break; } }
    }
    nloc = mine > 0u ? mine : 1u; nx = cnt > 0u ? cnt : 1u;
}
__device__ __forceinline__ void xcd_barrier(const XcdBarrier& b) {
    asm volatile("s_waitcnt vmcnt(0)" ::: "memory");
    __syncthreads();
    if (threadIdx.x == 0) {
        unsigned* bar = b.bar;
        __builtin_amdgcn_s_waitcnt(0);
        unsigned nloc = b.st[0], nx = b.st[1];
        if (nloc == 0u) { xcd_barrier_complete(bar, b.x, nloc, nx); b.st[0] = nloc; b.st[1] = nx; }
        const unsigned old = xb_add(&bar[XB_XSUB(b.x)], 1u);
        const unsigned gen = old / nloc;
        if (old + 1u == (gen + 1u) * nloc) {
            __builtin_amdgcn_fence(__ATOMIC_RELEASE, "agent");
            asm volatile("s_waitcnt vmcnt(0)" ::: "memory");
            const unsigned og = xb_add(&bar[XB_TOP], 1u);
            const unsigned tg = og / nx;
            if (og + 1u == (tg + 1u) * nx) xb_add(&bar[XB_TOPGEN], 1u);
            else XB_SPIN(xb_ld(&bar[XB_TOPGEN]) == tg, bar);
            __builtin_amdgcn_fence(__ATOMIC_ACQUIRE, "agent");
            xb_add(&bar[XB_XGEN(b.x)], 1u);
            asm volatile("s_waitcnt vmcnt(0)" ::: "memory");
        } else {
            XB_SPIN(xb_ld(&bar[XB_XGEN(b.x)]) == gen, bar);
            __builtin_amdgcn_fence(__ATOMIC_ACQUIRE, "agent");
            asm volatile("s_waitcnt vmcnt(0)" ::: "memory");
        }
    }
    __syncthreads();
}
#endif

namespace g8 {
#ifdef EMU
#define G8_LAS
__device__ __forceinline__ void glds16(const void* g, unsigned char* l) { memcpy(l + emu_cur->lane * 16, g, 16); }
#define G8_WAIT_V(n) do {} while (0)
#define G8_WAIT_L(n) do {} while (0)
#define G8_BAR __syncthreads()
#define G8_SCHED do {} while (0)
#define G8_PRIO(x) do {} while (0)
#else
#define G8_LAS __attribute__((address_space(3)))
__device__ __forceinline__ void glds16(const void* g, G8_LAS unsigned char* l) { __builtin_amdgcn_global_load_lds((const unsigned*)g, (G8_LAS unsigned*)l, 16, 0, 0); }
#define G8_WAIT_V(n) asm volatile("s_waitcnt vmcnt(" #n ")" ::: "memory")
#define G8_WAIT_L(n) asm volatile("s_waitcnt lgkmcnt(" #n ")" ::: "memory")
#define G8_BAR __builtin_amdgcn_s_barrier()
#define G8_SCHED __builtin_amdgcn_sched_barrier(0)
#define G8_PRIO(x) __builtin_amdgcn_s_setprio(x)
#endif
constexpr int TM = 256, TK = 64, HALF = 128, HTB = HALF * TK * 2, STAGE_BYTES = 8 * HTB, NXCD = 8, WGM = 8;
__device__ __forceinline__ int lds_byte(int r, int c) { const int st = (r >> 4) * 2 + (c >> 5), rr = r & 15, cc = c & 31, ob = rr * 64 + cc * 2; return st * 1024 + (ob ^ (((ob >> 9) & 1) << 5)); }
__device__ __forceinline__ void stage_rc(int b, int& R, int& C) { const int st = b / 1024, sb = b % 1024, swz = sb ^ (((sb >> 9) & 1) << 5); R = (st >> 1) * 16 + swz / 64; C = (st & 1) * 32 + (swz % 64) / 2; }
__device__ __forceinline__ int perm32(int rho) { const int n = rho >> 4, i = rho & 15; return 8 * (i >> 2) + 4 * n + (i & 3); }
__device__ __forceinline__ bool unit_of(int L, int nM, int nN, int& pm, int& pn) {
    const int nwg = nM * nN; if (L >= nwg) return false;
    int wgid = L; { const int q = nwg / NXCD, r = nwg % NXCD, xcd = wgid % NXCD, off = wgid / NXCD; wgid = (xcd < r ? xcd * (q + 1) : r * (q + 1) + (xcd - r) * q) + off; }
    const int nig = WGM * nN, gid = wgid / nig, fm = gid * WGM, gsz = (nM - fm) < WGM ? (nM - fm) : WGM;
    pm = fm + ((wgid % nig) % gsz); pn = (wgid % nig) / gsz; return true;
}

template <class Prob>
__device__ __forceinline__ void gemm_phase(unsigned char* smem, const Prob& pr) {
#ifdef EMU
    unsigned char* lds = smem;
#else
    G8_LAS unsigned char* lds = (G8_LAS unsigned char*)smem;
#endif
    const int tid = opaque_tid(), lane = tid & 63, fr = lane & 15, fq = lane >> 4;
#ifdef EMU
    const int wid = tid >> 6;
#else
    const int wid = __builtin_amdgcn_readfirstlane(tid >> 6);
#endif
    const int wr = wid >> 2, wc = wid & 3;
    constexpr int K = Prob::K, nt = K / TK;
    static_assert(K % 128 == 0 && K >= 256, "K");
    const int nM = pr.nM(), nN = pr.nN(), G = gridDim.x, c = blockIdx.x;
    int Rp[2], Cp[2]; unsigned voffB[2];
#pragma unroll
    for (int i = 0; i < 2; ++i) { int R, C; stage_rc(tid * 16 + i * 8192, R, C); Rp[i] = R; Cp[i] = C; const int Rb = Prob::PERM ? ((R & ~31) + perm32(R & 31)) : R; voffB[i] = (unsigned)(Rb * K + C) * 2u; }
    constexpr size_t kstep = (size_t)(TK * 2), hstepB = (size_t)HALF * K * 2, tstepB = 2 * hstepB;
    const unsigned ldsw = (unsigned)wid * 1024u;
    const int aoff = lds_byte(wr * 64 + fr, fq * 8), boff = lds_byte(wc * 32 + fr, fq * 8);
#define G8_SA(b, h) (((b) * 2 + (h)) * HTB)
#define G8_SB(b, h) ((4 + (b) * 2 + (h)) * HTB)
#define G8_STAGE(bufoff, gbase, voff) do { _Pragma("unroll") for (int _i = 0; _i < 2; ++_i) glds16((const char*)(gbase) + (voff)[_i], lds + (bufoff) + ldsw + _i * 8192); } while (0)
#define G8_LDA(dst, b, h) do { _Pragma("unroll") for (int m = 0; m < 4; ++m) _Pragma("unroll") for (int k = 0; k < 2; ++k) dst[m][k] = *(const G8_LAS bf16x8*)(lds + G8_SA(b, h) + aoff + m * 2048 + k * 1024); } while (0)
#define G8_LDB(dst, b, h) do { _Pragma("unroll") for (int n = 0; n < 2; ++n) _Pragma("unroll") for (int k = 0; k < 2; ++k) dst[n][k] = *(const G8_LAS bf16x8*)(lds + G8_SB(b, h) + boff + n * 2048 + k * 1024); } while (0)
#define G8_MMA(ai, bj, At, Bt) do { G8_PRIO(1); _Pragma("unroll") for (int m = 0; m < 4; ++m) _Pragma("unroll") for (int n = 0; n < 2; ++n) _Pragma("unroll") for (int k = 0; k < 2; ++k) \
        acc[ai][bj][m][n] = mfma16(Bt[n][k], At[m][k], acc[ai][bj][m][n]); G8_PRIO(0); } while (0)
    int pm, pn, npm = 0, npn = 0, ui = 0;
    if (!unit_of(c, nM, nN, pm, pn)) return;
    f32x4 acc[2][2][4][2];
#pragma unroll
    for (int a = 0; a < 2; ++a)
#pragma unroll
        for (int b = 0; b < 2; ++b)
#pragma unroll
            for (int m = 0; m < 4; ++m)
#pragma unroll
                for (int n = 0; n < 2; ++n) acc[a][b][m][n] = f32x4{0.f, 0.f, 0.f, 0.f};
    bf16x8 At[4][2], B0[2][2], B1[2][2];
    const char* const Ab = pr.a_base();
    unsigned ca0[2], ca1[2], na0[2], na1[2];
#pragma unroll
    for (int i = 0; i < 2; ++i) { ca0[i] = pr.a_off(pm, Rp[i]) + (unsigned)Cp[i] * 2u; ca1[i] = pr.a_off(pm, HALF + Rp[i]) + (unsigned)Cp[i] * 2u; na0[i] = ca0[i]; na1[i] = ca1[i]; }
    const char* cB = pr.b_base(pm, pn);
    G8_STAGE(G8_SB(0, 0), cB, voffB); G8_STAGE(G8_SA(0, 0), Ab, ca0); G8_STAGE(G8_SB(0, 1), cB + hstepB, voffB); G8_STAGE(G8_SA(0, 1), Ab, ca1);
    if (wr == 1) G8_BAR;
    G8_WAIT_V(4); G8_BAR;
    G8_STAGE(G8_SB(1, 0), cB + kstep, voffB); G8_STAGE(G8_SA(1, 0), Ab + kstep, ca0); G8_STAGE(G8_SB(1, 1), cB + hstepB + kstep, voffB);
    G8_WAIT_V(6); G8_BAR;
    for (;;) {
        const bool has_next = unit_of((ui + 1) * G + c, nM, nN, npm, npn);
        const char* nB = has_next ? pr.b_base(npm, npn) : cB;
        for (int t = 0; t < nt; t += 2) {
            const bool last = (t == nt - 2);
            if (last) {
                if (has_next) {
#pragma unroll
                    for (int i = 0; i < 2; ++i) { na0[i] = pr.a_off(npm, Rp[i]) + (unsigned)Cp[i] * 2u; na1[i] = pr.a_off(npm, HALF + Rp[i]) + (unsigned)Cp[i] * 2u; }
                } else {
#pragma unroll
                    for (int i = 0; i < 2; ++i) { na0[i] = ca0[i]; na1[i] = ca1[i]; }
                }
            }
            const char* a1 = Ab + (size_t)(t + 1) * kstep;
            const char* a2 = last ? Ab : Ab + (size_t)(t + 2) * kstep; const char* b2 = last ? nB : cB + (size_t)(t + 2) * kstep;
            const char* a3 = a2 + kstep; const char* b3 = b2 + kstep;
            G8_LDB(B0, 0, 0); G8_SCHED; G8_LDA(At, 0, 0); G8_STAGE(G8_SA(1, 1), a1, ca1);
            G8_WAIT_L(8); G8_BAR; G8_WAIT_L(0); G8_MMA(0, 0, At, B0); G8_BAR; G8_SCHED;
            G8_LDB(B1, 0, 1); G8_STAGE(G8_SB(0, 0), b2, voffB);
            G8_BAR; G8_WAIT_L(0); G8_MMA(0, 1, At, B1); G8_BAR;
            G8_LDA(At, 0, 1); if (last) { G8_STAGE(G8_SA(0, 0), a2, na0); } else { G8_STAGE(G8_SA(0, 0), a2, ca0); }
            G8_BAR; G8_WAIT_L(0); G8_MMA(1, 0, At, B0); G8_BAR; G8_SCHED;
            G8_STAGE(G8_SB(0, 1), b2 + hstepB, voffB);
            G8_WAIT_V(6); G8_BAR; G8_MMA(1, 1, At, B1); G8_BAR;
            G8_LDB(B0, 1, 0); G8_SCHED; G8_LDA(At, 1, 0); if (last) { G8_STAGE(G8_SA(0, 1), a2, na1); } else { G8_STAGE(G8_SA(0, 1), a2, ca1); }
            G8_WAIT_L(8); G8_BAR; G8_WAIT_L(0); G8_MMA(0, 0, At, B0); G8_BAR; G8_SCHED;
            G8_LDB(B1, 1, 1); G8_STAGE(G8_SB(1, 0), b3, voffB);
            G8_BAR; G8_WAIT_L(0); G8_MMA(0, 1, At, B1); G8_BAR;
            G8_LDA(At, 1, 1); if (last) { G8_STAGE(G8_SA(1, 0), a3, na0); } else { G8_STAGE(G8_SA(1, 0), a3, ca0); }
            G8_BAR; G8_WAIT_L(0); G8_MMA(1, 0, At, B0); G8_BAR; G8_SCHED;
            G8_STAGE(G8_SB(1, 1), b3 + hstepB, voffB);
            G8_WAIT_V(6); G8_BAR; G8_MMA(1, 1, At, B1); G8_BAR;
        }
        pr.epi(acc, pm, pn, wr, wc, fr, fq);
        if (!has_next) break;
#pragma unroll
        for (int a = 0; a < 2; ++a)
#pragma unroll
            for (int b = 0; b < 2; ++b)
#pragma unroll
                for (int m = 0; m < 4; ++m)
#pragma unroll
                    for (int n = 0; n < 2; ++n) acc[a][b][m][n] = f32x4{0.f, 0.f, 0.f, 0.f};
        pm = npm; pn = npn; cB = nB; ++ui;
#pragma unroll
        for (int i = 0; i < 2; ++i) { ca0[i] = na0[i]; ca1[i] = na1[i]; }
    }
    G8_WAIT_V(0);
    if (wr == 0) G8_BAR;
    G8_BAR;
#undef G8_SA
#undef G8_SB
#undef G8_STAGE
#undef G8_LDA
#undef G8_LDB
#undef G8_MMA
}
}

template <class RowMap>
__device__ __forceinline__ void cvt_tile(const float* src, int N, int K, int k0, int n0, bf16_t* dst, RowMap dst_row, int n_valid) {
    const int tid = opaque_tid(), n = n0 + (tid & 63), kg = tid >> 6;
    float v[8];
#pragma unroll
    for (int j = 0; j < 8; ++j) v[j] = (n < n_valid) ? src[(size_t)(k0 + kg * 8 + j) * N + n] : 0.f;
    U4 o; o.x = pack2(v[0], v[1]); o.y = pack2(v[2], v[3]); o.z = pack2(v[4], v[5]); o.w = pack2(v[6], v[7]);
    st16(dst + (size_t)dst_row(n) * K + k0 + kg * 8, o);
}
__device__ __forceinline__ int gu_row(int col, int is_up) { return (col >> 7) * 256 + is_up * 128 + (col & 127); }

template <class RowMap>
__device__ __forceinline__ void cvt_tile_lds(const float* src, int N, int K, int k0, int n0, bf16_t* dst, RowMap dst_row, unsigned char* smem) {
    constexpr int LD = 68;
    bf16_t* tile = reinterpret_cast<bf16_t*>(smem);
    const int tid = opaque_tid();
    {
        const int kp = tid >> 7, n = tid & 127;
        float a[8], b[8];
#pragma unroll
        for (int i = 0; i < 8; ++i) { const int k = 2 * (kp + 4 * i); a[i] = src[(size_t)(k0 + k) * N + n0 + n]; b[i] = src[(size_t)(k0 + k + 1) * N + n0 + n]; }
#pragma unroll
        for (int i = 0; i < 8; ++i) *reinterpret_cast<unsigned*>(tile + n * LD + 2 * (kp + 4 * i)) = pack2(a[i], b[i]);
    }
    __syncthreads();
    {
        const int n = tid >> 2, kq = tid & 3;
        const unsigned long long* rp = reinterpret_cast<const unsigned long long*>(tile + n * LD + kq * 16);
        const unsigned long long q0 = rp[0], q1 = rp[1], q2 = rp[2], q3 = rp[3];
        U4 o0, o1; o0.x = (unsigned)q0; o0.y = (unsigned)(q0 >> 32); o0.z = (unsigned)q1; o0.w = (unsigned)(q1 >> 32);
        o1.x = (unsigned)q2; o1.y = (unsigned)(q2 >> 32); o1.z = (unsigned)q3; o1.w = (unsigned)(q3 >> 32);
        bf16_t* d = dst + (size_t)dst_row(n0 + n) * K + k0 + kq * 16;
        st16(d, o0); st16(d + 8, o1);
    }
    __syncthreads();
}

constexpr int SCAN1_UNITS = 2 * BATCH * SSD_G * (SSD_HG / 2) + 2 * BATCH * MLSTM_HEADS * 2;
static_assert(WS_WDN >= WS_END1, "WS_WDN must not alias the layer-1 mixer buffers");
constexpr int CVT_T1 = (D_MODEL / 64) * (D_FF / 128);
constexpr int CVT_T2 = (D_FF / 64) * (D_MODEL / 128);
constexpr int CVT_NDN = N_EXPERTS * CVT_T2, CVT_NTOT = CVT_NDN + N_EXPERTS * 2 * CVT_T1;
template <int LAYER> __device__ void convert_expert_weights(const Params& p, int unit_begin, int unit_stride, unsigned char* smem, int v_lo, int v_hi) {
    bf16_t* wgu = reinterpret_cast<bf16_t*>(p.ws + WS_WGU); bf16_t* wdn = reinterpret_cast<bf16_t*>(p.ws + WS_WDN);
    constexpr int T1 = CVT_T1, T2 = CVT_T2;
    for (int v = v_lo + unit_begin; v < v_hi; v += unit_stride) {
        if (v >= CVT_NDN) {
            const int u = v - CVT_NDN, e = u / (2 * T1), r = u - e * (2 * T1);
            const int is_up = r / T1, t = r - is_up * T1, kt = t / (D_FF / 128), nt_ = t - kt * (D_FF / 128);
            const float* src = (is_up ? p.exp_w_up : p.exp_w_gate) + ((size_t)LAYER * N_EXPERTS + e) * D_MODEL * D_FF;
            cvt_tile_lds(src, D_FF, D_MODEL, kt * 64, nt_ * 128, wgu + (size_t)e * 2 * D_FF * D_MODEL,
                         [=](int n) { return gu_row(n, is_up); }, smem);
        } else {
            const int e = v / T2, t = v - e * T2, kt = t / (D_MODEL / 128), nt_ = t - kt * (D_MODEL / 128);
            const float* src = p.exp_w_down + ((size_t)LAYER * N_EXPERTS + e) * D_FF * D_MODEL;
            cvt_tile_lds(src, D_MODEL, D_FF, kt * 64, nt_ * 128, wdn + (size_t)e * D_MODEL * D_FF, [](int n) { return n; }, smem);
        }
    }
}

__device__ void phase_prologue(const Params& p, unsigned char* smem) {
    const int tid = opaque_tid(), bid = blockIdx.x, nb = gridDim.x;
    if (bid == 0) { int* cnt = reinterpret_cast<int*>(p.ws + WS_CNT); if (tid < 2 * N_EXPERTS) cnt[tid] = 0; }
    if (bid == (1 % nb)) {
        float* lb = reinterpret_cast<float*>(p.ws + WS_LB);
        for (int i = tid; i < HG_KW; i += NT) {
            float a0 = p.hgrn_lower_bounds[i], a1 = p.hgrn_lower_bounds[HG_KW + i], a2 = p.hgrn_lower_bounds[2 * HG_KW + i];
            float m = fmaxf(a0, fmaxf(a1, a2));
            float e0 = fexp(a0 - m), e1 = fexp(a1 - m), e2 = fexp(a2 - m);
            lb[i] = e0 / (e0 + e1 + e2);
        }
    }
    {
        float* mod = reinterpret_cast<float*>(p.ws + WS_MOD);
        float* sc = reinterpret_cast<float*>(smem);
        for (int i = tid; i < (BATCH + 1) * D_MODEL; i += NT) {
            int bb = i / D_MODEL, d = i - bb * D_MODEL;
            float v = bb < BATCH ? p.c[bb * D_MODEL + d] : p.c_ctx[d];
            sc[i] = siluf_(v);
        }
        __syncthreads();
        constexpr int NCOL = DEPTH * N_MOD * D_MODEL, KS = D_MODEL / 8;
        float* part = sc + (BATCH + 1) * D_MODEL;
        const int w8 = tid >> 6, ln = tid & 63;
        for (int u = bid; u < NCOL / 64; u += nb) {
            const int col = u * 64 + ln, l = col / (N_MOD * D_MODEL), j = col - l * (N_MOD * D_MODEL);
            const float* w = p.ada_w + (size_t)l * D_MODEL * N_MOD * D_MODEL + j;
            float acc[BATCH + 1];
#pragma unroll
            for (int bb = 0; bb <= BATCH; ++bb) acc[bb] = 0.f;
#pragma unroll 8
            for (int i = w8 * KS; i < (w8 + 1) * KS; ++i) {
                const float wv = w[(size_t)i * (N_MOD * D_MODEL)];
#pragma unroll
                for (int bb = 0; bb <= BATCH; ++bb) acc[bb] += sc[bb * D_MODEL + i] * wv;
            }
#pragma unroll
            for (int bb = 0; bb <= BATCH; ++bb) part[(w8 * (BATCH + 1) + bb) * 64 + ln] = acc[bb];
            __syncthreads();
            for (int o = tid; o < (BATCH + 1) * 64; o += NT) {
                const int bb = o >> 6, c = o & 63, cc = u * 64 + c, ll = cc / (N_MOD * D_MODEL), jj = cc - ll * (N_MOD * D_MODEL);
                float t = p.ada_b[ll * N_MOD * D_MODEL + jj];
#pragma unroll
                for (int q = 0; q < 8; ++q) t += part[(q * (BATCH + 1) + bb) * 64 + c];
                mod[((size_t)ll * (BATCH + 1) + bb) * (N_MOD * D_MODEL) + jj] = t;
            }
            __syncthreads();
        }
        __syncthreads();
    }
    {
        bf16_t* lrw = reinterpret_cast<bf16_t*>(p.ws + WS_LRW);
        constexpr int TOT = RWKV_W * (2 * RWKV_DR + 2 * RWKV_AR + RWKV_GR);
        for (int i = bid * NT + tid; i < TOT; i += nb * NT) {
            int kind, rem;
            if (i < 2 * RWKV_W * RWKV_DR) { kind = i / (RWKV_W * RWKV_DR); rem = i - kind * RWKV_W * RWKV_DR; }
            else if (i < 2 * RWKV_W * RWKV_DR + 2 * RWKV_W * RWKV_AR) { const int q = i - 2 * RWKV_W * RWKV_DR; kind = 2 + q / (RWKV_W * RWKV_AR); rem = q - (kind - 2) * RWKV_W * RWKV_AR; }
            else { kind = 4; rem = i - 2 * RWKV_W * RWKV_DR - 2 * RWKV_W * RWKV_AR; }
            const int rank = kind < 2 ? RWKV_DR : (kind < 4 ? RWKV_AR : RWKV_GR);
            const int c = rem / rank, r = rem - c * rank;
            const float* src = kind < 2 ? p.rwkv_w2 + (size_t)kind * RWKV_DR * RWKV_W : (kind < 4 ? p.rwkv_a2 + (size_t)(kind - 2) * RWKV_AR * RWKV_W : p.rwkv_g2);
            lrw[i] = f2bf(src[(size_t)r * RWKV_W + c]);
        }
    }
    {
        constexpr int KT = D_MODEL / 64;
        constexpr int U0 = KT * (EVEN_PROJ_PAD / 64), U1 = KT * (ODD_PROJ_PAD / 64);
        constexpr int U2 = (EVEN_OUT / 64) * (D_MODEL / 64), U3 = (ODD_OUT / 64) * (D_MODEL / 64);
        for (int u = bid; u < U0 + U1 + U2 + U3; u += nb) {
            if (u < U0) { int kt = u % KT, nt_ = u / KT; cvt_tile(p.even_w_in, EVEN_PROJ, D_MODEL, kt * 64, nt_ * 64, reinterpret_cast<bf16_t*>(p.ws + WS_WIN0), [](int n) { return n; }, EVEN_PROJ); }
            else if (u < U0 + U1) { int v = u - U0; int kt = v % KT, nt_ = v / KT; cvt_tile(p.odd_w_in, ODD_PROJ, D_MODEL, kt * 64, nt_ * 64, reinterpret_cast<bf16_t*>(p.ws + WS_WIN1), [](int n) { return n; }, ODD_PROJ); }
            else if (u < U0 + U1 + U2) { int v = u - U0 - U1; int kt = v % (EVEN_OUT / 64), nt_ = v / (EVEN_OUT / 64); cvt_tile(p.even_w_out, D_MODEL, EVEN_OUT, kt * 64, nt_ * 64, reinterpret_cast<bf16_t*>(p.ws + WS_WOUT0), [](int n) { return n; }, D_MODEL); }
            else { int v = u - U0 - U1 - U2; int kt = v % (ODD_OUT / 64), nt_ = v / (ODD_OUT / 64); cvt_tile(p.odd_w_out, D_MODEL, ODD_OUT, kt * 64, nt_ * 64, reinterpret_cast<bf16_t*>(p.ws + WS_WOUT1), [](int n) { return n; }, D_MODEL); }
        }
    }
}

template <int LAYER> __device__ void phase_norm1(const Params& p) {
    const int tid = opaque_tid(), lane = tid & 63, wv = (blockIdx.x * NT + tid) >> 6, nwv = gridDim.x * (NT / 64);
    const float* mod = reinterpret_cast<const float*>(p.ws + WS_MOD) + (size_t)LAYER * (BATCH + 1) * N_MOD * D_MODEL;
    const float* xc = LAYER == 0 ? p.ctx : reinterpret_cast<const float*>(p.ws + WS_XC);
    const float* xl = LAYER == 0 ? p.x : p.out;
    bf16_t* h = reinterpret_cast<bf16_t*>(p.ws + WS_H);
    const float* g = p.norm1_w + LAYER * D_MODEL;
    constexpr int NV = D_MODEL / 256;
    for (int row = wv; row < T_ALL; row += nwv) {
        const int b = row / LSEQ, s = row - b * LSEQ;
        const float* src; const float* md;
        if (s < CTX_LEN) { src = xc + ((size_t)b * CTX_LEN + s) * D_MODEL; md = mod + (size_t)BATCH * N_MOD * D_MODEL; }
        else { src = xl + ((size_t)b * SEQ + lat_nat<LAYER>(s - CTX_LEN)) * D_MODEL; md = mod + (size_t)b * N_MOD * D_MODEL; }
        F4 v[NV]; float ss = 0.f;
#pragma unroll
        for (int i = 0; i < NV; ++i) { v[i] = ldf4(src + i * 256 + lane * 4); ss += v[i].x * v[i].x + v[i].y * v[i].y + v[i].z * v[i].z + v[i].w * v[i].w; }
        ss = wave_sum(ss);
        const float rs = rsqrtf(ss * (1.0f / D_MODEL) + EPS);
#pragma unroll
        for (int i = 0; i < NV; ++i) {
            const int c = i * 256 + lane * 4;
            F4 gg = ldf4(g + c), m0 = ldf4(md + c), m1 = ldf4(md + D_MODEL + c);
            float o0 = v[i].x * rs * gg.x * (1.f + m1.x) + m0.x, o1 = v[i].y * rs * gg.y * (1.f + m1.y) + m0.y;
            float o2 = v[i].z * rs * gg.z * (1.f + m1.z) + m0.z, o3 = v[i].w * rs * gg.w * (1.f + m1.w) + m0.w;
            unsigned* dst = reinterpret_cast<unsigned*>(h + (size_t)row * D_MODEL + c);
            dst[0] = pack2(o0, o1); dst[1] = pack2(o2, o3);
        }
    }
}

constexpr int PREP_TOK = 64;
constexpr int LR_K[5] = {RWKV_DR, RWKV_DR, RWKV_AR, RWKV_AR, RWKV_GR};
constexpr int LR_OFF[5] = {0, RWKV_DR, 2 * RWKV_DR, 2 * RWKV_DR + RWKV_AR, 2 * RWKV_DR + 2 * RWKV_AR};
constexpr int LR_WOFF[5] = {0, RWKV_W * RWKV_DR, 2 * RWKV_W * RWKV_DR, 2 * RWKV_W * RWKV_DR + RWKV_W * RWKV_AR, 2 * RWKV_W * RWKV_DR + 2 * RWKV_W * RWKV_AR};
__device__ void hgrn_unit(const Params& p, unsigned char* smem, int u);
__device__ void phase_prep0(const Params& p, unsigned char* smem) {
    constexpr int NU_H = 2 * BATCH * HGRN_HEADS;
    const int nb = gridDim.x, bid = blockIdx.x;
    const bool split = nb > NU_H;
    const int hu_first = bid, hu_stride = split ? nb : nb, hu_end = split ? (bid < NU_H ? bid + 1 : 0) : NU_H;
    const int u_first = split ? (bid < NU_H ? (T_ALL / PREP_TOK) : bid - NU_H) : bid, u_stride = split ? nb - NU_H : nb;
#pragma unroll 1
    for (int u = hu_first; u < hu_end; u += hu_stride) { for (int rep = 0; rep < PROBE_REPS_B; ++rep) { hgrn_unit(p, smem, u); __syncthreads(); } }
    constexpr int W = RWKV_W, NP = EVEN_PROJ_PAD, NACT = 2 * RWKV_DR + 2 * RWKV_AR + RWKV_GR;
    constexpr int ALD = NACT + 8;
    constexpr int NG = RWKV_PROJ / 8;
    static_assert(RWKV_PROJ % 8 == 0 && W % 64 == 0, "prep0 layout");
    const bf16_t* P = reinterpret_cast<const bf16_t*>(p.ws + WS_P);
    bf16_t* AUX = reinterpret_cast<bf16_t*>(p.ws + WS_AUX0);
    const bf16_t* LRW = reinterpret_cast<const bf16_t*>(p.ws + WS_LRW);
    bf16_t* act = reinterpret_cast<bf16_t*>(smem);
    const int tid = opaque_tid(), wid = tid >> 6, lane = tid & 63, fr = lane & 15, fq = lane >> 4;
    for (int rep0 = 0; rep0 < PROBE_PREP0; ++rep0)
    for (int u = u_first; u < T_ALL / PREP_TOK; u += u_stride) {
        const int row0 = u * PREP_TOK;
        constexpr int PF = 5, NITEM = PREP_TOK * NG;
        static_assert(NITEM % (NT * PF) == 0 || true, "");
#pragma unroll 1
        for (int base = tid; base < NITEM; base += NT * PF) {
            U4 cu[PF], pv[PF], nx[PF]; F4 m0[PF], m1[PF];
#pragma unroll
            for (int k = 0; k < PF; ++k) {
                const int idx = base + k * NT;
                cu[k] = U4{0u, 0u, 0u, 0u}; pv[k] = cu[k]; nx[k] = cu[k]; m0[k] = F4{0.f, 0.f, 0.f, 0.f}; m1[k] = m0[k];
                if (idx < NITEM) {
                    const int t = idx / NG, col = (idx - t * NG) * 8, row = row0 + t;
                    const int sq = row % LSEQ;
                    const bool has_prev = (sq != 0) && (sq != CTX_LEN), has_next = (sq != CTX_LEN - 1) && (sq != LSEQ - 1);
                    cu[k] = ld16(P + (size_t)row * NP + col);
                    if (has_prev) pv[k] = ld16(P + (size_t)(row - 1) * NP + col);
                    if (has_next) nx[k] = ld16(P + (size_t)(row + 1) * NP + col);
                    m0[k] = ldf4(p.rwkv_mu + col); m1[k] = ldf4(p.rwkv_mu + col + 4);
                }
            }
#pragma unroll
            for (int k = 0; k < PF; ++k) {
                const int idx = base + k * NT;
                if (idx < NITEM) {
                    const int t = idx / NG, col = (idx - t * NG) * 8, row = row0 + t;
                    const unsigned cw[4] = {cu[k].x, cu[k].y, cu[k].z, cu[k].w}, pw[4] = {pv[k].x, pv[k].y, pv[k].z, pv[k].w}, nw[4] = {nx[k].x, nx[k].y, nx[k].z, nx[k].w};
                    const float mu[8] = {m0[k].x, m0[k].y, m0[k].z, m0[k].w, m1[k].x, m1[k].y, m1[k].z, m1[k].w};
                    float mx[8];
#pragma unroll
                    for (int q = 0; q < 4; ++q) {
                        const float c0 = lo2f(cw[q]), c1 = hi2f(cw[q]);
                        mx[2 * q] = c0 + (0.5f * (lo2f(pw[q]) + lo2f(nw[q])) - c0) * mu[2 * q];
                        mx[2 * q + 1] = c1 + (0.5f * (hi2f(pw[q]) + hi2f(nw[q])) - c1) * mu[2 * q + 1];
                    }
                    if (col < 3 * W) {
                        st16(AUX + (size_t)row * AUX0_W + col, pack8f(mx));
                    } else {
                        const int a = col - 3 * W;
#pragma unroll
                        for (int q = 0; q < 8; ++q) {
                            if (a < 2 * RWKV_DR) mx[q] = 2.f * sigmoidf_(2.f * mx[q]) - 1.f;
                            else if (a >= 2 * RWKV_DR + 2 * RWKV_AR) mx[q] = sigmoidf_(mx[q]);
                        }
                        st16(act + t * ALD + a, pack8f(mx));
                    }
                }
            }
        }
        __syncthreads();
#pragma unroll 1
        for (int ct = wid; ct < W / 16; ct += NT / 64) {
#pragma unroll
            for (int kind = 0; kind < 5; ++kind) {
#ifndef EMU
                __builtin_amdgcn_sched_barrier(0);
#endif
                f32x4 acc[4];
#pragma unroll
                for (int m = 0; m < 4; ++m) acc[m] = f32x4{0.f, 0.f, 0.f, 0.f};
#pragma unroll
                for (int ks = 0; ks < LR_K[kind] / 32; ++ks) {
                    const bf16x8 wf = *reinterpret_cast<const bf16x8*>(LRW + LR_WOFF[kind] + (size_t)(ct * 16 + fr) * LR_K[kind] + ks * 32 + fq * 8);
#pragma unroll
                    for (int m = 0; m < 4; ++m) {
                        const bf16x8 af = *reinterpret_cast<const bf16x8*>(act + (m * 16 + fr) * ALD + LR_OFF[kind] + ks * 32 + fq * 8);
                        acc[m] = mfma16(wf, af, acc[m]);
                    }
                }
                const int c0 = ct * 16 + fq * 4;
                float bias[4] = {0.f, 0.f, 0.f, 0.f};
                if (kind < 2) { const F4 b = ldf4(p.rwkv_w0 + kind * W + c0); bias[0] = b.x; bias[1] = b.y; bias[2] = b.z; bias[3] = b.w; }
                else if (kind < 4) { const F4 b = ldf4(p.rwkv_a0 + (kind - 2) * W + c0); bias[0] = b.x; bias[1] = b.y; bias[2] = b.z; bias[3] = b.w; }
#pragma unroll
                for (int m = 0; m < 4; ++m) {
                    float o[4];
#pragma unroll
                    for (int j = 0; j < 4; ++j) {
                        const float v = acc[m][j] + bias[j];
                        if (kind < 2) o[j] = -0.6065306597126334f * sigmoidf_(v);
                        else if (kind < 4) o[j] = sigmoidf_(v);
                        else o[j] = v;
                    }
                    unsigned* dst = reinterpret_cast<unsigned*>(AUX + (size_t)(row0 + m * 16 + fr) * AUX0_W + (3 + kind) * W + c0);
                    dst[0] = pack2(o[0], o[1]); dst[1] = pack2(o[2], o[3]);
                }
            }
        }
        __syncthreads();
    }
    if (split) { if (bid >= NU_H) convert_expert_weights<0>(p, bid - NU_H, nb - NU_H, smem, 0, CVT_NTOT); }
    else convert_expert_weights<0>(p, bid, nb, smem, 0, CVT_NTOT);
}


__device__ __forceinline__ U4 scale8(U4 v, float s) {
    U4 o; o.x = pack2(lo2f(v.x) * s, hi2f(v.x) * s); o.y = pack2(lo2f(v.y) * s, hi2f(v.y) * s);
    o.z = pack2(lo2f(v.z) * s, hi2f(v.z) * s); o.w = pack2(lo2f(v.w) * s, hi2f(v.w) * s); return o;
}
__device__ __forceinline__ U4 gather8(const bf16_t* base, int ld) {
    unsigned v[8];
#pragma unroll
    for (int i = 0; i < 8; ++i) v[i] = base[i * ld];
    U4 o; o.x = v[0] | (v[1] << 16); o.y = v[2] | (v[3] << 16); o.z = v[4] | (v[5] << 16); o.w = v[6] | (v[7] << 16); return o;
}
template <int CTRL> __device__ __forceinline__ float dpp_f(float v) {
#ifdef EMU
    auto r = emu_wave_exchange(&v, 4); const int l = emu_cur->lane; int s;
    if (CTRL == 0xB1) s = l ^ 1; else if (CTRL == 0x4E) s = l ^ 2; else if (CTRL == 0x1B) s = l ^ 3; else if (CTRL == 0x141) s = (l & ~7) | (7 - (l & 7));
    else if (CTRL == 0x128) s = l ^ 8; else s = (l & ~15) | (15 - (l & 15));
    float o; memcpy(&o, r[s], 4); return o;
#else
    return __builtin_bit_cast(float, __builtin_amdgcn_update_dpp(0, __builtin_bit_cast(int, v), CTRL, 0xF, 0xF, true));
#endif
}
__device__ __forceinline__ float sum8(float v) { v += dpp_f<0xB1>(v); v += dpp_f<0x4E>(v); v += dpp_f<0x141>(v); return v; }
__device__ __forceinline__ float sum16(float v) {
    const float q = (v + dpp_f<0xB1>(v)) + (dpp_f<0x4E>(v) + dpp_f<0x1B>(v));
    return (q + dpp_f<0x141>(q)) + (dpp_f<0x140>(q) + dpp_f<0x128>(q));
}

template <int GV> __device__ __forceinline__ float group_sum_v(float v) {
    static_assert(GV == 8 || GV == 16 || GV == 32 || GV == 64, "group size");
    if (GV == 8) return sum8(v);
    v = sum16(v);
    if (GV >= 32) v += __shfl_xor(v, 16, 64);
    if (GV >= 64) v += __shfl_xor(v, 32, 64);
    return v;
}
template <bool DRY> __device__ __forceinline__ void finish0_hgrn_row(const Params& p, int row, int lane) {
    constexpr int W = RWKV_W, NP = EVEN_PROJ_PAD, NVH = HG_VW / 8;
    const bf16_t* P = reinterpret_cast<const bf16_t*>(p.ws + WS_P);
    bf16_t* O0 = reinterpret_cast<bf16_t*>(p.ws + WS_O0);
    const bf16_t* O1 = O0 + (size_t)T_ALL * OW0;
    const bool acth = lane < NVH; const int ch = (acth ? lane : 0) * 8;
    float hw[8]; ldf8(p.hgrn_norm_w + ch, hw);
    bf16_t* o0 = O0 + (size_t)row * OW0; const bf16_t* o1 = O1 + (size_t)row * OW0;
    const U4 h0 = ld16(o0 + W + ch), h1 = ld16(o1 + W + ch), hg = ld16(P + (size_t)row * NP + RWKV_PROJ + 3 * HG_KW + HG_VW + ch);
    float x0[8], x1[8], g[8], o[8];
    unpack8(h0, x0); unpack8(h1, x1); unpack8(hg, g);
    float ss = 0.f;
#pragma unroll
    for (int i = 0; i < 8; ++i) { o[i] = x0[i] + x1[i]; ss += o[i] * o[i]; }
    ss = group_sum_v<HG_DV / 8>(acth ? ss : 0.f) * (1.f / HG_DV);
    const float rs = rsqrtf(ss + EPS);
    float y[8];
#pragma unroll
    for (int i = 0; i < 8; ++i) y[i] = o[i] * rs * hw[i] * siluf_(g[i]);
    if (acth) { if (DRY) { sink(y[0]); sink(y[7]); } else st16(o0 + W + ch, pack8f(y)); }
}
constexpr int RW_NB = LSEQ / 64;
constexpr int RW_NU = 2 * BATCH * RWKV_HEADS * 2;
constexpr int FIN_RPS = (T_ALL + RW_NB * RW_NU * 4 - 1) / (RW_NB * RW_NU * 4);

typedef float f32x2 __attribute__((ext_vector_type(2)));
struct V2x4 { f32x2 v[4]; };
__device__ __forceinline__ V2x4 ldv8(const float* p) {
    const F4 a = *reinterpret_cast<const F4*>(p), b = *reinterpret_cast<const F4*>(p + 4);
    V2x4 r; r.v[0] = f32x2{a.x, a.y}; r.v[1] = f32x2{a.z, a.w}; r.v[2] = f32x2{b.x, b.y}; r.v[3] = f32x2{b.z, b.w}; return r;
}
constexpr int RW_TB = 64;
__device__ void rwkv_unit(const Params& p, unsigned char* smem, int u) {
    constexpr int W = RWKV_W;
    const int half = u & 1, uu = u >> 1;
    const int dir = uu / (BATCH * RWKV_HEADS), b = (uu / RWKV_HEADS) % BATCH, h = uu % RWKV_HEADS;
    const int tid = opaque_tid(), rl = (tid >> 3) & 31, kq = tid & 7;
    const int si = tid >> 3, part = tid & 7;
    const bf16_t* AUX = reinterpret_cast<const bf16_t*>(p.ws + WS_AUX0);
    bf16_t* O = reinterpret_cast<bf16_t*>(p.ws + WS_O0) + (size_t)dir * T_ALL * OW0;
    float* srec = reinterpret_cast<float*>(smem);
    float* sv = srec + RW_TB * 320; float* so = sv + RW_TB * 64;
    float* sdummy = so + RW_TB * 64; const int t2d = tid & 255;
    f32x2 S2[4];
#pragma unroll
    for (int j = 0; j < 4; ++j) S2[j] = f32x2{0.f, 0.f};
    const int ch0 = h * 64 + part * 8;
    float kkg[8], kag[8];
    { const F4 a = ldf4(p.rwkv_k_k + ch0), c = ldf4(p.rwkv_k_k + ch0 + 4), d = ldf4(p.rwkv_k_a + ch0), e = ldf4(p.rwkv_k_a + ch0 + 4);
      kkg[0] = a.x; kkg[1] = a.y; kkg[2] = a.z; kkg[3] = a.w; kkg[4] = c.x; kkg[5] = c.y; kkg[6] = c.z; kkg[7] = c.w;
      kag[0] = d.x; kag[1] = d.y; kag[2] = d.z; kag[3] = d.w; kag[4] = e.x; kag[5] = e.y; kag[6] = e.z; kag[7] = e.w; }
    U4 raw[5];
    {
        const bf16_t* a = AUX + ((size_t)b * LSEQ + step_pos(dir, si)) * AUX0_W + ch0;
        raw[0] = ld16(a); raw[1] = ld16(a + W); raw[2] = ld16(a + 2 * W); raw[3] = ld16(a + (3 + dir) * W); raw[4] = ld16(a + (5 + dir) * W);
    }
    for (int j0 = 0; j0 < LSEQ; j0 += RW_TB) {
        {
            const unsigned rr[4] = {raw[0].x, raw[0].y, raw[0].z, raw[0].w}, kr[4] = {raw[1].x, raw[1].y, raw[1].z, raw[1].w}, vr[4] = {raw[2].x, raw[2].y, raw[2].z, raw[2].w};
            const unsigned wr_[4] = {raw[3].x, raw[3].y, raw[3].z, raw[3].w}, ar[4] = {raw[4].x, raw[4].y, raw[4].z, raw[4].w};
            float r[8], k[8], v[8], lw[8], av[8], kk[8];
            float nrm = 0.f;
#pragma unroll
            for (int q = 0; q < 4; ++q) {
                r[2 * q] = lo2f(rr[q]); r[2 * q + 1] = hi2f(rr[q]); k[2 * q] = lo2f(kr[q]); k[2 * q + 1] = hi2f(kr[q]);
                v[2 * q] = lo2f(vr[q]); v[2 * q + 1] = hi2f(vr[q]); lw[2 * q] = lo2f(wr_[q]); lw[2 * q + 1] = hi2f(wr_[q]);
                av[2 * q] = lo2f(ar[q]); av[2 * q + 1] = hi2f(ar[q]);
            }
#pragma unroll
            for (int j = 0; j < 8; ++j) { kk[j] = k[j] * kkg[j]; nrm += kk[j] * kk[j]; }
            nrm = sum8(nrm);
            const float rn = rsqrtf(nrm + 1e-12f);
            const int o = si * 320 + part * 8, ov = si * 64 + part * 8;
#pragma unroll
            for (int hq = 0; hq < 2; ++hq) {
                F4 t;
                t.x = fexp(lw[4 * hq]); t.y = fexp(lw[4 * hq + 1]); t.z = fexp(lw[4 * hq + 2]); t.w = fexp(lw[4 * hq + 3]);
                *reinterpret_cast<F4*>(srec + o + 4 * hq) = t;
                t.x = k[4 * hq] * (1.f + (av[4 * hq] - 1.f) * kag[4 * hq]); t.y = k[4 * hq + 1] * (1.f + (av[4 * hq + 1] - 1.f) * kag[4 * hq + 1]);
                t.z = k[4 * hq + 2] * (1.f + (av[4 * hq + 2] - 1.f) * kag[4 * hq + 2]); t.w = k[4 * hq + 3] * (1.f + (av[4 * hq + 3] - 1.f) * kag[4 * hq + 3]);
                *reinterpret_cast<F4*>(srec + o + 64 + 4 * hq) = t;
                F4 kn; kn.x = kk[4 * hq] * rn; kn.y = kk[4 * hq + 1] * rn; kn.z = kk[4 * hq + 2] * rn; kn.w = kk[4 * hq + 3] * rn;
                *reinterpret_cast<F4*>(srec + o + 128 + 4 * hq) = kn;
                t.x = kn.x * av[4 * hq]; t.y = kn.y * av[4 * hq + 1]; t.z = kn.z * av[4 * hq + 2]; t.w = kn.w * av[4 * hq + 3];
                *reinterpret_cast<F4*>(srec + o + 192 + 4 * hq) = t;
                t.x = r[4 * hq]; t.y = r[4 * hq + 1]; t.z = r[4 * hq + 2]; t.w = r[4 * hq + 3];
                *reinterpret_cast<F4*>(srec + o + 256 + 4 * hq) = t;
                t.x = v[4 * hq]; t.y = v[4 * hq + 1]; t.z = v[4 * hq + 2]; t.w = v[4 * hq + 3];
                *reinterpret_cast<F4*>(sv + ov + 4 * hq) = t;
            }
        }
        lds_barrier();
        if (j0 + RW_TB < LSEQ) {
            const bf16_t* a = AUX + ((size_t)b * LSEQ + step_pos(dir, j0 + RW_TB + si)) * AUX0_W + ch0;
            raw[0] = ld16(a); raw[1] = ld16(a + W); raw[2] = ld16(a + 2 * W); raw[3] = ld16(a + (3 + dir) * W); raw[4] = ld16(a + (5 + dir) * W);
        }
        if (tid < 256) {
            const int base0 = kq * 8;
            V2x4 kkc = ldv8(srec + base0 + 128), wc = ldv8(srec + base0), bc = ldv8(srec + base0 + 192), kc = ldv8(srec + base0 + 64), rc = ldv8(srec + base0 + 256);
            float v0 = sv[32 * half + rl];
#pragma unroll 2
            for (int i = 0; i < RW_TB; ++i) {
                const int i1 = (i + 1 < RW_TB ? i + 1 : i);
                const float* rn_ = srec + i1 * 320 + base0;
                const V2x4 nkk = ldv8(rn_ + 128), nw = ldv8(rn_), nbb = ldv8(rn_ + 192), nk = ldv8(rn_ + 64), nr = ldv8(rn_ + 256);
                const float nv0 = sv[i1 * 64 + 32 * half + rl];
                f32x2 t = S2[0] * kkc.v[0]; t = S2[1] * kkc.v[1] + t; t = S2[2] * kkc.v[2] + t; t = S2[3] * kkc.v[3] + t;
                const float sa = sum8(t.x + t.y);
                const f32x2 sav = f32x2{sa, sa}, vv = f32x2{v0, v0};
#pragma unroll
                for (int q = 0; q < 4; ++q) { f32x2 u2 = S2[q] * wc.v[q]; u2 = u2 - sav * bc.v[q]; S2[q] = vv * kc.v[q] + u2; }
                f32x2 o2 = S2[0] * rc.v[0]; o2 = S2[1] * rc.v[1] + o2; o2 = S2[2] * rc.v[2] + o2; o2 = S2[3] * rc.v[3] + o2;
                const float o0 = sum8(o2.x + o2.y);
                *((kq == 0) ? (so + i * 32 + rl) : (sdummy + t2d)) = o0;
                kkc = nkk; wc = nw; bc = nbb; kc = nk; rc = nr; v0 = nv0;
            }
        } else {
            const int slot = ((j0 / RW_TB) * RW_NU + u) * 4 + ((tid >> 6) - 4);
#pragma unroll 1
            for (int q = 0; q < FIN_RPS; ++q) { const int row = slot * FIN_RPS + q; if (row < T_ALL) finish0_hgrn_row<false>(p, row, tid & 63); }
        }
        lds_barrier();
        if (part < 4) {
            const size_t rowg = (size_t)b * LSEQ + step_pos(dir, j0 + si);
            const F4 a = *reinterpret_cast<const F4*>(so + si * 32 + part * 8), c = *reinterpret_cast<const F4*>(so + si * 32 + part * 8 + 4);
            U4 o; o.x = pack2(a.x, a.y); o.y = pack2(a.z, a.w); o.z = pack2(c.x, c.y); o.w = pack2(c.z, c.w);
            st16(O + rowg * OW0 + h * 64 + 32 * half + part * 8, o);
        }
    }
    lds_barrier();
}

__device__ void hgrn_unit(const Params& p, unsigned char* smem, int u) {
    constexpr int NP = EVEN_PROJ_PAD, CH = HG_CH, LDK = 136, LDC = 40;
    const int dir = u / (BATCH * HGRN_HEADS), b = (u / HGRN_HEADS) % BATCH, h = u % HGRN_HEADS;
    const int tid = opaque_tid(), wid = tid >> 6, lane = tid & 63, fr = lane & 15, fq = lane >> 4;
    const bf16_t* P = reinterpret_cast<const bf16_t*>(p.ws + WS_P);
    const float* lb = reinterpret_cast<const float*>(p.ws + WS_LB);
    bf16_t* O = reinterpret_cast<bf16_t*>(p.ws + WS_O0) + (size_t)dir * T_ALL * OW0;
    float* lfS = reinterpret_cast<float*>(smem);
    bf16_t* qsS = reinterpret_cast<bf16_t*>(lfS + CH * 128);
    bf16_t* kfS = qsS + CH * LDK;
    bf16_t* vS = kfS + CH * LDK;
    bf16_t* qin = vS + CH * LDK;
    bf16_t* kin = qin + CH * LDK;
    bf16_t* kendT = kin + CH * LDK;
    bf16_t* vT = kendT + 128 * LDC;
    float* eblast = reinterpret_cast<float*>(vT + 128 * LDC);
    f32x4 S[8];
#pragma unroll
    for (int n = 0; n < 8; ++n) S[n] = f32x4{0.f, 0.f, 0.f, 0.f};
    const int lt = tid >> 4, lc = (tid & 15) * 8;
    float lbv[8];
    { const F4 a = ldf4(lb + h * 128 + lc), c = ldf4(lb + h * 128 + lc + 4); lbv[0] = a.x; lbv[1] = a.y; lbv[2] = a.z; lbv[3] = a.w; lbv[4] = c.x; lbv[5] = c.y; lbv[6] = c.z; lbv[7] = c.w; }
    struct Regs { U4 rq, rf, rv; };
    Regs setA, setB;
    auto issue = [&](Regs& r, int j0) {
        const bf16_t* pr = P + ((size_t)b * LSEQ + step_pos(dir, j0 + lt)) * NP + RWKV_PROJ + h * 128 + lc;
        r.rq = ld16(pr); r.rf = ld16(pr + HG_KW + dir * HG_KW); r.rv = ld16(pr + 3 * HG_KW);
    };
    issue(setA, 0); issue(setB, CH);
    const int g = tid >> 7, d = tid & 127;
    static_assert((LSEQ / HG_CH) % 2 == 0, "even chunk count");
    auto chunk = [&](Regs& r, int j0) {
        const U4 rq = r.rq, rf = r.rf, rv = r.rv;
        for (int repA = 0; repA < PROBE_HG_A; ++repA) {
            #ifndef EMU
            if (PROBE_HG_A > 1) { asm volatile("" ::: "memory"); }
#endif
            const unsigned qw[4] = {rq.x, rq.y, rq.z, rq.w}, fw[4] = {rf.x, rf.y, rf.z, rf.w};
            float lf[8], kf[8], qs[8];
#pragma unroll
            for (int q = 0; q < 4; ++q) {
#pragma unroll
                for (int e = 0; e < 2; ++e) {
                    const int i = 2 * q + e;
                    const float fv = e ? hi2f(fw[q]) : lo2f(fw[q]), qv = e ? hi2f(qw[q]) : lo2f(qw[q]);
                    const float sg = sigmoidf_(fv);
                    lf[i] = flog(lbv[i] + (1.f - lbv[i]) * sg); kf[i] = (1.f - lbv[i]) * (1.f - sg);
                    qs[i] = siluf_(qv) * 0.08838834764831845f;
                }
            }
            F4 t0, t1; t0.x = lf[0]; t0.y = lf[1]; t0.z = lf[2]; t0.w = lf[3]; t1.x = lf[4]; t1.y = lf[5]; t1.z = lf[6]; t1.w = lf[7];
            *reinterpret_cast<F4*>(lfS + lt * 128 + lc) = t0; *reinterpret_cast<F4*>(lfS + lt * 128 + lc + 4) = t1;
            U4 o; o.x = pack2(qs[0], qs[1]); o.y = pack2(qs[2], qs[3]); o.z = pack2(qs[4], qs[5]); o.w = pack2(qs[6], qs[7]);
            st16(qsS + lt * LDK + lc, o);
            o.x = pack2(kf[0], kf[1]); o.y = pack2(kf[2], kf[3]); o.z = pack2(kf[4], kf[5]); o.w = pack2(kf[6], kf[7]);
            st16(kfS + lt * LDK + lc, o);
            st16(vS + lt * LDK + lc, rv);
        }
        lds_barrier();
        if (j0 + 2 * CH < LSEQ) issue(r, j0 + 2 * CH);
        for (int repB = 0; repB < PROBE_HG_B; ++repB) {
            float off = 0.f, bl = 0.f, cs[8];
#pragma unroll
            for (int t = 0; t < CH; ++t) {
                const float v = lfS[t * 128 + d];
                if (t < 8 * g) off += v;
                bl += v;
            }
            float run = off;
#pragma unroll
            for (int tt = 0; tt < 8; ++tt) { run += lfS[(8 * g + tt) * 128 + d]; cs[tt] = run; }
            const U4 kf8 = gather8(kfS + (8 * g) * LDK + d, LDK), qs8 = gather8(qsS + (8 * g) * LDK + d, LDK), v8 = gather8(vS + (8 * g) * LDK + d, LDK);
            const unsigned kw[4] = {kf8.x, kf8.y, kf8.z, kf8.w}, qw[4] = {qs8.x, qs8.y, qs8.z, qs8.w};
            float ke[8];
#pragma unroll
            for (int tt = 0; tt < 8; ++tt) {
                const float kfv = (tt & 1) ? hi2f(kw[tt >> 1]) : lo2f(kw[tt >> 1]), qsv = (tt & 1) ? hi2f(qw[tt >> 1]) : lo2f(qw[tt >> 1]);
                qin[(8 * g + tt) * LDK + d] = f2bf(qsv * fexp(cs[tt]));
                kin[(8 * g + tt) * LDK + d] = f2bf(kfv * fexp(-cs[tt]));
                ke[tt] = kfv * fexp(bl - cs[tt]);
            }
            U4 o; o.x = pack2(ke[0], ke[1]); o.y = pack2(ke[2], ke[3]); o.z = pack2(ke[4], ke[5]); o.w = pack2(ke[6], ke[7]);
            st16(kendT + d * LDC + 8 * g, o);
            st16(vT + d * LDC + 8 * g, v8);
            if (g == 0) eblast[d] = fexp(bl);
        }
        lds_barrier();
        bf16x8 fk0[4], fk1[4];
#pragma unroll
        for (int ks = 0; ks < 4; ++ks) {
            fk0[ks] = *reinterpret_cast<const bf16x8*>(kin + (fr) * LDK + ks * 32 + fq * 8);
            fk1[ks] = *reinterpret_cast<const bf16x8*>(kin + (16 + fr) * LDK + ks * 32 + fq * 8);
        }
        for (int repC = 0; repC < PROBE_HG_C; ++repC)
#pragma unroll
        for (int ti = 0; ti < 2; ++ti) {
#ifndef EMU
            if (PROBE_HG_C > 1) { asm volatile("" ::: "memory"); }
#endif
            f32x4 a0 = f32x4{0.f, 0.f, 0.f, 0.f}, a1 = f32x4{0.f, 0.f, 0.f, 0.f};
#pragma unroll
            for (int ks = 0; ks < 4; ++ks) {
                const bf16x8 fq_ = *reinterpret_cast<const bf16x8*>(qin + (ti * 16 + fr) * LDK + ks * 32 + fq * 8);
                a0 = mfma16(fk0[ks], fq_, a0);
                a1 = mfma16(fk1[ks], fq_, a1);
            }
            const int t = ti * 16 + fr, s0 = fq * 4;
            U4 au;
            au.x = pack2(s0 <= t ? a0[0] : 0.f, s0 + 1 <= t ? a0[1] : 0.f); au.y = pack2(s0 + 2 <= t ? a0[2] : 0.f, s0 + 3 <= t ? a0[3] : 0.f);
            au.z = pack2(s0 + 16 <= t ? a1[0] : 0.f, s0 + 17 <= t ? a1[1] : 0.f); au.w = pack2(s0 + 18 <= t ? a1[2] : 0.f, s0 + 19 <= t ? a1[3] : 0.f);
            const bf16x8 af = __builtin_bit_cast(bf16x8, au);
            const unsigned long long v0 = *reinterpret_cast<const unsigned long long*>(vT + (wid * 16 + fr) * LDC + 4 * fq);
            const unsigned long long v1 = *reinterpret_cast<const unsigned long long*>(vT + (wid * 16 + fr) * LDC + 16 + 4 * fq);
            U4 vu; vu.x = (unsigned)v0; vu.y = (unsigned)(v0 >> 32); vu.z = (unsigned)v1; vu.w = (unsigned)(v1 >> 32);
            f32x4 oa = f32x4{0.f, 0.f, 0.f, 0.f};
            oa = mfma16(__builtin_bit_cast(bf16x8, vu), af, oa);
#pragma unroll
            for (int ks = 0; ks < 4; ++ks) {
                U4 su; su.x = pack2(S[2 * ks][0], S[2 * ks][1]); su.y = pack2(S[2 * ks][2], S[2 * ks][3]);
                su.z = pack2(S[2 * ks + 1][0], S[2 * ks + 1][1]); su.w = pack2(S[2 * ks + 1][2], S[2 * ks + 1][3]);
                const unsigned long long q0 = *reinterpret_cast<const unsigned long long*>(qin + (ti * 16 + fr) * LDK + ks * 32 + 4 * fq);
                const unsigned long long q1 = *reinterpret_cast<const unsigned long long*>(qin + (ti * 16 + fr) * LDK + ks * 32 + 16 + 4 * fq);
                U4 qu; qu.x = (unsigned)q0; qu.y = (unsigned)(q0 >> 32); qu.z = (unsigned)q1; qu.w = (unsigned)(q1 >> 32);
                oa = mfma16(__builtin_bit_cast(bf16x8, su), __builtin_bit_cast(bf16x8, qu), oa);
            }
            const size_t rowg = (size_t)b * LSEQ + step_pos(dir, j0 + t);
            unsigned* dst = reinterpret_cast<unsigned*>(O + rowg * OW0 + RWKV_W + h * 128 + wid * 16 + fq * 4);
            dst[0] = pack2(oa[0], oa[1]); dst[1] = pack2(oa[2], oa[3]);
        }
        {
            bf16x8 fv = *reinterpret_cast<const bf16x8*>(vT + (wid * 16 + fr) * LDC + fq * 8);
#pragma unroll
            for (int n = 0; n < 8; ++n) {
                const F4 e = ldf4(eblast + n * 16 + fq * 4);
                f32x4 c = S[n]; c[0] *= e.x; c[1] *= e.y; c[2] *= e.z; c[3] *= e.w;
                bf16x8 fk = *reinterpret_cast<const bf16x8*>(kendT + (n * 16 + fr) * LDC + fq * 8);
                S[n] = mfma16(fk, fv, c);
            }
        }
        lds_barrier();
    };
#pragma unroll 1
    for (int j0 = 0; j0 < LSEQ; j0 += 2 * CH) { chunk(setA, j0); chunk(setB, j0 + CH); }
}

template <int MODE = 0> __device__ void phase_scan0(const Params& p, unsigned char* smem) {
    constexpr int NU_R = 2 * BATCH * RWKV_HEADS * 2;
    for (int u = blockIdx.x; u < NU_R; u += gridDim.x) { for (int rep = 0; rep < PROBE_REPS_A; ++rep) { rwkv_unit(p, smem, u); __syncthreads(); } }
}

template <bool DRY> __device__ void phase_finish0(const Params& p) {
    constexpr int W = RWKV_W, NP = EVEN_PROJ_PAD;
    constexpr int NVR = W / 8, NVH = HG_VW / 8;
    static_assert(NVR <= 64 && NVH <= 64, "finish0 layout");
    const int tid = opaque_tid(), lane = tid & 63, wv = (blockIdx.x * NT + tid) >> 6, nwv = gridDim.x * (NT / 64);
    const bf16_t* P = reinterpret_cast<const bf16_t*>(p.ws + WS_P);
    const bf16_t* AUX = reinterpret_cast<const bf16_t*>(p.ws + WS_AUX0);
    bf16_t* O0 = reinterpret_cast<bf16_t*>(p.ws + WS_O0);
    const bf16_t* O1 = O0 + (size_t)T_ALL * OW0;
    const bool actr = lane < NVR, acth = lane < NVH;
    const int c = (actr ? lane : 0) * 8, ch = (acth ? lane : 0) * 8;
    float ka[8], rk[8], lw[8], lbv[8], hw[8];
    ldf8(p.rwkv_k_a + c, ka); ldf8(p.rwkv_r_k + c, rk); ldf8(p.rwkv_ln_w + c, lw); ldf8(p.rwkv_ln_b + c, lbv);
    for (int row = wv; row < T_ALL; row += nwv) {
        bf16_t* o0 = O0 + (size_t)row * OW0; const bf16_t* o1 = O1 + (size_t)row * OW0;
        const bf16_t* a = AUX + (size_t)row * AUX0_W;
        const U4 u0 = ld16(o0 + c), u1 = ld16(o1 + c), ur = ld16(a + c), uk = ld16(a + W + c), uv = ld16(a + 2 * W + c);
        const U4 ua0 = ld16(a + 5 * W + c), ua1 = ld16(a + 6 * W + c), ug = ld16(a + 7 * W + c);
        {
            float x0[8], x1[8], r[8], k[8], v[8], a0[8], a1[8], g[8], o[8];
            unpack8(u0, x0); unpack8(u1, x1); unpack8(ur, r); unpack8(uk, k); unpack8(uv, v); unpack8(ua0, a0); unpack8(ua1, a1); unpack8(ug, g);
            float sum = 0.f, bon = 0.f;
#pragma unroll
            for (int i = 0; i < 8; ++i) {
                o[i] = x0[i] + x1[i]; sum += o[i];
                const float km = k[i] * (1.f + (a0[i] - 1.f) * ka[i]) + k[i] * (1.f + (a1[i] - 1.f) * ka[i]);
                bon += r[i] * km * rk[i];
            }
            if (!actr) { sum = 0.f; bon = 0.f; }
            const float mu = sum8(sum) * (1.f / 64.f);
            bon = sum8(bon);
            float var = 0.f;
#pragma unroll
            for (int i = 0; i < 8; ++i) { const float dd = o[i] - mu; var += dd * dd; }
            var = sum8(actr ? var : 0.f) * (1.f / 64.f);
            const float rs = rsqrtf(var + RWKV_GN_EPS);
            float y[8];
#pragma unroll
            for (int i = 0; i < 8; ++i) y[i] = ((o[i] - mu) * rs * lw[i] + lbv[i] + bon * v[i]) * g[i];
            if (actr) { if (DRY) { sink(y[0]); sink(y[7]); } else st16(o0 + c, pack8f(y)); }
        }
    }
}

__device__ __forceinline__ U4 pack8(const f32x4& a, const f32x4& b) { U4 o; o.x = pack2(a[0], a[1]); o.y = pack2(a[2], a[3]); o.z = pack2(b[0], b[1]); o.w = pack2(b[2], b[3]); return o; }

template <int LAYER> struct ProbInproj {
    static constexpr int K = D_MODEL; static constexpr bool PERM = true;
    static constexpr int NP = LAYER == 0 ? EVEN_PROJ_PAD : ODD_PROJ_PAD;
    const char* A; const char* Bt; bf16_t* P;
    __device__ __forceinline__ int nM() const { return T_ALL / 256; }
    __device__ __forceinline__ int nN() const { return NP / 256; }
    __device__ __forceinline__ const char* a_base() const { return A; }
    __device__ __forceinline__ unsigned a_off(int pm, int r) const { return (unsigned)(pm * 256 + r) * (unsigned)(K * 2); }
    __device__ __forceinline__ const char* b_base(int, int pn) const { return Bt + (size_t)pn * 256 * K * 2; }
    __device__ __forceinline__ void epi(const f32x4 (&acc)[2][2][4][2], int pm, int pn, int wr, int wc, int fr, int fq) const {
#pragma unroll
        for (int ai = 0; ai < 2; ++ai)
#pragma unroll
            for (int m = 0; m < 4; ++m) {
                bf16_t* rowp = P + (size_t)(pm * 256 + ai * 128 + wr * 64 + m * 16 + fr) * NP + pn * 256 + wc * 32 + fq * 8;
#pragma unroll
                for (int bj = 0; bj < 2; ++bj) st16(rowp + bj * 128, pack8(acc[ai][bj][m][0], acc[ai][bj][m][1]));
            }
    }
};
template <int LAYER> __device__ void phase_inproj(const Params& p, unsigned char* smem) {
    ProbInproj<LAYER> pr;
    pr.A = reinterpret_cast<const char*>(p.ws + WS_H); pr.Bt = reinterpret_cast<const char*>(p.ws + (LAYER == 0 ? WS_WIN0 : WS_WIN1));
    pr.P = reinterpret_cast<bf16_t*>(p.ws + WS_P);
    g8::gemm_phase(smem, pr);
}

template <int LAYER> struct ProbOutproj {
    static constexpr int K = LAYER == 0 ? EVEN_OUT : ODD_OUT; static constexpr bool PERM = false;
    static constexpr int OWL = LAYER == 0 ? OW0 : OW1, MROWS = LAYER == 0 ? T_ALL : T_LAT;
    const char* A; const char* Bt; const float* mod; const float* x_in; const float* ctx_in; float* xl; float* xc;
    __device__ __forceinline__ int nM() const { return MROWS / 256; }
    __device__ __forceinline__ int nN() const { return D_MODEL / 256; }
    __device__ __forceinline__ const char* a_base() const { return A; }
    __device__ __forceinline__ unsigned a_off(int pm, int r) const {
        const int m = pm * 256 + r;
        if (LAYER == 0) return (unsigned)m * (unsigned)(OWL * 2);
        const int b = m / SEQ, j = m - b * SEQ; return (unsigned)(b * LSEQ + CTX_LEN + j) * (unsigned)(OWL * 2);
    }
    __device__ __forceinline__ const char* b_base(int, int pn) const { return Bt + (size_t)pn * 256 * K * 2; }
    __device__ __forceinline__ void epi(const f32x4 (&acc)[2][2][4][2], int pm, int pn, int wr, int wc, int fr, int fq) const {
#pragma unroll
        for (int ai = 0; ai < 2; ++ai)
#pragma unroll
            for (int m = 0; m < 4; ++m) {
                const int row = pm * 256 + ai * 128 + wr * 64 + m * 16 + fr;
                const float* src; float* dst; const float* md;
                if (LAYER == 0) {
                    const int b = row / LSEQ, s = row - b * LSEQ;
                    if (s < CTX_LEN) { const size_t o = ((size_t)b * CTX_LEN + s) * D_MODEL; src = ctx_in + o; dst = xc + o; md = mod + ((size_t)BATCH * N_MOD + 2) * D_MODEL; }
                    else { const size_t o = ((size_t)b * SEQ + (s - CTX_LEN)) * D_MODEL; src = x_in + o; dst = xl + o; md = mod + ((size_t)b * N_MOD + 2) * D_MODEL; }
                } else {
                    const int b = row / SEQ, jj = row - b * SEQ;
                    const size_t o = ((size_t)b * SEQ + lat_nat<1>(jj)) * D_MODEL; src = xl + o; dst = xl + o; md = mod + ((size_t)b * N_MOD + 2) * D_MODEL;
                }
#pragma unroll
                for (int bj = 0; bj < 2; ++bj)
#pragma unroll
                    for (int n = 0; n < 2; ++n) {
                        const int col = pn * 256 + bj * 128 + wc * 32 + n * 16 + fq * 4;
                        const F4 sv = ldf4(src + col), mv = ldf4(md + col);
                        F4 o; o.x = sv.x + mv.x * acc[ai][bj][m][n][0]; o.y = sv.y + mv.y * acc[ai][bj][m][n][1];
                        o.z = sv.z + mv.z * acc[ai][bj][m][n][2]; o.w = sv.w + mv.w * acc[ai][bj][m][n][3];
                        *reinterpret_cast<F4*>(dst + col) = o;
                    }
            }
    }
};
template <int LAYER> __device__ void phase_outproj(const Params& p, unsigned char* smem) {
    ProbOutproj<LAYER> pr;
    pr.A = reinterpret_cast<const char*>(p.ws + (LAYER == 0 ? WS_O0 : WS_O1)); pr.Bt = reinterpret_cast<const char*>(p.ws + (LAYER == 0 ? WS_WOUT0 : WS_WOUT1));
    pr.mod = reinterpret_cast<const float*>(p.ws + WS_MOD) + (size_t)LAYER * (BATCH + 1) * N_MOD * D_MODEL;
    pr.x_in = p.x; pr.ctx_in = p.ctx; pr.xl = p.out; pr.xc = reinterpret_cast<float*>(p.ws + WS_XC);
    g8::gemm_phase(smem, pr);
}

template <int CTRL> __device__ __forceinline__ int dpp_i(int v) {
#ifdef EMU
    auto r = emu_wave_exchange(&v, 4); const int l = emu_cur->lane; int s;
    if (CTRL == 0xB1) s = l ^ 1; else if (CTRL == 0x4E) s = l ^ 2; else if (CTRL == 0x141) s = (l & ~7) | (7 - (l & 7)); else s = (l & ~15) | (15 - (l & 15));
    int o; memcpy(&o, r[s], 4); return o;
#else
    return __builtin_amdgcn_update_dpp(0, v, CTRL, 0xF, 0xF, true);
#endif
}
template <int LAYER, bool DRY> __device__ void phase_router(const Params& p, unsigned char* smem) {
    constexpr int TM = LAYER == 0 ? T_MOE0 : T_MOE1;
    constexpr int EPL = 4, LPG = N_EXPERTS / EPL, NG = 64 / LPG, DG = D_MODEL / NG;
    constexpr int TB4 = 4;
    constexpr int ROWF = D_MODEL + NG * 4;
    static_assert(N_EXPERTS % EPL == 0 && LPG <= 8 && 64 % LPG == 0 && D_MODEL % NG == 0, "router layout");
    const int tid = opaque_tid(), lane = tid & 63, wl = tid >> 6, wv = (blockIdx.x * NT + tid) >> 6, nwv = gridDim.x * (NT / 64);
    const float* mod = reinterpret_cast<const float*>(p.ws + WS_MOD) + (size_t)LAYER * (BATCH + 1) * N_MOD * D_MODEL;
    const float* xcw = reinterpret_cast<const float*>(p.ws + WS_XC);
    bf16_t* h2 = reinterpret_cast<bf16_t*>(p.ws + WS_H);
    int* tope = reinterpret_cast<int*>(p.ws + WS_TOPE); float* topp = reinterpret_cast<float*>(p.ws + WS_TOPP);
    int* rank = reinterpret_cast<int*>(p.ws + WS_RANK); int* cnt = reinterpret_cast<int*>(p.ws + WS_CNT) + LAYER * N_EXPERTS;
    float* hrow = reinterpret_cast<float*>(smem) + wl * (TB4 * ROWF);
    constexpr int RT_MAXTOK = 1024;
    int* lcount = reinterpret_cast<int*>(smem + 8 * TB4 * ROWF * sizeof(float));
    int* lbase = lcount + N_EXPERTS;
    short* lrec = reinterpret_cast<short*>(lbase + N_EXPERTS);
    if (tid < N_EXPERTS) lcount[tid] = 0;
    __syncthreads();
    const float* g = p.norm2_w + LAYER * D_MODEL;
    const float* rw = p.router_w + (size_t)LAYER * D_MODEL * N_EXPERTS;
    constexpr int NV = D_MODEL / 256;
    const int eg = lane % LPG, dg = lane / LPG;
    const F4 rb = ldf4(p.router_b + LAYER * N_EXPERTS + eg * EPL);
    int itg = 0;
    for (int tok0 = wv; tok0 < TM; tok0 += TB4 * nwv, ++itg) {
        F4 v[TB4][NV]; const float* mdq[TB4];
#pragma unroll
        for (int q = 0; q < TB4; ++q) {
            const int tq = tok0 + q * nwv, tok = tq < TM ? tq : tok0;
            const float* src;
            if (LAYER == 0 && tok < T_CTX) { src = xcw + (size_t)tok * D_MODEL; mdq[q] = mod + (size_t)BATCH * N_MOD * D_MODEL; }
            else { const int n = LAYER == 0 ? tok - T_CTX : tok; src = p.out + (size_t)n * D_MODEL; mdq[q] = mod + (size_t)(n / SEQ) * N_MOD * D_MODEL; }
#pragma unroll
            for (int i = 0; i < NV; ++i) v[q][i] = ldf4(src + i * 256 + lane * 4);
        }
#pragma unroll
        for (int q = 0; q < TB4; ++q) {
            const int tok = tok0 + q * nwv; const bool valid = tok < TM;
            const float* md = mdq[q];
            float ss = 0.f;
#pragma unroll
            for (int i = 0; i < NV; ++i) ss += v[q][i].x * v[q][i].x + v[q][i].y * v[q][i].y + v[q][i].z * v[q][i].z + v[q][i].w * v[q][i].w;
            ss = wave_sum(ss);
            const float rs = rsqrtf(ss * (1.0f / D_MODEL) + EPS);
#pragma unroll
            for (int i = 0; i < NV; ++i) {
                const int c = i * 256 + lane * 4;
                F4 gg = ldf4(g + c), m3 = ldf4(md + 3 * D_MODEL + c), m4 = ldf4(md + 4 * D_MODEL + c);
                F4 o; o.x = v[q][i].x * rs * gg.x * (1.f + m4.x) + m3.x; o.y = v[q][i].y * rs * gg.y * (1.f + m4.y) + m3.y;
                o.z = v[q][i].z * rs * gg.z * (1.f + m4.z) + m3.z; o.w = v[q][i].w * rs * gg.w * (1.f + m4.w) + m3.w;
                if (!DRY && valid) { unsigned* dst = reinterpret_cast<unsigned*>(h2 + (size_t)tok * D_MODEL + c); dst[0] = pack2(o.x, o.y); dst[1] = pack2(o.z, o.w); }
                *reinterpret_cast<F4*>(hrow + q * ROWF + c + (c / DG) * 4) = o;
            }
        }
        wave_sync();
        float lg[TB4][EPL];
#pragma unroll
        for (int q = 0; q < TB4; ++q)
#pragma unroll
            for (int e = 0; e < EPL; ++e) lg[q][e] = 0.f;
        const float* rwp = rw + (size_t)dg * DG * N_EXPERTS + eg * EPL; const float* hp = hrow + dg * (DG + 4);
#pragma unroll 4
        for (int dd = 0; dd < DG; ++dd) {
            const F4 w4 = ldf4(rwp + (size_t)dd * N_EXPERTS);
#pragma unroll
            for (int q = 0; q < TB4; ++q) {
                const float hv = hp[q * ROWF + dd];
                lg[q][0] += hv * w4.x; lg[q][1] += hv * w4.y; lg[q][2] += hv * w4.z; lg[q][3] += hv * w4.w;
            }
        }
#pragma unroll
        for (int q = 0; q < TB4; ++q) {
#pragma unroll
            for (int m = LPG; m < 64; m <<= 1) {
#pragma unroll
                for (int e = 0; e < EPL; ++e) lg[q][e] += __shfl_xor(lg[q][e], m, 64);
            }
            lg[q][0] += rb.x; lg[q][1] += rb.y; lg[q][2] += rb.z; lg[q][3] += rb.w;
            float tv[TOP_K]; int ti[TOP_K];
#pragma unroll
            for (int k = 0; k < TOP_K; ++k) {
                float bv = lg[q][0]; int bi = eg * EPL;
#pragma unroll
                for (int e = 1; e < EPL; ++e) if (lg[q][e] > bv) { bv = lg[q][e]; bi = eg * EPL + e; }
                if (LPG > 1) { const float ov = dpp_f<0xB1>(bv); const int oi = dpp_i<0xB1>(bi); if (ov > bv || (ov == bv && oi < bi)) { bv = ov; bi = oi; } }
                if (LPG > 2) { const float ov = dpp_f<0x4E>(bv); const int oi = dpp_i<0x4E>(bi); if (ov > bv || (ov == bv && oi < bi)) { bv = ov; bi = oi; } }
                if (LPG > 4) { const float ov = dpp_f<0x141>(bv); const int oi = dpp_i<0x141>(bi); if (ov > bv || (ov == bv && oi < bi)) { bv = ov; bi = oi; } }
                tv[k] = bv; ti[k] = bi;
#pragma unroll
                for (int e = 0; e < EPL; ++e) if (eg * EPL + e == bi) lg[q][e] = -INFINITY;
            }
            const int tok = tok0 + q * nwv;
            if (lane == 0 && tok < TM) {
                float s = 0.f, pe[TOP_K];
#pragma unroll
                for (int k = 0; k < TOP_K; ++k) { pe[k] = fexp(tv[k] - tv[0]); s += pe[k]; }
                const int itk = itg * TB4 + q;
#pragma unroll
                for (int k = 0; k < TOP_K; ++k) {
                    if (DRY) { sink(ti[k]); sink(pe[k] / s); }
                    else {
                        tope[(size_t)tok * TOP_K + k] = ti[k]; topp[(size_t)tok * TOP_K + k] = pe[k] / s;
                        const int lr = atomicAdd(&lcount[ti[k]], 1);
                        const int slot = ((itk * (NT / 64) + wl) * TOP_K + k) * 2;
                        lrec[slot] = (short)ti[k]; lrec[slot + 1] = (short)lr;
                    }
                }
            }
        }
        wave_sync();
    }
    if (!DRY) {
        __syncthreads();
        if (tid < N_EXPERTS) lbase[tid] = atomicAdd(&cnt[tid], lcount[tid]);
        __syncthreads();
        const int wv0 = (blockIdx.x * NT) >> 6;
        const int itmax = wv0 < TM ? (TM - 1 - wv0) / nwv + 1 : 0;
        for (int q = tid; q < itmax * (NT / 64) * TOP_K; q += NT) {
            const int itq = q / ((NT / 64) * TOP_K), rem = q - itq * ((NT / 64) * TOP_K), wq = rem / TOP_K, kq2 = rem - wq * TOP_K;
            const int tokq = wv0 + wq + itq * nwv;
            if (tokq < TM) rank[(size_t)tokq * TOP_K + kq2] = lbase[lrec[q * 2]] + lrec[q * 2 + 1];
        }
    }
}

struct MoeTab { int poff[N_EXPERTS + 1]; int cnt[N_EXPERTS]; int tile_e[MAX_MTILES]; int ntiles; };
template <int LAYER> __device__ __forceinline__ void build_moe_tab(const Params& p, MoeTab* tab) {
    const int* cnt = reinterpret_cast<const int*>(p.ws + WS_CNT) + LAYER * N_EXPERTS;
    const int tid = opaque_tid();
    if (tid < N_EXPERTS) tab->cnt[tid] = cnt[tid];
    __syncthreads();
    if (tid == 0) {
        int off = 0, nt = 0;
        for (int e = 0; e < N_EXPERTS; ++e) { tab->poff[e] = off; const int tl = (tab->cnt[e] + BM - 1) / BM; off += tl * BM; nt += tl; }
        tab->poff[N_EXPERTS] = off; tab->ntiles = nt;
    }
    __syncthreads();
    if (tid < N_EXPERTS) {
        const int t0 = tab->poff[tid] / BM, t1 = tab->poff[tid + 1] / BM;
        for (int t = t0; t < t1; ++t) tab->tile_e[t] = tid;
    }
    __syncthreads();
}

template <int LAYER> __device__ void phase_scatter(const Params& p, unsigned char* smem) {
    constexpr int TM = LAYER == 0 ? T_MOE0 : T_MOE1;
    MoeTab* tab = reinterpret_cast<MoeTab*>(smem);
    build_moe_tab<LAYER>(p, tab);
    const int* tope = reinterpret_cast<const int*>(p.ws + WS_TOPE); const int* rank = reinterpret_cast<const int*>(p.ws + WS_RANK);
    int* posof = reinterpret_cast<int*>(p.ws + WS_POSOF); int* tokof = reinterpret_cast<int*>(p.ws + WS_TOKOF);
    for (int i = blockIdx.x * NT + opaque_tid(); i < TM * TOP_K; i += gridDim.x * NT) {
        const int pos = tab->poff[tope[i]] + rank[i];
        posof[i] = pos; tokof[pos] = i / TOP_K;
    }
    __syncthreads();
    if (LAYER == 1) convert_expert_weights<1>(p, blockIdx.x, gridDim.x, smem, (int)gridDim.x > SCAN1_UNITS ? CVT_NDN : 0, CVT_NTOT);
}

constexpr int MOE1_MAX_UNITS = 24;
template <int LAYER, bool DRYE = false> struct ProbMoe1 {
    static constexpr int K = D_MODEL; static constexpr bool PERM = true;
    const MoeTab* tab; const char* A; const char* W; const int* toklds; bf16_t* H1; const float* bg; const float* bu; int G, c, nNv;
    __device__ __forceinline__ int nM() const { return tab->ntiles; }
    __device__ __forceinline__ int nN() const { return 2 * D_FF / 256; }
    __device__ __forceinline__ const char* a_base() const { return A; }
    __device__ __forceinline__ unsigned a_off(int pm, int r) const {
        int slot = 0;
        for (int i = 0; i < MOE1_MAX_UNITS; ++i) { if (toklds[MOE1_MAX_UNITS * 256 + i] == pm) { slot = i; break; } }
        return (unsigned)toklds[slot * 256 + r] * (unsigned)(K * 2);
    }
    __device__ __forceinline__ const char* b_base(int pm, int pn) const { return W + ((size_t)tab->tile_e[pm] * 2 * D_FF + (size_t)pn * 256) * K * 2; }
    __device__ __forceinline__ void epi(const f32x4 (&acc)[2][2][4][2], int pm, int pn, int wr, int wc, int fr, int fq) const {
        if (DRYE) { float t = 0.f; for (int a = 0; a < 2; ++a) for (int b = 0; b < 2; ++b) for (int m = 0; m < 4; ++m) for (int n = 0; n < 2; ++n) t += acc[a][b][m][n][0] + acc[a][b][m][n][1] + acc[a][b][m][n][2] + acc[a][b][m][n][3]; sink(t); return; }
        const int e = tab->tile_e[pm], col = pn * 128 + wc * 32 + fq * 8;
        const float* bgp = bg + (size_t)e * D_FF + col; const float* bup = bu + (size_t)e * D_FF + col;
        float bgv[8], buv[8];
#pragma unroll
        for (int i = 0; i < 2; ++i) { const F4 a = ldf4(bgp + 4 * i), b = ldf4(bup + 4 * i); bgv[4 * i] = a.x; bgv[4 * i + 1] = a.y; bgv[4 * i + 2] = a.z; bgv[4 * i + 3] = a.w; buv[4 * i] = b.x; buv[4 * i + 1] = b.y; buv[4 * i + 2] = b.z; buv[4 * i + 3] = b.w; }
#pragma unroll
        for (int ai = 0; ai < 2; ++ai)
#pragma unroll
            for (int m = 0; m < 4; ++m) {
                const int row = pm * 256 + ai * 128 + wr * 64 + m * 16 + fr;
                f32x4 hv[2];
#pragma unroll
                for (int n = 0; n < 2; ++n)
#pragma unroll
                    for (int j = 0; j < 4; ++j) {
                        const float gv = fminf(acc[ai][0][m][n][j] + bgv[4 * n + j], SWIGLU_LIMIT);
                        const float uv = fminf(fmaxf(acc[ai][1][m][n][j] + buv[4 * n + j], -SWIGLU_LIMIT), SWIGLU_LIMIT);
                        hv[n][j] = gv * sigmoidf_(SWIGLU_ALPHA * gv) * (uv + 1.f);
                    }
                st16(H1 + (size_t)row * D_FF + col, pack8(hv[0], hv[1]));
            }
    }
};
template <int LAYER, bool DRYE = false> __device__ void phase_moe1(const Params& p, unsigned char* smem) {
    MoeTab* tab = reinterpret_cast<MoeTab*>(smem + g8::STAGE_BYTES);
    build_moe_tab<LAYER>(p, tab);
    ProbMoe1<LAYER, DRYE> pr;
    pr.tab = tab; pr.A = reinterpret_cast<const char*>(p.ws + WS_H); pr.W = reinterpret_cast<const char*>(p.ws + WS_WGU);
    pr.H1 = reinterpret_cast<bf16_t*>(p.ws + WS_H1);
    {
        int* toklds = reinterpret_cast<int*>(smem + g8::STAGE_BYTES + 4096);
        int* slot_pm = toklds + MOE1_MAX_UNITS * 256;
        const int* tokof = reinterpret_cast<const int*>(p.ws + WS_TOKOF);
        const int tid = opaque_tid(), nM = tab->ntiles, nN = 2 * D_FF / 256;
        if (tid < MOE1_MAX_UNITS) slot_pm[tid] = -1;
        __syncthreads();
        if (tid == 0) {
            int nslot = 0;
            for (int i = 0; i < MOE1_MAX_UNITS * 4; ++i) {
                int pm, pn; if (!g8::unit_of(i * (int)gridDim.x + (int)blockIdx.x, nM, nN, pm, pn)) break;
                bool seen = false;
                for (int q = 0; q < nslot; ++q) seen = seen || (slot_pm[q] == pm);
                if (!seen && nslot < MOE1_MAX_UNITS) slot_pm[nslot++] = pm;
            }
            slot_pm[MOE1_MAX_UNITS] = nslot;
        }
        __syncthreads();
        const int nslot = slot_pm[MOE1_MAX_UNITS];
        for (int idx = tid; idx < nslot * 256; idx += NT) {
            const int pm = slot_pm[idx >> 8], e = tab->tile_e[pm], pbase = tab->poff[e], pos = pm * 256 + (idx & 255);
            toklds[idx] = tokof[(pos - pbase < tab->cnt[e]) ? pos : pbase];
        }
        __syncthreads();
        pr.toklds = toklds;
    }
    pr.bg = p.exp_b_gate + (size_t)LAYER * N_EXPERTS * D_FF; pr.bu = p.exp_b_up + (size_t)LAYER * N_EXPERTS * D_FF;
    g8::gemm_phase(smem, pr);
}

template <int LAYER, bool DRYE = false> struct ProbMoe2 {
    static constexpr int K = D_FF; static constexpr bool PERM = true;
    const MoeTab* tab; const char* A; const char* W; bf16_t* Y; const float* bd;
    __device__ __forceinline__ int nM() const { return tab->ntiles; }
    __device__ __forceinline__ int nN() const { return D_MODEL / 256; }
    __device__ __forceinline__ const char* a_base() const { return A; }
    __device__ __forceinline__ unsigned a_off(int pm, int r) const { return (unsigned)(pm * 256 + r) * (unsigned)(K * 2); }
    __device__ __forceinline__ const char* b_base(int pm, int pn) const { return W + ((size_t)tab->tile_e[pm] * D_MODEL + (size_t)pn * 256) * K * 2; }
    __device__ __forceinline__ void epi(const f32x4 (&acc)[2][2][4][2], int pm, int pn, int wr, int wc, int fr, int fq) const {
        if (DRYE) { float t = 0.f; for (int a = 0; a < 2; ++a) for (int b = 0; b < 2; ++b) for (int m = 0; m < 4; ++m) for (int n = 0; n < 2; ++n) t += acc[a][b][m][n][0] + acc[a][b][m][n][1] + acc[a][b][m][n][2] + acc[a][b][m][n][3]; sink(t); return; }
        const int e = tab->tile_e[pm];
#pragma unroll
        for (int bj = 0; bj < 2; ++bj) {
            const int col = pn * 256 + bj * 128 + wc * 32 + fq * 8;
            const F4 b0 = ldf4(bd + (size_t)e * D_MODEL + col), b1 = ldf4(bd + (size_t)e * D_MODEL + col + 4);
#pragma unroll
            for (int ai = 0; ai < 2; ++ai)
#pragma unroll
                for (int m = 0; m < 4; ++m) {
                    const int row = pm * 256 + ai * 128 + wr * 64 + m * 16 + fr;
                    f32x4 v0 = acc[ai][bj][m][0], v1 = acc[ai][bj][m][1];
                    v0[0] += b0.x; v0[1] += b0.y; v0[2] += b0.z; v0[3] += b0.w; v1[0] += b1.x; v1[1] += b1.y; v1[2] += b1.z; v1[3] += b1.w;
                    st16(Y + (size_t)row * D_MODEL + col, pack8(v0, v1));
                }
        }
    }
};
template <int LAYER, bool DRYE = false> __device__ void phase_moe2(const Params& p, unsigned char* smem) {
    MoeTab* tab = reinterpret_cast<MoeTab*>(smem + g8::STAGE_BYTES);
    build_moe_tab<LAYER>(p, tab);
    ProbMoe2<LAYER, DRYE> pr;
    pr.tab = tab; pr.A = reinterpret_cast<const char*>(p.ws + WS_H1); pr.W = reinterpret_cast<const char*>(p.ws + WS_WDN);
    pr.Y = reinterpret_cast<bf16_t*>(p.ws + WS_Y); pr.bd = p.exp_b_down + (size_t)LAYER * N_EXPERTS * D_MODEL;
    g8::gemm_phase(smem, pr);
}

template <int LAYER, bool DRY> __device__ void phase_combine(const Params& p) {
    constexpr int TM = LAYER == 0 ? T_MOE0 : T_MOE1;
    const int tid = opaque_tid(), lane = tid & 63, wv = (blockIdx.x * NT + tid) >> 6, nwv = gridDim.x * (NT / 64);
    const float* mod = reinterpret_cast<const float*>(p.ws + WS_MOD) + (size_t)LAYER * (BATCH + 1) * N_MOD * D_MODEL;
    float* xcw = reinterpret_cast<float*>(p.ws + WS_XC);
    const bf16_t* Y = reinterpret_cast<const bf16_t*>(p.ws + WS_Y);
    const int* posof = reinterpret_cast<const int*>(p.ws + WS_POSOF); const float* topp = reinterpret_cast<const float*>(p.ws + WS_TOPP);
    constexpr int NV = D_MODEL / 256;
    for (int tok = wv; tok < TM; tok += nwv) {
        float* xr; const float* md;
        if (LAYER == 0 && tok < T_CTX) { xr = xcw + (size_t)tok * D_MODEL; md = mod + ((size_t)BATCH * N_MOD + 5) * D_MODEL; }
        else { const int n = LAYER == 0 ? tok - T_CTX : tok; xr = p.out + (size_t)n * D_MODEL; md = mod + ((size_t)(n / SEQ) * N_MOD + 5) * D_MODEL; }
        int pos[TOP_K]; float pr[TOP_K];
#pragma unroll
        for (int k = 0; k < TOP_K; ++k) { pos[k] = posof[(size_t)tok * TOP_K + k]; pr[k] = topp[(size_t)tok * TOP_K + k]; }
        F4 xo[NV]; float ss = 0.f;
#pragma unroll
        for (int i = 0; i < NV; ++i) {
            const int c = i * 256 + lane * 4;
            float f0 = 0.f, f1 = 0.f, f2 = 0.f, f3 = 0.f;
#pragma unroll
            for (int k = 0; k < TOP_K; ++k) {
                const unsigned* yp = reinterpret_cast<const unsigned*>(Y + (size_t)pos[k] * D_MODEL + c);
                const unsigned u0 = yp[0], u1 = yp[1];
                f0 += pr[k] * lo2f(u0); f1 += pr[k] * hi2f(u0); f2 += pr[k] * lo2f(u1); f3 += pr[k] * hi2f(u1);
            }
            F4 xv = ldf4(xr + c), m5 = ldf4(md + c);
            xv.x += m5.x * f0; xv.y += m5.y * f1; xv.z += m5.z * f2; xv.w += m5.w * f3;
            xo[i] = xv; ss += xv.x * xv.x + xv.y * xv.y + xv.z * xv.z + xv.w * xv.w;
        }
        if (LAYER == 0 && !DRY) {
            const float rs1 = rsqrtf(wave_sum(ss) * (1.0f / D_MODEL) + EPS);
            const float* mod1 = reinterpret_cast<const float*>(p.ws + WS_MOD) + (size_t)(BATCH + 1) * N_MOD * D_MODEL;
            const float* md1; size_t drow;
            if (tok < T_CTX) { md1 = mod1 + (size_t)BATCH * N_MOD * D_MODEL; drow = (size_t)(tok / CTX_LEN) * LSEQ + tok % CTX_LEN; }
            else {
                const int n = tok - T_CTX, bb = n / SEQ, nn = n - bb * SEQ, r = nn / GRID_W, w = nn - r * GRID_W;
                md1 = mod1 + (size_t)bb * N_MOD * D_MODEL; drow = (size_t)bb * LSEQ + CTX_LEN + w * GRID_ROWS + r;
            }
            bf16_t* hrow1 = reinterpret_cast<bf16_t*>(p.ws + WS_H) + drow * D_MODEL;
#pragma unroll
            for (int i = 0; i < NV; ++i) {
                const int c = i * 256 + lane * 4;
                const F4 gg = ldf4(p.norm1_w + D_MODEL + c), m0 = ldf4(md1 + c), m1 = ldf4(md1 + D_MODEL + c);
                unsigned* dst = reinterpret_cast<unsigned*>(hrow1 + c);
                dst[0] = pack2(xo[i].x * rs1 * gg.x * (1.f + m1.x) + m0.x, xo[i].y * rs1 * gg.y * (1.f + m1.y) + m0.y);
                dst[1] = pack2(xo[i].z * rs1 * gg.z * (1.f + m1.z) + m0.z, xo[i].w * rs1 * gg.w * (1.f + m1.w) + m0.w);
            }
        }
        if (LAYER == 1) {
            ss = wave_sum(ss);
            const float rs = rsqrtf(ss * (1.0f / D_MODEL) + EPS);
#pragma unroll
            for (int i = 0; i < NV; ++i) {
                const int c = i * 256 + lane * 4; F4 gg = ldf4(p.final_norm_w + c);
                xo[i].x *= rs * gg.x; xo[i].y *= rs * gg.y; xo[i].z *= rs * gg.z; xo[i].w *= rs * gg.w;
            }
        }
#pragma unroll
        for (int i = 0; i < NV; ++i) { if (DRY) { sink(xo[i].x); sink(xo[i].y); sink(xo[i].z); sink(xo[i].w); } else *reinterpret_cast<F4*>(xr + i * 256 + lane * 4) = xo[i]; }
    }
}
__device__ void phase_prep1(const Params& p) {
    constexpr int NP = ODD_PROJ_PAD, RB = 32;
    constexpr int NCG = XC_W / 8;
    static_assert(SSD_CONV_CH % 8 == 0 && XC_W % 8 == 0 && SSD_INNER % 8 == 0 && SSD_PROJ % 8 == 0, "prep1 alignment");
    const bf16_t* P = reinterpret_cast<const bf16_t*>(p.ws + WS_P);
    bf16_t* XC = reinterpret_cast<bf16_t*>(p.ws + WS_AUX1);
    const int tid = opaque_tid();
    for (int task = blockIdx.x * NT + tid; task < (T_ALL / RB) * NCG; task += gridDim.x * NT) {
        const int rb = task / NCG, cg = task - rb * NCG, c = cg * 8, row0 = rb * RB;
        const int s0 = row0 % LSEQ;
        const int lo = s0 < CTX_LEN ? 0 : CTX_LEN, hi = s0 < CTX_LEN ? CTX_LEN : LSEQ;
        int pc; const float* cw; const float* cb; int cc, cwid;
        if (c < SSD_CONV_CH) { pc = SSD_INNER + c; cw = p.ssd_conv_w; cb = p.ssd_conv_b; cc = c; cwid = SSD_CONV_CH; }
        else { cc = c - SSD_CONV_CH; pc = SSD_PROJ + cc; cw = p.mlstm_conv_w; cb = p.mlstm_conv_b; cwid = 2 * ML_QKW; }
        float w[5][8], bias[8];
#pragma unroll
        for (int j = 0; j < 5; ++j) { const F4 a = ldf4(cw + j * cwid + cc), b = ldf4(cw + j * cwid + cc + 4); w[j][0] = a.x; w[j][1] = a.y; w[j][2] = a.z; w[j][3] = a.w; w[j][4] = b.x; w[j][5] = b.y; w[j][6] = b.z; w[j][7] = b.w; }
        { const F4 a = ldf4(cb + cc), b = ldf4(cb + cc + 4); bias[0] = a.x; bias[1] = a.y; bias[2] = a.z; bias[3] = a.w; bias[4] = b.x; bias[5] = b.y; bias[6] = b.z; bias[7] = b.w; }
        const bf16_t* src = P + (size_t)row0 * NP + pc;
        U4 win[5];
        const U4 zero = U4{0u, 0u, 0u, 0u};
        win[0] = zero; win[1] = zero;
        if (s0 - 2 >= lo) win[0] = ld16(src - 2 * (size_t)NP);
        if (s0 - 1 >= lo) win[1] = ld16(src - (size_t)NP);
        win[2] = ld16(src); win[3] = ld16(src + NP);
#pragma unroll 4
        for (int r = 0; r < RB; ++r) {
            win[4] = (s0 + r + 2 < hi) ? ld16(src + (size_t)(r + 2) * NP) : zero;
            float acc[8];
#pragma unroll
            for (int q = 0; q < 8; ++q) acc[q] = bias[q];
#pragma unroll
            for (int j = 0; j < 5; ++j) {
                const unsigned uu[4] = {win[j].x, win[j].y, win[j].z, win[j].w};
#pragma unroll
                for (int q = 0; q < 4; ++q) { acc[2 * q] += lo2f(uu[q]) * w[j][2 * q]; acc[2 * q + 1] += hi2f(uu[q]) * w[j][2 * q + 1]; }
            }
            U4 o; o.x = pack2(siluf_(acc[0]), siluf_(acc[1])); o.y = pack2(siluf_(acc[2]), siluf_(acc[3]));
            o.z = pack2(siluf_(acc[4]), siluf_(acc[5])); o.w = pack2(siluf_(acc[6]), siluf_(acc[7]));
            st16(XC + (size_t)(row0 + r) * XC_W + c, o);
            win[0] = win[1]; win[1] = win[2]; win[2] = win[3]; win[3] = win[4];
        }
    }
}

#ifdef EMU
__device__ __forceinline__ float wave_incl_scan_add(float v, int lane) {
#pragma unroll
    for (int d = 1; d < 64; d <<= 1) { const float o = __shfl_up(v, d, 64); if (lane >= d) v += o; }
    return v;
}
__device__ __forceinline__ float wave_incl_scan_max(float v, int lane) {
#pragma unroll
    for (int d = 1; d < 64; d <<= 1) { const float o = __shfl_up(v, d, 64); if (lane >= d) v = fmaxf(v, o); }
    return v;
}
__device__ __forceinline__ float wave_last(float v) { return __shfl(v, 63, 64); }
#else
template <int CTRL, int ROWMASK> __device__ __forceinline__ float dpp_or(float oldv, float v) {
    return __builtin_bit_cast(float, __builtin_amdgcn_update_dpp(__builtin_bit_cast(int, oldv), __builtin_bit_cast(int, v), CTRL, ROWMASK, 0xF, false));
}
__device__ __forceinline__ float wave_incl_scan_add(float v, int) {
    v += dpp_or<0x111, 0xF>(0.f, v); v += dpp_or<0x112, 0xF>(0.f, v); v += dpp_or<0x114, 0xF>(0.f, v); v += dpp_or<0x118, 0xF>(0.f, v);
    v += dpp_or<0x142, 0xA>(0.f, v); v += dpp_or<0x143, 0xC>(0.f, v);
    return v;
}
__device__ __forceinline__ float wave_incl_scan_max(float v, int) {
    const float ninf = -INFINITY;
    v = fmaxf(v, dpp_or<0x111, 0xF>(ninf, v)); v = fmaxf(v, dpp_or<0x112, 0xF>(ninf, v)); v = fmaxf(v, dpp_or<0x114, 0xF>(ninf, v)); v = fmaxf(v, dpp_or<0x118, 0xF>(ninf, v));
    v = fmaxf(v, dpp_or<0x142, 0xA>(ninf, v)); v = fmaxf(v, dpp_or<0x143, 0xC>(ninf, v));
    return v;
}
__device__ __forceinline__ float wave_last(float v) { return __builtin_bit_cast(float, __builtin_amdgcn_readlane(__builtin_bit_cast(int, v), 63)); }
#endif

__device__ void ssd_unit(const Params& p, unsigned char* smem, int u) {
    constexpr int NP = ODD_PROJ_PAD, CH = SSD_CH, HP = SSD_HG / 2, LDN = 136, LDS_ = 72;
    const int dir = u / (BATCH * SSD_G * HP), b = (u / (SSD_G * HP)) % BATCH, g = (u / HP) % SSD_G, hp = u % HP;
    const int tid = opaque_tid(), wid = tid >> 6, lane = tid & 63, fr = lane & 15, fq = lane >> 4;
    const int hh = wid >> 2, wq = wid & 3, head0 = g * SSD_HG + hp * 2, head = head0 + hh;
    const bf16_t* P = reinterpret_cast<const bf16_t*>(p.ws + WS_P);
    const bf16_t* XC = reinterpret_cast<const bf16_t*>(p.ws + WS_AUX1);
    bf16_t* O = reinterpret_cast<bf16_t*>(p.ws + WS_O1) + (size_t)dir * T_ALL * OW1;
    bf16_t* Cm = reinterpret_cast<bf16_t*>(smem);
    bf16_t* Bm = Cm + CH * LDN;
    bf16_t* BT = Bm + CH * LDN;
    bf16_t* xL = BT + 128 * LDS_;
    bf16_t* Gb = xL + CH * 128;
    bf16_t* xdtTb = Gb + 2 * CH * LDS_;
    bf16_t* xdtETb = xdtTb + 2 * 64 * LDS_;
    float* acumb = reinterpret_cast<float*>(xdtETb + 2 * 64 * LDS_);
    f32x4 hs[8];
#pragma unroll
    for (int n = 0; n < 8; ++n) hs[n] = f32x4{0.f, 0.f, 0.f, 0.f};
    const float dtb = p.ssd_dt_bias[dir * SSD_HEADS + head], aneg = -fexp(p.ssd_a_log[dir * SSD_HEADS + head]);
    const int lt = tid >> 4, lc = (tid & 15) * 8;
    U4 rB[2], rC[2], rX[2]; float rdt = 0.f;
    auto issue = [&](int j0) {
#pragma unroll
        for (int i = 0; i < 2; ++i) {
            const bf16_t* xr = XC + ((size_t)b * LSEQ + step_pos(dir, j0 + lt + 32 * i)) * XC_W;
            rB[i] = ld16(xr + SSD_INNER + g * SSD_N + lc); rC[i] = ld16(xr + SSD_INNER + SSD_G * SSD_N + g * SSD_N + lc);
            rX[i] = ld16(xr + head0 * SSD_P + lc);
        }
        if (wq == 0) rdt = bf2f(P[((size_t)b * LSEQ + step_pos(dir, j0 + lane)) * NP + SSD_INNER + SSD_CONV_CH + dir * SSD_HEADS + head]);
    };
    issue(0);
    for (int j0 = 0; j0 < LSEQ; j0 += CH) {
#pragma unroll
        for (int i = 0; i < 2; ++i) {
            const int t = lt + 32 * i;
            st16(Bm + t * LDN + lc, rB[i]); st16(Cm + t * LDN + lc, rC[i]); st16(xL + t * 128 + lc, rX[i]);
        }
        if (wq == 0) {
            const float dt = softplusf_(rdt + dtb);
            const float ac = wave_incl_scan_add(dt * aneg, lane);
            acumb[hh * 128 + lane] = ac; acumb[hh * 128 + 64 + lane] = dt;
        }
        lds_barrier();
        if (j0 + CH < LSEQ) issue(j0 + CH);
#pragma unroll
        for (int i = 0; i < 2; ++i) {
            const int it = tid + 512 * i;
            { const int sg = it >> 7, n = it & 127; st16(BT + n * LDS_ + 8 * sg, gather8(Bm + (8 * sg) * LDN + n, LDN)); }
            {
                const int h2 = it >> 9, sg = (it >> 6) & 7, pp = it & 63;
                const U4 x8 = gather8(xL + (8 * sg) * 128 + h2 * 64 + pp, 128);
                const float* ac = acumb + h2 * 128;
                const F4 a0 = ldf4(ac + 8 * sg), a1 = ldf4(ac + 8 * sg + 4), d0 = ldf4(ac + 64 + 8 * sg), d1 = ldf4(ac + 64 + 8 * sg + 4);
                const float al = ac[63];
                const float xv[8] = {lo2f(x8.x) * d0.x, hi2f(x8.x) * d0.y, lo2f(x8.y) * d0.z, hi2f(x8.y) * d0.w, lo2f(x8.z) * d1.x, hi2f(x8.z) * d1.y, lo2f(x8.w) * d1.z, hi2f(x8.w) * d1.w};
                const float ev[8] = {fexp(al - a0.x), fexp(al - a0.y), fexp(al - a0.z), fexp(al - a0.w), fexp(al - a1.x), fexp(al - a1.y), fexp(al - a1.z), fexp(al - a1.w)};
                U4 o; o.x = pack2(xv[0], xv[1]); o.y = pack2(xv[2], xv[3]); o.z = pack2(xv[4], xv[5]); o.w = pack2(xv[6], xv[7]);
                st16(xdtTb + h2 * (64 * LDS_) + pp * LDS_ + 8 * sg, o);
                o.x = pack2(xv[0] * ev[0], xv[1] * ev[1]); o.y = pack2(xv[2] * ev[2], xv[3] * ev[3]); o.z = pack2(xv[4] * ev[4], xv[5] * ev[5]); o.w = pack2(xv[6] * ev[6], xv[7] * ev[7]);
                st16(xdtETb + h2 * (64 * LDS_) + pp * LDS_ + 8 * sg, o);
            }
        }
#pragma unroll
        for (int q = 0; q < 2; ++q) {
            const int tile = wid * 2 + q, ti = tile >> 2, si = tile & 3;
            f32x4 a = f32x4{0.f, 0.f, 0.f, 0.f};
#pragma unroll
            for (int ks = 0; ks < 4; ++ks) {
                bf16x8 fa = *reinterpret_cast<const bf16x8*>(Cm + (ti * 16 + fr) * LDN + ks * 32 + fq * 8);
                bf16x8 fb = *reinterpret_cast<const bf16x8*>(Bm + (si * 16 + fr) * LDN + ks * 32 + fq * 8);
                a = mfma16(fb, fa, a);
            }
            const int t = ti * 16 + fr, s0 = si * 16 + fq * 4;
#pragma unroll
            for (int h2 = 0; h2 < 2; ++h2) {
                const float* ac = acumb + h2 * 128;
                const float at = ac[t]; const F4 as = ldf4(ac + s0);
                const float e0 = s0 <= t ? a[0] * fexp(at - as.x) : 0.f, e1 = s0 + 1 <= t ? a[1] * fexp(at - as.y) : 0.f;
                const float e2 = s0 + 2 <= t ? a[2] * fexp(at - as.z) : 0.f, e3 = s0 + 3 <= t ? a[3] * fexp(at - as.w) : 0.f;
                unsigned* dst = reinterpret_cast<unsigned*>(Gb + h2 * (CH * LDS_) + t * LDS_ + s0);
                dst[0] = pack2(e0, e1); dst[1] = pack2(e2, e3);
            }
        }
        lds_barrier();
        {
            const bf16_t* Gm = Gb + hh * (CH * LDS_); const bf16_t* xdtT = xdtTb + hh * (64 * LDS_); const bf16_t* xdtET = xdtETb + hh * (64 * LDS_);
            const float* ac = acumb + hh * 128;
            const bool lat = step_pos(dir, j0) >= CTX_LEN;
#pragma unroll
            for (int ti = 0; ti < 4; ++ti) {
                f32x4 a1 = f32x4{0.f, 0.f, 0.f, 0.f}, a2 = f32x4{0.f, 0.f, 0.f, 0.f};
#pragma unroll
                for (int ks = 0; ks < 2; ++ks) {
                    bf16x8 fa = *reinterpret_cast<const bf16x8*>(Gm + (ti * 16 + fr) * LDS_ + ks * 32 + fq * 8);
                    bf16x8 fb = *reinterpret_cast<const bf16x8*>(xdtT + (wq * 16 + fr) * LDS_ + ks * 32 + fq * 8);
                    a1 = mfma16(fb, fa, a1);
                }
#pragma unroll
                for (int ks = 0; ks < 4; ++ks) {
                    U4 su; su.x = pack2(hs[2 * ks][0], hs[2 * ks][1]); su.y = pack2(hs[2 * ks][2], hs[2 * ks][3]);
                    su.z = pack2(hs[2 * ks + 1][0], hs[2 * ks + 1][1]); su.w = pack2(hs[2 * ks + 1][2], hs[2 * ks + 1][3]);
                    const unsigned long long c0 = *reinterpret_cast<const unsigned long long*>(Cm + (ti * 16 + fr) * LDN + ks * 32 + 4 * fq);
                    const unsigned long long c1 = *reinterpret_cast<const unsigned long long*>(Cm + (ti * 16 + fr) * LDN + ks * 32 + 16 + 4 * fq);
                    U4 cu; cu.x = (unsigned)c0; cu.y = (unsigned)(c0 >> 32); cu.z = (unsigned)c1; cu.w = (unsigned)(c1 >> 32);
                    a2 = mfma16(__builtin_bit_cast(bf16x8, su), __builtin_bit_cast(bf16x8, cu), a2);
                }
                if (lat) {
                    const int t = ti * 16 + fr;
                    const float ea = fexp(ac[t]);
                    const size_t rowg = (size_t)b * LSEQ + step_pos(dir, j0 + t);
                    unsigned* dst = reinterpret_cast<unsigned*>(O + rowg * OW1 + head * SSD_P + wq * 16 + fq * 4);
                    dst[0] = pack2(a1[0] + ea * a2[0], a1[1] + ea * a2[1]); dst[1] = pack2(a1[2] + ea * a2[2], a1[3] + ea * a2[3]);
                }
            }
            const float ea = fexp(ac[63]);
            bf16x8 fa0 = *reinterpret_cast<const bf16x8*>(xdtET + (wq * 16 + fr) * LDS_ + fq * 8);
            bf16x8 fa1 = *reinterpret_cast<const bf16x8*>(xdtET + (wq * 16 + fr) * LDS_ + 32 + fq * 8);
#pragma unroll
            for (int n = 0; n < 8; ++n) {
                f32x4 c = hs[n]; c[0] *= ea; c[1] *= ea; c[2] *= ea; c[3] *= ea;
                bf16x8 fb0 = *reinterpret_cast<const bf16x8*>(BT + (n * 16 + fr) * LDS_ + fq * 8);
                bf16x8 fb1 = *reinterpret_cast<const bf16x8*>(BT + (n * 16 + fr) * LDS_ + 32 + fq * 8);
                c = mfma16(fb0, fa0, c);
                hs[n] = mfma16(fb1, fa1, c);
            }
        }
        lds_barrier();
    }
}

__device__ void mlstm_unit(const Params& p, unsigned char* smem, int u) {
    constexpr int NP = ODD_PROJ_PAD, CH = ML_CH, VH = ML_DV / 2, LDD = 136, LDS_ = 72;
    const int dir = u / (BATCH * MLSTM_HEADS * 2), b = (u / (MLSTM_HEADS * 2)) % BATCH, h = (u >> 1) % MLSTM_HEADS, half = u & 1;
    const int tid = opaque_tid(), wid = tid >> 6, lane = tid & 63, fr = lane & 15, fq = lane >> 4;
    const bf16_t* P = reinterpret_cast<const bf16_t*>(p.ws + WS_P);
    const bf16_t* XC = reinterpret_cast<const bf16_t*>(p.ws + WS_AUX1);
    bf16_t* O = reinterpret_cast<bf16_t*>(p.ws + WS_O1) + (size_t)dir * T_ALL * OW1;
    bf16_t* qL = reinterpret_cast<bf16_t*>(smem);
    bf16_t* kL = qL + CH * LDD;
    bf16_t* vL = kL + CH * LDD;
    bf16_t* vT = vL + CH * LDD;
    bf16_t* kET = vT + VH * LDS_;
    bf16_t* Sc = kET + 128 * LDS_;
    float* Fv = reinterpret_cast<float*>(Sc + CH * LDS_);
    float* gv = Fv + 64; float* Mv = gv + 64; float* wint = Mv + 64; float* coef = wint + 64; float* den = coef + 64;
    float* nsv = den + 64;
    float* scal = nsv + 128;
    f32x4 Ct[8];
#pragma unroll
    for (int n = 0; n < 8; ++n) Ct[n] = f32x4{0.f, 0.f, 0.f, 0.f};
    if (tid < 128) nsv[tid] = 0.f;
    if (tid == 0) scal[0] = ML_M_INIT;
    const float ib = p.mlstm_i_bias[dir * MLSTM_HEADS + h], fb_ = p.mlstm_f_bias[dir * MLSTM_HEADS + h];
    const int lt = tid >> 4, lc = (tid & 15) * 8;
    U4 rq[2], rk[2], rv[2]; float rli = 0.f, rfg = 0.f;
    auto issue = [&](int j0) {
#pragma unroll
        for (int i = 0; i < 2; ++i) {
            const size_t rowg = (size_t)b * LSEQ + step_pos(dir, j0 + lt + 32 * i);
            const bf16_t* xr = XC + rowg * XC_W + SSD_CONV_CH + h * ML_DK + lc;
            rq[i] = ld16(xr); rk[i] = ld16(xr + ML_QKW);
            rv[i] = ld16(P + rowg * NP + SSD_PROJ + 2 * ML_QKW + h * ML_DV + half * VH + lc);
        }
        if (wid == 0) {
            const bf16_t* gr = P + ((size_t)b * LSEQ + step_pos(dir, j0 + lane)) * NP + SSD_PROJ + 2 * ML_QKW + 2 * ML_VW;
            rli = bf2f(gr[dir * MLSTM_HEADS + h]); rfg = bf2f(gr[2 * MLSTM_HEADS + dir * MLSTM_HEADS + h]);
        }
    };
    issue(0);
    lds_barrier();
    for (int j0 = 0; j0 < LSEQ; j0 += CH) {
#pragma unroll
        for (int i = 0; i < 2; ++i) {
            const int t = lt + 32 * i;
            st16(qL + t * LDD + lc, rq[i]); st16(kL + t * LDD + lc, scale8(rk[i], 0.08838834764831845f)); st16(vL + t * LDD + lc, rv[i]);
        }
        if (wid == 0) {
            const float li = rli + ib, fx = rfg + fb_;
            const float lf = -softplusf_(-fx);
            const float F = wave_incl_scan_add(lf, lane);
            const float gg = li - F;
            const float pm = wave_incl_scan_max(gg, lane);
            const float mc = scal[0];
            const float M = fmaxf(pm, mc);
            const float F63 = wave_last(F), pm63 = wave_last(pm);
            const float m_end = F63 + pm63, m_new = fmaxf(F63 + mc, m_end);
            Fv[lane] = F; gv[lane] = gg; Mv[lane] = M; wint[lane] = fexp(mc - M);
            coef[lane] = fexp(gg + F63 - m_new);
            if (lane == 0) { scal[1] = fexp(F63 + mc - m_new); scal[2] = m_new; }
        }
        lds_barrier();
        if (j0 + CH < LSEQ) issue(j0 + CH);
#pragma unroll
        for (int i = 0; i < 2; ++i) {
            const int it = tid + 512 * i, sg = it >> 7, d = it & 127;
            U4 kk = gather8(kL + (8 * sg) * LDD + d, LDD);
            const F4 c0 = ldf4(coef + 8 * sg), c1 = ldf4(coef + 8 * sg + 4);
            U4 ke; ke.x = pack2(lo2f(kk.x) * c0.x, hi2f(kk.x) * c0.y); ke.y = pack2(lo2f(kk.y) * c0.z, hi2f(kk.y) * c0.w);
            ke.z = pack2(lo2f(kk.z) * c1.x, hi2f(kk.z) * c1.y); ke.w = pack2(lo2f(kk.w) * c1.z, hi2f(kk.w) * c1.w);
            st16(kET + d * LDS_ + 8 * sg, ke);
            st16(vT + d * LDS_ + 8 * sg, gather8(vL + (8 * sg) * LDD + d, LDD));
        }
#pragma unroll
        for (int q = 0; q < 2; ++q) {
            const int tile = wid * 2 + q, ti = tile >> 2, si = tile & 3;
            f32x4 a = f32x4{0.f, 0.f, 0.f, 0.f};
#pragma unroll
            for (int ks = 0; ks < 4; ++ks) {
                bf16x8 fa = *reinterpret_cast<const bf16x8*>(qL + (ti * 16 + fr) * LDD + ks * 32 + fq * 8);
                bf16x8 fb = *reinterpret_cast<const bf16x8*>(kL + (si * 16 + fr) * LDD + ks * 32 + fq * 8);
                a = mfma16(fb, fa, a);
            }
            const int t = ti * 16 + fr, s0 = si * 16 + fq * 4;
            const float mt = Mv[t]; const F4 g4 = ldf4(gv + s0);
            const float e0 = s0 <= t ? a[0] * fexp(g4.x - mt) : 0.f, e1 = s0 + 1 <= t ? a[1] * fexp(g4.y - mt) : 0.f;
            const float e2 = s0 + 2 <= t ? a[2] * fexp(g4.z - mt) : 0.f, e3 = s0 + 3 <= t ? a[3] * fexp(g4.w - mt) : 0.f;
            unsigned* dst = reinterpret_cast<unsigned*>(Sc + t * LDS_ + s0);
            dst[0] = pack2(e0, e1); dst[1] = pack2(e2, e3);
        }
        lds_barrier();
        {
            const int t = tid >> 3, part = tid & 7;
            const U4 sv = ld16(Sc + t * LDS_ + part * 8);
            float rsum = (lo2f(sv.x) + hi2f(sv.x)) + (lo2f(sv.y) + hi2f(sv.y)) + (lo2f(sv.z) + hi2f(sv.z)) + (lo2f(sv.w) + hi2f(sv.w));
            const U4 q0 = ld16(qL + t * LDD + part * 16), q1 = ld16(qL + t * LDD + part * 16 + 8);
            const F4 n0 = ldf4(nsv + part * 16), n1 = ldf4(nsv + part * 16 + 4), n2 = ldf4(nsv + part * 16 + 8), n3 = ldf4(nsv + part * 16 + 12);
            float qn = lo2f(q0.x) * n0.x + hi2f(q0.x) * n0.y + lo2f(q0.y) * n0.z + hi2f(q0.y) * n0.w + lo2f(q0.z) * n1.x + hi2f(q0.z) * n1.y + lo2f(q0.w) * n1.z + hi2f(q0.w) * n1.w
                     + lo2f(q1.x) * n2.x + hi2f(q1.x) * n2.y + lo2f(q1.y) * n2.z + hi2f(q1.y) * n2.w + lo2f(q1.z) * n3.x + hi2f(q1.z) * n3.y + lo2f(q1.w) * n3.z + hi2f(q1.w) * n3.w;
            const float dsum = sum8(rsum + wint[t] * qn);
            if (part == 0) den[t] = dsum;
        }
        float nsnew;
        {
            const int d = tid >> 2, part = tid & 3;
            const U4 k0 = ld16(kET + d * LDS_ + part * 16), k1 = ld16(kET + d * LDS_ + part * 16 + 8);
            float acc = (lo2f(k0.x) + hi2f(k0.x)) + (lo2f(k0.y) + hi2f(k0.y)) + (lo2f(k0.z) + hi2f(k0.z)) + (lo2f(k0.w) + hi2f(k0.w))
                      + (lo2f(k1.x) + hi2f(k1.x)) + (lo2f(k1.y) + hi2f(k1.y)) + (lo2f(k1.z) + hi2f(k1.z)) + (lo2f(k1.w) + hi2f(k1.w));
            acc += dpp_f<0xB1>(acc); acc += dpp_f<0x4E>(acc);
            nsnew = scal[1] * nsv[d] + acc;
        }
        f32x4 num[4];
#pragma unroll
        for (int ti = 0; ti < 4; ++ti) {
            f32x4 a1 = f32x4{0.f, 0.f, 0.f, 0.f}, a2 = f32x4{0.f, 0.f, 0.f, 0.f};
#pragma unroll
            for (int ks = 0; ks < 2; ++ks) {
                bf16x8 fa = *reinterpret_cast<const bf16x8*>(Sc + (ti * 16 + fr) * LDS_ + ks * 32 + fq * 8);
                bf16x8 fb = *reinterpret_cast<const bf16x8*>(vT + (wid * 16 + fr) * LDS_ + ks * 32 + fq * 8);
                a1 = mfma16(fb, fa, a1);
            }
#pragma unroll
            for (int ks = 0; ks < 4; ++ks) {
                U4 su; su.x = pack2(Ct[2 * ks][0], Ct[2 * ks][1]); su.y = pack2(Ct[2 * ks][2], Ct[2 * ks][3]);
                su.z = pack2(Ct[2 * ks + 1][0], Ct[2 * ks + 1][1]); su.w = pack2(Ct[2 * ks + 1][2], Ct[2 * ks + 1][3]);
                const unsigned long long q0 = *reinterpret_cast<const unsigned long long*>(qL + (ti * 16 + fr) * LDD + ks * 32 + 4 * fq);
                const unsigned long long q1 = *reinterpret_cast<const unsigned long long*>(qL + (ti * 16 + fr) * LDD + ks * 32 + 16 + 4 * fq);
                U4 qu; qu.x = (unsigned)q0; qu.y = (unsigned)(q0 >> 32); qu.z = (unsigned)q1; qu.w = (unsigned)(q1 >> 32);
                a2 = mfma16(__builtin_bit_cast(bf16x8, su), __builtin_bit_cast(bf16x8, qu), a2);
            }
            const float wi = wint[ti * 16 + fr];
#pragma unroll
            for (int j = 0; j < 4; ++j) num[ti][j] = a1[j] + wi * a2[j];
        }
        lds_barrier();
        if ((tid & 3) == 0) nsv[tid >> 2] = nsnew;
        if (tid == 0) scal[0] = scal[2];
        if (step_pos(dir, j0) >= CTX_LEN) {
#pragma unroll
            for (int ti = 0; ti < 4; ++ti) {
                const int t = ti * 16 + fr;
                const size_t rowg = (size_t)b * LSEQ + step_pos(dir, j0 + t);
                const float inv = 1.0f / fmaxf(fabsf(den[t]), fexp(-(Mv[t] + Fv[t])));
                unsigned* dst = reinterpret_cast<unsigned*>(O + rowg * OW1 + SSD_INNER + h * ML_DV + half * VH + wid * 16 + fq * 4);
                dst[0] = pack2(num[ti][0] * inv, num[ti][1] * inv); dst[1] = pack2(num[ti][2] * inv, num[ti][3] * inv);
            }
        }
        {
            const float so = scal[1];
            bf16x8 fa0 = *reinterpret_cast<const bf16x8*>(vT + (wid * 16 + fr) * LDS_ + fq * 8);
            bf16x8 fa1 = *reinterpret_cast<const bf16x8*>(vT + (wid * 16 + fr) * LDS_ + 32 + fq * 8);
#pragma unroll
            for (int n = 0; n < 8; ++n) {
                f32x4 c = Ct[n]; c[0] *= so; c[1] *= so; c[2] *= so; c[3] *= so;
                bf16x8 fb0 = *reinterpret_cast<const bf16x8*>(kET + (n * 16 + fr) * LDS_ + fq * 8);
                bf16x8 fb1 = *reinterpret_cast<const bf16x8*>(kET + (n * 16 + fr) * LDS_ + 32 + fq * 8);
                c = mfma16(fb0, fa0, c);
                Ct[n] = mfma16(fb1, fa1, c);
            }
        }
        lds_barrier();
    }
}

template <int MODE = 0> __device__ void phase_scan1(const Params& p, unsigned char* smem) {
    constexpr int NU_S = 2 * BATCH * SSD_G * (SSD_HG / 2), NU_M = 2 * BATCH * MLSTM_HEADS * 2;
    static_assert(NU_S + NU_M == SCAN1_UNITS, "scan-1 units");
    if ((int)gridDim.x > SCAN1_UNITS && (int)blockIdx.x >= SCAN1_UNITS) convert_expert_weights<1>(p, blockIdx.x - SCAN1_UNITS, gridDim.x - SCAN1_UNITS, smem, 0, CVT_NDN);
    for (int u = blockIdx.x; u < NU_S + NU_M; u += gridDim.x) {
#ifndef PROBE_REPS_C
#define PROBE_REPS_C 1
#define PROBE_REPS_D 1
#endif
        if (u < NU_M) { for (int rep = 0; rep < PROBE_REPS_C; ++rep) mlstm_unit(p, smem, u); } else { for (int rep = 0; rep < PROBE_REPS_D; ++rep) ssd_unit(p, smem, u - NU_M); }
        __syncthreads();
    }
}

template <bool DRY> __device__ void phase_finish1(const Params& p) {
    constexpr int NP = ODD_PROJ_PAD;
    constexpr int NVS = SSD_INNER / 8, NIS = (NVS + 63) / 64, GVS = (SSD_INNER / SSD_G) / 8;
    constexpr int NVM = ML_VW / 8, NIM = (NVM + 63) / 64, GVM = ML_DV / 8;
    static_assert(GVS <= 64 && GVM <= 64 && (NVS % 64 == 0 || NVS < 64) && (NVM % 64 == 0 || NVM < 64), "finish1 layout");
    const int tid = opaque_tid(), lane = tid & 63, wv = (blockIdx.x * NT + tid) >> 6, nwv = gridDim.x * (NT / 64);
    const bf16_t* P = reinterpret_cast<const bf16_t*>(p.ws + WS_P);
    const bf16_t* XC = reinterpret_cast<const bf16_t*>(p.ws + WS_AUX1);
    bf16_t* O0 = reinterpret_cast<bf16_t*>(p.ws + WS_O1);
    const bf16_t* O1 = O0 + (size_t)T_ALL * OW1;
    for (int m = wv; m < T_LAT; m += nwv) {
        const int b = m / SEQ, j = m - b * SEQ;
        const size_t row = (size_t)b * LSEQ + CTX_LEN + j;
        bf16_t* o0 = O0 + row * OW1; const bf16_t* o1 = O1 + row * OW1;
        const bf16_t* pr = P + row * NP; const bf16_t* xr = XC + row * XC_W;
#pragma unroll
        for (int it = 0; it < NIS; ++it) {
            const int vi = lane + 64 * it; const bool act = vi < NVS; const int c = (act ? vi : 0) * 8;
            float x0[8], x1[8], xs[8], zg[8], nw[8], y[8];
            unpack8(ld16(o0 + c), x0); unpack8(ld16(o1 + c), x1); unpack8(ld16(xr + c), xs); unpack8(ld16(pr + c), zg); ldf8(p.ssd_norm_w + c, nw);
            const float dsk = p.ssd_d[c / SSD_P];
            float ss = 0.f;
#pragma unroll
            for (int i = 0; i < 8; ++i) { y[i] = (x0[i] + x1[i] + dsk * xs[i]) * siluf_(zg[i]); ss += y[i] * y[i]; }
            ss = group_sum_v<GVS>(act ? ss : 0.f) * (1.f / (SSD_INNER / SSD_G));
            const float rs = rsqrtf(ss + EPS);
#pragma unroll
            for (int i = 0; i < 8; ++i) y[i] *= rs * nw[i];
            if (act) { if (DRY) { sink(y[0]); sink(y[7]); } else st16(o0 + c, pack8f(y)); }
        }
#pragma unroll
        for (int it = 0; it < NIM; ++it) {
            const int vi = lane + 64 * it; const bool act = vi < NVM; const int c = (act ? vi : 0) * 8;
            float x0[8], x1[8], og[8], nw[8], y[8];
            unpack8(ld16(o0 + SSD_INNER + c), x0); unpack8(ld16(o1 + SSD_INNER + c), x1); unpack8(ld16(pr + SSD_PROJ + 2 * ML_QKW + ML_VW + c), og); ldf8(p.mlstm_norm_w + c, nw);
            float ss = 0.f;
#pragma unroll
            for (int i = 0; i < 8; ++i) { y[i] = x0[i] + x1[i]; ss += y[i] * y[i]; }
            ss = group_sum_v<GVM>(act ? ss : 0.f) * (1.f / ML_DV);
            const float rs = rsqrtf(ss + EPS);
#pragma unroll
            for (int i = 0; i < 8; ++i) y[i] *= rs * nw[i] * sigmoidf_(og[i]);
            if (act) { if (DRY) { sink(y[0]); sink(y[7]); } else st16(o0 + SSD_INNER + c, pack8f(y)); }
        }
    }
}

enum { PH_PRO = 0,
       PH_NORM1_0, PH_INPROJ_0, PH_PREP_0, PH_SCAN_0, PH_FIN_0, PH_OUTPROJ_0, PH_ROUTER_0, PH_SCATTER_0, PH_MOE1_0, PH_MOE2_0, PH_COMBINE_0,
       PH_INPROJ_1, PH_PREP_1, PH_SCAN_1, PH_FIN_1, PH_OUTPROJ_1, PH_ROUTER_1, PH_SCATTER_1, PH_MOE1_1, PH_MOE2_1, PH_COMBINE_1,
       PH_COUNT };

template <int PH, bool DRY = false> __device__ __forceinline__ void run_phase(const Params& p, unsigned char* smem) {
    if (PH == PH_PRO) phase_prologue(p, smem);
    else if (PH == PH_NORM1_0) phase_norm1<0>(p);
    else if (PH == PH_INPROJ_0) phase_inproj<0>(p, smem);
    else if (PH == PH_PREP_0) phase_prep0(p, smem);
#ifndef PROBE_SCAN_MODE
#define PROBE_SCAN_MODE 0
#endif
    else if (PH == PH_SCAN_0) { if (DRY) phase_scan0<PROBE_SCAN_MODE>(p, smem); else phase_scan0<0>(p, smem); }
    else if (PH == PH_FIN_0) phase_finish0<DRY>(p);
    else if (PH == PH_OUTPROJ_0) phase_outproj<0>(p, smem);
    else if (PH == PH_ROUTER_0) phase_router<0, DRY>(p, smem);
    else if (PH == PH_SCATTER_0) phase_scatter<0>(p, smem);
    else if (PH == PH_MOE1_0) phase_moe1<0, DRY>(p, smem);
    else if (PH == PH_MOE2_0) phase_moe2<0, DRY>(p, smem);
    else if (PH == PH_COMBINE_0) phase_combine<0, DRY>(p);
    else if (PH == PH_INPROJ_1) phase_inproj<1>(p, smem);
    else if (PH == PH_PREP_1) phase_prep1(p);
    else if (PH == PH_SCAN_1) { if (DRY) phase_scan1<PROBE_SCAN_MODE>(p, smem); else phase_scan1<0>(p, smem); }
    else if (PH == PH_FIN_1) phase_finish1<DRY>(p);
    else if (PH == PH_OUTPROJ_1) phase_outproj<1>(p, smem);
    else if (PH == PH_ROUTER_1) phase_router<1, DRY>(p, smem);
    else if (PH == PH_SCATTER_1) phase_scatter<1>(p, smem);
    else if (PH == PH_MOE1_1) phase_moe1<1>(p, smem);
    else if (PH == PH_MOE2_1) phase_moe2<1>(p, smem);
    else if (PH == PH_COMBINE_1) phase_combine<1, DRY>(p);
}

template <int PH> __global__ void __launch_bounds__(NT, 2) k_phase(Params p) {
    SMEM_DECL;
    run_phase<PH>(p, smem);
}

constexpr int SMEM_BYTES = 160 * 1024;

#ifdef EMU
struct GridBar { int dummy; };
__device__ __forceinline__ void grid_sync(const GridBar&) { emu_grid_barrier(); }
#else
typedef XcdBarrier GridBar;
__device__ __forceinline__ void grid_sync(const GridBar& b) { xcd_barrier(b); }
#endif
#ifndef PROBE_MASK
#define PROBE_MASK 0u
#endif
#ifndef PROBE_DRY_MASK
#define PROBE_DRY_MASK 0u
#endif
#ifndef PROBE_BAR2
#define PROBE_BAR2 0
#endif
template <int PH> __device__ __forceinline__ void run_from(const Params& p, unsigned char* smem, const GridBar& bar) {
    if constexpr ((PROBE_DRY_MASK >> PH) & 1u) { run_phase<PH, true>(p, smem); grid_sync(bar); }
    run_phase<PH>(p, smem);
    if constexpr ((PROBE_MASK >> PH) & 1u) { grid_sync(bar); run_phase<PH>(p, smem); }
    if constexpr (PH + 1 < PH_COUNT) { grid_sync(bar); if (PROBE_BAR2) grid_sync(bar); run_from<PH + 1>(p, smem, bar); }
}
__global__ void __launch_bounds__(NT, 2) k_mega(Params p) {
    SMEM_DECL;
#ifdef EMU
    GridBar bar{0};
#else
    if (threadIdx.x == 0) *reinterpret_cast<U4*>(smem + SMEM_BYTES - 16) = U4{0u, 0u, 0u, 0u};
    __syncthreads();
    GridBar bar = xcd_barrier_post(reinterpret_cast<unsigned*>(p.ws + WS_BAR), (volatile LAS unsigned*)(smem + SMEM_BYTES - 16));
#endif
    run_from<0>(p, smem, bar);
}

static Params make_params(void* const* d_in, void* d_out, void* d_ws) {
    Params p{};
    const float** f = reinterpret_cast<const float**>(&p);
    for (int i = 0; i < 45; ++i) f[i] = (const float*)d_in[i];
    p.out = (float*)d_out; p.ws = (unsigned char*)d_ws;
    return p;
}

#ifdef EMU
int emu_last_phase = PH_COUNT;
#endif
template <int PH> static void launch_phases(const Params& p, int grid, hipStream_t stream) {
    if constexpr (PH < PH_COUNT) {
#ifdef EMU
        if (PH >= emu_last_phase) return;
#else
        (void)hipFuncSetAttribute((const void*)k_phase<PH>, hipFuncAttributeMaxDynamicSharedMemorySize, SMEM_BYTES);
#endif
        hipLaunchKernelGGL(k_phase<PH>, dim3(grid), dim3(NT), SMEM_BYTES, stream, p);
        launch_phases<PH + 1>(p, grid, stream);
    }
}

#ifndef MK_MULTI
#define MK_MULTI 0
#endif
extern "C" void kernel_launch(void* const* d_in, const int* in_sizes, int n_in, void* d_out, int out_size, void* d_ws, size_t ws_size,
                              hipStream_t stream) {
    Params p = make_params(d_in, d_out, d_ws);
#ifdef EMU
    int grid = getenv("EMU_GRID") ? atoi(getenv("EMU_GRID")) : 4;
    if (emu_last_phase < PH_COUNT) { launch_phases<0>(p, grid, stream); return; }
    hipLaunchKernelGGL(k_mega, dim3(grid), dim3(NT), SMEM_BYTES, stream, p);
#else
    static int grid = 0;
    if (!grid) {
        int dev = 0, cus = 0, per_cu = 0;
        (void)hipGetDevice(&dev);
        (void)hipDeviceGetAttribute(&cus, hipDeviceAttributeMultiprocessorCount, dev);
        (void)hipFuncSetAttribute((const void*)k_mega, hipFuncAttributeMaxDynamicSharedMemorySize, SMEM_BYTES);
        (void)hipOccupancyMaxActiveBlocksPerMultiprocessor(&per_cu, k_mega, NT, SMEM_BYTES);
        grid = (per_cu >= 1) ? cus : 0;
        if (grid > 256) grid = 256;
    }
    if (MK_MULTI || grid == 0) { launch_phases<0>(p, 256, stream); return; }
    (void)hipMemsetAsync((unsigned char*)d_ws + WS_BAR, 0, XCD_BAR_WORDS * sizeof(unsigned), stream);
    hipLaunchKernelGGL(k_mega, dim3(grid), dim3(NT), SMEM_BYTES, stream, p);
#endif
}
```

```cpp
#ifdef EMU
#include "hipemu.h"
#else
#include <hip/hip_runtime.h>
#include <cstdio>
#include <cstdint>
#endif

#ifdef SMALL_CFG
constexpr int D_MODEL = 256, BATCH = 2, SEQ = 256, GRID_W = 16, CTX_LEN = 128;
constexpr int RWKV_HEADS = 2, HGRN_HEADS = 1, SSD_HEADS = 4, MLSTM_HEADS = 1, N_EXPERTS = 8, D_FF = 256;
#else
constexpr int D_MODEL = 1024, BATCH = 8, SEQ = 4096, GRID_W = 64, CTX_LEN = 256;
constexpr int RWKV_HEADS = 8, HGRN_HEADS = 4, SSD_HEADS = 16, MLSTM_HEADS = 4, N_EXPERTS = 32, D_FF = 1024;
#endif
#ifndef PROBE_PREP0
#define PROBE_PREP0 1
#endif
#ifndef PROBE_HG_C
#define PROBE_HG_C 1
#endif
#ifndef PROBE_HG_A
#define PROBE_HG_A 1
#define PROBE_HG_B 1
#endif
#ifndef PROBE_REPS_A
#define PROBE_REPS_A 1
#define PROBE_REPS_B 1
#endif
constexpr int DEPTH = 2, N_MOD = 6;
constexpr float EPS = 1e-6f;
constexpr int GRID_ROWS = SEQ / GRID_W;
constexpr int LSEQ = CTX_LEN + SEQ;
constexpr int T_CTX = BATCH * CTX_LEN, T_LAT = BATCH * SEQ, T_ALL = BATCH * LSEQ;
constexpr int RWKV_N = 64, RWKV_W = RWKV_HEADS * RWKV_N, RWKV_DR = 64, RWKV_AR = 64, RWKV_GR = 128;
constexpr float RWKV_GN_EPS = 64e-5f;
constexpr int RWKV_PROJ = 3 * RWKV_W + 2 * RWKV_DR + 2 * RWKV_AR + RWKV_GR;
constexpr int HG_DK = 128, HG_DV = 128, HG_KW = HGRN_HEADS * HG_DK, HG_VW = HGRN_HEADS * HG_DV, HG_CH = 32;
constexpr int HGRN_PROJ = HG_KW + 2 * HG_KW + 2 * HG_VW;
constexpr int EVEN_PROJ = RWKV_PROJ + HGRN_PROJ, EVEN_OUT = RWKV_W + HG_VW;
constexpr int SSD_P = 64, SSD_INNER = SSD_HEADS * SSD_P, SSD_G = 2, SSD_N = 128, SSD_CH = 64, SSD_HG = SSD_HEADS / SSD_G;
constexpr int SSD_CONV_CH = SSD_INNER + 2 * SSD_G * SSD_N, SSD_PROJ = SSD_INNER + SSD_CONV_CH + 2 * SSD_HEADS;
constexpr int ML_DK = 128, ML_DV = 256, ML_QKW = MLSTM_HEADS * ML_DK, ML_VW = MLSTM_HEADS * ML_DV, ML_CH = 64;
constexpr float ML_M_INIT = -1e30f;
constexpr int MLSTM_PROJ = 2 * ML_QKW + 2 * ML_VW + 4 * MLSTM_HEADS;
constexpr int ODD_PROJ = SSD_PROJ + MLSTM_PROJ, ODD_OUT = SSD_INNER + ML_VW;
constexpr int TOP_K = 4;
constexpr float SWIGLU_LIMIT = 7.0f, SWIGLU_ALPHA = 1.702f;

constexpr int NT = 512;
constexpr int BM = 256, BN = 256;
constexpr int rup(int a, int b) { return (a + b - 1) / b * b; }
constexpr int EVEN_PROJ_PAD = rup(EVEN_PROJ, BN), ODD_PROJ_PAD = rup(ODD_PROJ, BN);
constexpr int PROJ_PAD_MAX = EVEN_PROJ_PAD > ODD_PROJ_PAD ? EVEN_PROJ_PAD : ODD_PROJ_PAD;
constexpr int AUX0_W = 8 * RWKV_W;
constexpr int XC_W = SSD_CONV_CH + 2 * ML_QKW;
constexpr int OW0 = EVEN_OUT, OW1 = ODD_OUT, OW_MAX = OW0 > OW1 ? OW0 : OW1;
constexpr int T_MOE0 = T_ALL, T_MOE1 = T_LAT;
constexpr int MOE_ROWS_MAX = T_MOE0 * TOP_K + N_EXPERTS * BM;
constexpr int MAX_MTILES = MOE_ROWS_MAX / BM;
static_assert(T_ALL % BM == 0 && T_LAT % BM == 0, "row tiles");
static_assert(CTX_LEN % 64 == 0 && SEQ % 64 == 0, "chunk alignment");
static_assert(D_MODEL % BN == 0 && (2 * D_FF) % BN == 0 && D_MODEL % 128 == 0 && D_FF % 128 == 0, "tiles");

typedef unsigned short bf16_t;
#ifndef EMU
typedef short bf16x8 __attribute__((ext_vector_type(8)));
typedef float f32x4 __attribute__((ext_vector_type(4)));
#define mfma16(a, b, c) __builtin_amdgcn_mfma_f32_16x16x32_bf16(a, b, c, 0, 0, 0)
#define SMEM_DECL extern __shared__ __attribute__((aligned(16))) unsigned char smem[]
#else
#define mfma16(a, b, c) emu_mfma_16x16x32_bf16(a, b, c)
#define SMEM_DECL unsigned char* smem = emu_cur->blk->smem
#endif

constexpr size_t al256(size_t x) { return (x + 255) / 256 * 256; }
constexpr size_t WS_BAR = 0;
constexpr size_t WS_CNT = 16384;
constexpr size_t WS_MOD = WS_CNT + 4096;
constexpr size_t WS_LB = al256(WS_MOD + sizeof(float) * 2 * (BATCH + 1) * N_MOD * D_MODEL);
constexpr size_t WS_WIN0 = al256(WS_LB + sizeof(float) * HG_KW);
constexpr size_t WS_WIN1 = al256(WS_WIN0 + 2ull * EVEN_PROJ_PAD * D_MODEL);
constexpr size_t WS_WOUT0 = al256(WS_WIN1 + 2ull * ODD_PROJ_PAD * D_MODEL);
constexpr size_t WS_WOUT1 = al256(WS_WOUT0 + 2ull * D_MODEL * EVEN_OUT);
constexpr size_t WS_XC = al256(WS_WOUT1 + 2ull * D_MODEL * ODD_OUT);
constexpr size_t WS_LRW = al256(WS_XC + 4ull * T_CTX * D_MODEL);
constexpr size_t WS_TOPE = al256(WS_LRW + 2ull * RWKV_W * (2 * RWKV_DR + 2 * RWKV_AR + RWKV_GR));
constexpr size_t WS_TOPP = al256(WS_TOPE + 4ull * T_MOE0 * TOP_K);
constexpr size_t WS_RANK = al256(WS_TOPP + 4ull * T_MOE0 * TOP_K);
constexpr size_t WS_POSOF = al256(WS_RANK + 4ull * T_MOE0 * TOP_K);
constexpr size_t WS_TOKOF = al256(WS_POSOF + 4ull * T_MOE0 * TOP_K);
constexpr size_t WS_H = al256(WS_TOKOF + 4ull * MOE_ROWS_MAX);
constexpr size_t WS_BIG = al256(WS_H + 2ull * T_ALL * D_MODEL);
constexpr size_t WS_P = WS_BIG;
constexpr size_t WS_AUX0 = al256(WS_P + 2ull * T_ALL * EVEN_PROJ_PAD);
constexpr size_t WS_O0 = al256(WS_AUX0 + 2ull * T_ALL * AUX0_W);
constexpr size_t WS_END0 = al256(WS_O0 + 2ull * 2 * T_ALL * OW0);
constexpr size_t WS_AUX1 = al256(WS_P + 2ull * T_ALL * ODD_PROJ_PAD);
constexpr size_t WS_O1 = al256(WS_AUX1 + 2ull * T_ALL * XC_W);
constexpr size_t WS_END1 = al256(WS_O1 + 2ull * 2 * T_ALL * OW1);
constexpr size_t WS_END_MIX = WS_END0 > WS_END1 ? WS_END0 : WS_END1;
constexpr size_t WS_H1 = WS_BIG;
constexpr size_t WS_Y = al256(WS_H1 + 2ull * MOE_ROWS_MAX * D_FF);
constexpr size_t WS_YEND = al256(WS_Y + 2ull * MOE_ROWS_MAX * D_MODEL);
constexpr size_t WS_WGU = WS_END0 > WS_YEND ? WS_END0 : WS_YEND;
constexpr size_t WS_WDN = al256(WS_WGU + 2ull * N_EXPERTS * 2 * D_FF * D_MODEL);
constexpr size_t WS_END_MOE = al256(WS_WDN + 2ull * N_EXPERTS * D_MODEL * D_FF);
constexpr size_t WS_TOTAL = WS_END_MIX > WS_END_MOE ? WS_END_MIX : WS_END_MOE;
#ifndef SMALL_CFG
static_assert(WS_TOTAL <= (1ull << 30), "workspace exceeds 1 GiB");
#endif

struct Params {
    const float *x, *c, *ctx, *c_ctx, *ada_w, *ada_b, *norm1_w, *norm2_w, *even_w_in, *even_w_out, *rwkv_mu, *rwkv_w0,
        *rwkv_w2, *rwkv_a0, *rwkv_a2, *rwkv_g2, *rwkv_k_k, *rwkv_k_a, *rwkv_r_k, *rwkv_ln_w, *rwkv_ln_b,
        *hgrn_lower_bounds, *hgrn_norm_w, *odd_w_in, *odd_w_out, *ssd_conv_w, *ssd_conv_b, *ssd_dt_bias,
        *ssd_a_log, *ssd_d, *ssd_norm_w, *mlstm_conv_w, *mlstm_conv_b, *mlstm_i_bias, *mlstm_f_bias,
        *mlstm_norm_w, *router_w, *router_b, *exp_w_gate, *exp_b_gate, *exp_w_up, *exp_b_up, *exp_w_down,
        *exp_b_down, *final_norm_w;
    float* out;
    unsigned char* ws;
};

#ifdef EMU
__device__ __forceinline__ bf16_t f2bf(float f) {
    unsigned u = __builtin_bit_cast(unsigned, f);
    u += 0x7FFFu + ((u >> 16) & 1u);
    return (bf16_t)(u >> 16);
}
#else
__device__ __forceinline__ bf16_t f2bf(float f) { return __builtin_bit_cast(bf16_t, (__bf16)f); }
#endif
__device__ __forceinline__ float bf2f(bf16_t h) { return __builtin_bit_cast(float, ((unsigned)h) << 16); }
#ifdef EMU
__device__ __forceinline__ unsigned pack2(float a, float b) { return (unsigned)f2bf(a) | ((unsigned)f2bf(b) << 16); }
__device__ __forceinline__ float flog(float x) { return logf(x); }
#else
typedef __bf16 bf16x2_hw __attribute__((ext_vector_type(2)));
typedef float f32x2_hw __attribute__((ext_vector_type(2)));
__device__ __forceinline__ unsigned pack2(float a, float b) {
    return __builtin_bit_cast(unsigned, __builtin_convertvector(f32x2_hw{a, b}, bf16x2_hw));
}
__device__ __forceinline__ float flog(float x) { return __builtin_amdgcn_logf(x) * 0.6931471805599453f; }
#endif
__device__ __forceinline__ float lo2f(unsigned u) { return __builtin_bit_cast(float, u << 16); }
__device__ __forceinline__ float hi2f(unsigned u) { return __builtin_bit_cast(float, u & 0xFFFF0000u); }
#ifdef EMU
__device__ __forceinline__ float fexp(float x) { return expf(x); }
__device__ __forceinline__ float frcp(float x) { return 1.0f / x; }
#else
__device__ __forceinline__ float fexp(float x) { return __builtin_amdgcn_exp2f(x * 1.4426950408889634f); }
__device__ __forceinline__ float frcp(float x) { return __builtin_amdgcn_rcpf(x); }
#endif
__device__ __forceinline__ float sigmoidf_(float x) { return frcp(1.0f + fexp(-x)); }
__device__ __forceinline__ float siluf_(float x) { return x * frcp(1.0f + fexp(-x)); }
__device__ __forceinline__ float softplusf_(float x) { return x > 20.f ? x : log1pf(expf(x)); }
__device__ __forceinline__ float wave_sum(float v) {
#pragma unroll
    for (int m = 32; m >= 1; m >>= 1) v += __shfl_xor(v, m, 64);
    return v;
}
#ifdef EMU
__device__ __forceinline__ void wave_sync() { int z = 0; (void)emu_wave_exchange(&z, 4); }
#else
__device__ __forceinline__ void wave_sync() { __builtin_amdgcn_fence(__ATOMIC_RELEASE, "wavefront"); __builtin_amdgcn_wave_barrier(); __builtin_amdgcn_fence(__ATOMIC_ACQUIRE, "wavefront"); }
#endif
__device__ __forceinline__ int opaque_tid() {
    int t = threadIdx.x;
#ifndef EMU
    asm volatile("" : "+v"(t));
#endif
    return t;
}
template <class T> __device__ __forceinline__ void sink(T v) {
#ifndef EMU
    asm volatile("" :: "v"(v));
#endif
}
__device__ __forceinline__ void lds_barrier() {
#ifdef EMU
    __syncthreads();
#else
    asm volatile("s_waitcnt lgkmcnt(0)" ::: "memory");
    __builtin_amdgcn_s_barrier();
    asm volatile("" ::: "memory");
#endif
}
struct alignas(16) U4 { unsigned x, y, z, w; };
__device__ __forceinline__ U4 ld16(const void* p) { return *reinterpret_cast<const U4*>(p); }
__device__ __forceinline__ void st16(void* p, U4 v) { *reinterpret_cast<U4*>(p) = v; }
struct alignas(16) F4 { float x, y, z, w; };
__device__ __forceinline__ F4 ldf4(const float* p) { return *reinterpret_cast<const F4*>(p); }

__device__ __forceinline__ void unpack8(const U4& u, float (&f)[8]) {
    f[0] = lo2f(u.x); f[1] = hi2f(u.x); f[2] = lo2f(u.y); f[3] = hi2f(u.y); f[4] = lo2f(u.z); f[5] = hi2f(u.z); f[6] = lo2f(u.w); f[7] = hi2f(u.w);
}
__device__ __forceinline__ void ldf8(const float* p, float (&f)[8]) {
    const F4 a = ldf4(p), b = ldf4(p + 4); f[0] = a.x; f[1] = a.y; f[2] = a.z; f[3] = a.w; f[4] = b.x; f[5] = b.y; f[6] = b.z; f[7] = b.w;
}
__device__ __forceinline__ U4 pack8f(const float (&f)[8]) { U4 o; o.x = pack2(f[0], f[1]); o.y = pack2(f[2], f[3]); o.z = pack2(f[4], f[5]); o.w = pack2(f[6], f[7]); return o; }

template <int LAYER> __device__ __forceinline__ int lat_nat(int j) {
    if (LAYER == 0) return j;
    int w = j / GRID_ROWS, r = j - w * GRID_ROWS;
    return r * GRID_W + w;
}
__device__ __forceinline__ int step_pos(int dir, int j) {
    if (dir == 0) return j;
    return j < CTX_LEN ? CTX_LEN - 1 - j : LSEQ + CTX_LEN - 1 - j;
}

#ifndef EMU
#define XB_TMO      128
#define XB_XCNT(j)  (256  + 64 * (j))
#define XB_XSUB(j)  (1280 + 64 * (j))
#define XB_XGEN(j)  (2304 + 64 * (j))
#define XB_TOP      3328
#define XB_TOPGEN   3392
#define XCD_BAR_WORDS 3456
#define XB_SPIN_CAP (1u << 22)
#define LAS __attribute__((address_space(3)))
__device__ __forceinline__ unsigned xb_ld(unsigned* p)              { return __hip_atomic_load(p, __ATOMIC_RELAXED, __HIP_MEMORY_SCOPE_AGENT); }
__device__ __forceinline__ unsigned xb_add(unsigned* p, unsigned v) { return __hip_atomic_fetch_add(p, v, __ATOMIC_RELAXED, __HIP_MEMORY_SCOPE_AGENT); }
__device__ __forceinline__ unsigned xb_xcc_id() { return (unsigned)__builtin_amdgcn_s_getreg((3 << 11) | 20) & 0xFu; }
#define XB_SPIN(cond, bar) do { unsigned _sp = 0; while (cond) { __builtin_amdgcn_s_sleep(1); \
    if ((++_sp & 255u) == 0u) { if (xb_ld(&(bar)[XB_TMO])) break; if (_sp > XB_SPIN_CAP) { atomicAdd(&(bar)[XB_TMO], 1u); break; } } } } while (0)
struct XcdBarrier { unsigned* bar; unsigned x; volatile LAS unsigned* st; };
__device__ __forceinline__ XcdBarrier xcd_barrier_post(unsigned* bar, volatile LAS unsigned* st) {
    XcdBarrier b; b.bar = bar; b.x = xb_xcc_id(); b.st = st;
    if (threadIdx.x == 0) (void)xb_add(&bar[XB_XCNT(b.x)], 1u);
    return b;
}
__device__ __forceinline__ void xcd_barrier_complete(unsigned* bar, unsigned x, unsigned& nloc, unsigned& nx) {
    const unsigned G = gridDim.x * gridDim.y * gridDim.z;
    unsigned sum, cnt, mine, sp = 0u;
    for (;;) {
        sum = 0u; cnt = 0u; mine = 0u;
#pragma unroll
        for (unsigned j = 0; j < 16; ++j) { const unsigned c = xb_ld(&bar[XB_XCNT(j)]); sum += c; cnt += (c > 0u) ? 1u : 0u; mine = (j == x) ? c : mine; }
        if (sum == G) break;
        __builtin_amdgcn_s_sleep(1);
        if ((++sp & 255u) == 0u) { if (xb_ld(&bar[XB_TMO])) break; if (sp > XB_SPIN_CAP) { atomicAdd(&bar[XB_TMO], 1u); break; } }
    }
    nloc = mine > 0u ? mine : 1u; nx = cnt > 0u ? cnt : 1u;
}
__device__ __forceinline__ void xcd_barrier(const XcdBarrier& b) {
    asm volatile("s_waitcnt vmcnt(0)" ::: "memory");
    __syncthreads();
    if (threadIdx.x == 0) {
        unsigned* bar = b.bar;
        __builtin_amdgcn_s_waitcnt(0);
        unsigned nloc = b.st[0], nx = b.st[1];
        if (nloc == 0u) { xcd_barrier_complete(bar, b.x, nloc, nx); b.st[0] = nloc; b.st[1] = nx; }
        const unsigned old = xb_add(&bar[XB_XSUB(b.x)], 1u);
        const unsigned gen = old / nloc;
        if (old + 1u == (gen + 1u) * nloc) {
            __builtin_amdgcn_fence(__ATOMIC_RELEASE, "agent");
            asm volatile("s_waitcnt vmcnt(0)" ::: "memory");
            const unsigned og = xb_add(&bar[XB_TOP], 1u);
            const unsigned tg = og / nx;
            if (og + 1u == (tg + 1u) * nx) xb_add(&bar[XB_TOPGEN], 1u);
            else XB_SPIN(xb_ld(&bar[XB_TOPGEN]) == tg, bar);
            __builtin_amdgcn_fence(__ATOMIC_ACQUIRE, "agent");
            xb_add(&bar[XB_XGEN(b.x)], 1u);
            asm volatile("s_waitcnt vmcnt(0)" ::: "memory");
        } else {
            XB_SPIN(xb_ld(&bar[XB_XGEN(b.x)]) == gen, bar);
            __builtin_amdgcn_fence(__ATOMIC_ACQUIRE, "agent");
            asm volatile("s_waitcnt vmcnt(0)" ::: "memory");
        }
    }
    __syncthreads();
}
#endif

namespace g8 {
#ifdef EMU
#define G8_LAS
__device__ __forceinline__ void glds16(const void* g, unsigned char* l) { memcpy(l + emu_cur->lane * 16, g, 16); }
#define G8_WAIT_V(n) do {} while (0)
#define G8_WAIT_L(n) do {} while (0)
#define G8_BAR __syncthreads()
#define G8_SCHED do {} while (0)
#define G8_PRIO(x) do {} while (0)
#else
#define G8_LAS __attribute__((address_space(3)))
__device__ __forceinline__ void glds16(const void* g, G8_LAS unsigned char* l) { __builtin_amdgcn_global_load_lds((const unsigned*)g, (G8_LAS unsigned*)l, 16, 0, 0); }
#define G8_WAIT_V(n) asm volatile("s_waitcnt vmcnt(" #n ")" ::: "memory")
#define G8_WAIT_L(n) asm volatile("s_waitcnt lgkmcnt(" #n ")" ::: "memory")
#define G8_BAR __builtin_amdgcn_s_barrier()
#define G8_SCHED __builtin_amdgcn_sched_barrier(0)
#define G8_PRIO(x) __builtin_amdgcn_s_setprio(x)
#endif
constexpr int TM = 256, TK = 64, HALF = 128, HTB = HALF * TK * 2, STAGE_BYTES = 8 * HTB, NXCD = 8, WGM = 8;
__device__ __forceinline__ int lds_byte(int r, int c) { const int st = (r >> 4) * 2 + (c >> 5), rr = r & 15, cc = c & 31, ob = rr * 64 + cc * 2; return st * 1024 + (ob ^ (((ob >> 9) & 1) << 5)); }
__device__ __forceinline__ void stage_rc(int b, int& R, int& C) { const int st = b / 1024, sb = b % 1024, swz = sb ^ (((sb >> 9) & 1) << 5); R = (st >> 1) * 16 + swz / 64; C = (st & 1) * 32 + (swz % 64) / 2; }
__device__ __forceinline__ int perm32(int rho) { const int n = rho >> 4, i = rho & 15; return 8 * (i >> 2) + 4 * n + (i & 3); }
__device__ __forceinline__ bool unit_of(int L, int nM, int nN, int& pm, int& pn) {
    const int nwg = nM * nN; if (L >= nwg) return false;
    int wgid = L; { const int q = nwg / NXCD, r = nwg % NXCD, xcd = wgid % NXCD, off = wgid / NXCD; wgid = (xcd < r ? xcd * (q + 1) : r * (q + 1) + (xcd - r) * q) + off; }
    const int nig = WGM * nN, gid = wgid / nig, fm = gid * WGM, gsz = (nM - fm) < WGM ? (nM - fm) : WGM;
    pm = fm + ((wgid % nig) % gsz); pn = (wgid % nig) / gsz; return true;
}

template <class Prob>
__device__ __forceinline__ void gemm_phase(unsigned char* smem, const Prob& pr) {
#ifdef EMU
    unsigned char* lds = smem;
#else
    G8_LAS unsigned char* lds = (G8_LAS unsigned char*)smem;
#endif
    const int tid = opaque_tid(), lane = tid & 63, fr = lane & 15, fq = lane >> 4;
#ifdef EMU
    const int wid = tid >> 6;
#else
    const int wid = __builtin_amdgcn_readfirstlane(tid >> 6);
#endif
    const int wr = wid >> 2, wc = wid & 3;
    constexpr int K = Prob::K, nt = K / TK;
    static_assert(K % 128 == 0 && K >= 256, "K");
    const int nM = pr.nM(), nN = pr.nN(), G = gridDim.x, c = blockIdx.x;
    int Rp[2], Cp[2]; unsigned voffB[2];
#pragma unroll
    for (int i = 0; i < 2; ++i) { int R, C; stage_rc(tid * 16 + i * 8192, R, C); Rp[i] = R; Cp[i] = C; const int Rb = Prob::PERM ? ((R & ~31) + perm32(R & 31)) : R; voffB[i] = (unsigned)(Rb * K + C) * 2u; }
    constexpr size_t kstep = (size_t)(TK * 2), hstepB = (size_t)HALF * K * 2, tstepB = 2 * hstepB;
    const unsigned ldsw = (unsigned)wid * 1024u;
    const int aoff = lds_byte(wr * 64 + fr, fq * 8), boff = lds_byte(wc * 32 + fr, fq * 8);
#define G8_SA(b, h) (((b) * 2 + (h)) * HTB)
#define G8_SB(b, h) ((4 + (b) * 2 + (h)) * HTB)
#define G8_STAGE(bufoff, gbase, voff) do { _Pragma("unroll") for (int _i = 0; _i < 2; ++_i) glds16((const char*)(gbase) + (voff)[_i], lds + (bufoff) + ldsw + _i * 8192); } while (0)
#define G8_LDA(dst, b, h) do { _Pragma("unroll") for (int m = 0; m < 4; ++m) _Pragma("unroll") for (int k = 0; k < 2; ++k) dst[m][k] = *(const G8_LAS bf16x8*)(lds + G8_SA(b, h) + aoff + m * 2048 + k * 1024); } while (0)
#define G8_LDB(dst, b, h) do { _Pragma("unroll") for (int n = 0; n < 2; ++n) _Pragma("unroll") for (int k = 0; k < 2; ++k) dst[n][k] = *(const G8_LAS bf16x8*)(lds + G8_SB(b, h) + boff + n * 2048 + k * 1024); } while (0)
#define G8_MMA(ai, bj, At, Bt) do { G8_PRIO(1); _Pragma("unroll") for (int m = 0; m < 4; ++m) _Pragma("unroll") for (int n = 0; n < 2; ++n) _Pragma("unroll") for (int k = 0; k < 2; ++k) \
        acc[ai][bj][m][n] = mfma16(Bt[n][k], At[m][k], acc[ai][bj][m][n]); G8_PRIO(0); } while (0)
    int pm, pn, npm = 0, npn = 0, ui = 0;
    if (!unit_of(c, nM, nN, pm, pn)) return;
    f32x4 acc[2][2][4][2];
#pragma unroll
    for (int a = 0; a < 2; ++a)
#pragma unroll
        for (int b = 0; b < 2; ++b)
#pragma unroll
            for (int m = 0; m < 4; ++m)
#pragma unroll
                for (int n = 0; n < 2; ++n) acc[a][b][m][n] = f32x4{0.f, 0.f, 0.f, 0.f};
    bf16x8 At[4][2], B0[2][2], B1[2][2];
    const char* const Ab = pr.a_base();
    unsigned ca0[2], ca1[2], na0[2], na1[2];
#pragma unroll
    for (int i = 0; i < 2; ++i) { ca0[i] = pr.a_off(pm, Rp[i]) + (unsigned)Cp[i] * 2u; ca1[i] = pr.a_off(pm, HALF + Rp[i]) + (unsigned)Cp[i] * 2u; na0[i] = ca0[i]; na1[i] = ca1[i]; }
    const char* cB = pr.b_base(pm, pn);
    G8_STAGE(G8_SB(0, 0), cB, voffB); G8_STAGE(G8_SA(0, 0), Ab, ca0); G8_STAGE(G8_SB(0, 1), cB + hstepB, voffB); G8_STAGE(G8_SA(0, 1), Ab, ca1);
    if (wr == 1) G8_BAR;
    G8_WAIT_V(4); G8_BAR;
    G8_STAGE(G8_SB(1, 0), cB + kstep, voffB); G8_STAGE(G8_SA(1, 0), Ab + kstep, ca0); G8_STAGE(G8_SB(1, 1), cB + hstepB + kstep, voffB);
    G8_WAIT_V(6); G8_BAR;
    for (;;) {
        const bool has_next = unit_of((ui + 1) * G + c, nM, nN, npm, npn);
        const char* nB = has_next ? pr.b_base(npm, npn) : cB;
        for (int t = 0; t < nt; t += 2) {
            const bool last = (t == nt - 2);
            if (last) {
                if (has_next) {
#pragma unroll
                    for (int i = 0; i < 2; ++i) { na0[i] = pr.a_off(npm, Rp[i]) + (unsigned)Cp[i] * 2u; na1[i] = pr.a_off(npm, HALF + Rp[i]) + (unsigned)Cp[i] * 2u; }
                } else {
#pragma unroll
                    for (int i = 0; i < 2; ++i) { na0[i] = ca0[i]; na1[i] = ca1[i]; }
                }
            }
            const char* a1 = Ab + (size_t)(t + 1) * kstep;
            const char* a2 = last ? Ab : Ab + (size_t)(t + 2) * kstep; const char* b2 = last ? nB : cB + (size_t)(t + 2) * kstep;
            const char* a3 = a2 + kstep; const char* b3 = b2 + kstep;
            G8_LDB(B0, 0, 0); G8_SCHED; G8_LDA(At, 0, 0); G8_STAGE(G8_SA(1, 1), a1, ca1);
            G8_WAIT_L(8); G8_BAR; G8_WAIT_L(0); G8_MMA(0, 0, At, B0); G8_BAR; G8_SCHED;
            G8_LDB(B1, 0, 1); G8_STAGE(G8_SB(0, 0), b2, voffB);
            G8_BAR; G8_WAIT_L(0); G8_MMA(0, 1, At, B1); G8_BAR;
            G8_LDA(At, 0, 1); if (last) { G8_STAGE(G8_SA(0, 0), a2, na0); } else { G8_STAGE(G8_SA(0, 0), a2, ca0); }
            G8_BAR; G8_WAIT_L(0); G8_MMA(1, 0, At, B0); G8_BAR; G8_SCHED;
            G8_STAGE(G8_SB(0, 1), b2 + hstepB, voffB);
            G8_WAIT_V(6); G8_BAR; G8_MMA(1, 1, At, B1); G8_BAR;
            G8_LDB(B0, 1, 0); G8_SCHED; G8_LDA(At, 1, 0); if (last) { G8_STAGE(G8_SA(0, 1), a2, na1); } else { G8_STAGE(G8_SA(0, 1), a2, ca1); }
            G8_WAIT_L(8); G8_BAR; G8_WAIT_L(0); G8_MMA(0, 0, At, B0); G8_BAR; G8_SCHED;
            G8_LDB(B1, 1, 1); G8_STAGE(G8_SB(1, 0), b3, voffB);
            G8_BAR; G8_WAIT_L(0); G8_MMA(0, 1, At, B1); G8_BAR;
            G8_LDA(At, 1, 1); if (last) { G8_STAGE(G8_SA(1, 0), a3, na0); } else { G8_STAGE(G8_SA(1, 0), a3, ca0); }
            G8_BAR; G8_WAIT_L(0); G8_MMA(1, 0, At, B0); G8_BAR; G8_SCHED;
            G8_STAGE(G8_SB(1, 1), b3 + hstepB, voffB);
            G8_WAIT_V(6); G8_BAR; G8_MMA(1, 1, At, B1); G8_BAR;
        }
        pr.epi(acc, pm, pn, wr, wc, fr, fq);
        if (!has_next) break;
#pragma unroll
        for (int a = 0; a < 2; ++a)
#pragma unroll
            for (int b = 0; b < 2; ++b)
#pragma unroll
                for (int m = 0; m < 4; ++m)
#pragma unroll
                    for (int n = 0; n < 2; ++n) acc[a][b][m][n] = f32x4{0.f, 0.f, 0.f, 0.f};
        pm = npm; pn = npn; cB = nB; ++ui;
#pragma unroll
        for (int i = 0; i < 2; ++i) { ca0[i] = na0[i]; ca1[i] = na1[i]; }
    }
    G8_WAIT_V(0);
    if (wr == 0) G8_BAR;
    G8_BAR;
#undef G8_SA
#undef G8_SB
#undef G8_STAGE
#undef G8_LDA
#undef G8_LDB
#undef G8_MMA
}
}

template <class RowMap>
__device__ __forceinline__ void cvt_tile(const float* src, int N, int K, int k0, int n0, bf16_t* dst, RowMap dst_row, int n_valid) {
    const int tid = opaque_tid(), n = n0 + (tid & 63), kg = tid >> 6;
    float v[8];
#pragma unroll
    for (int j = 0; j < 8; ++j) v[j] = (n < n_valid) ? src[(size_t)(k0 + kg * 8 + j) * N + n] : 0.f;
    U4 o; o.x = pack2(v[0], v[1]); o.y = pack2(v[2], v[3]); o.z = pack2(v[4], v[5]); o.w = pack2(v[6], v[7]);
    st16(dst + (size_t)dst_row(n) * K + k0 + kg * 8, o);
}
__device__ __forceinline__ int gu_row(int col, int is_up) { return (col >> 7) * 256 + is_up * 128 + (col & 127); }

template <class RowMap>
__device__ __forceinline__ void cvt_tile_lds(const float* src, int N, int K, int k0, int n0, bf16_t* dst, RowMap dst_row, unsigned char* smem) {
    constexpr int LD = 68;
    bf16_t* tile = reinterpret_cast<bf16_t*>(smem);
    const int tid = opaque_tid();
    {
        const int kp = tid >> 7, n = tid & 127;
        float a[8], b[8];
#pragma unroll
        for (int i = 0; i < 8; ++i) { const int k = 2 * (kp + 4 * i); a[i] = src[(size_t)(k0 + k) * N + n0 + n]; b[i] = src[(size_t)(k0 + k + 1) * N + n0 + n]; }
#pragma unroll
        for (int i = 0; i < 8; ++i) *reinterpret_cast<unsigned*>(tile + n * LD + 2 * (kp + 4 * i)) = pack2(a[i], b[i]);
    }
    __syncthreads();
    {
        const int n = tid >> 2, kq = tid & 3;
        const unsigned long long* rp = reinterpret_cast<const unsigned long long*>(tile + n * LD + kq * 16);
        const unsigned long long q0 = rp[0], q1 = rp[1], q2 = rp[2], q3 = rp[3];
        U4 o0, o1; o0.x = (unsigned)q0; o0.y = (unsigned)(q0 >> 32); o0.z = (unsigned)q1; o0.w = (unsigned)(q1 >> 32);
        o1.x = (unsigned)q2; o1.y = (unsigned)(q2 >> 32); o1.z = (unsigned)q3; o1.w = (unsigned)(q3 >> 32);
        bf16_t* d = dst + (size_t)dst_row(n0 + n) * K + k0 + kq * 16;
        st16(d, o0); st16(d + 8, o1);
    }
    __syncthreads();
}

constexpr int SCAN1_UNITS = 2 * BATCH * SSD_G * (SSD_HG / 2) + 2 * BATCH * MLSTM_HEADS * 2;
static_assert(WS_WDN >= WS_END1, "WS_WDN must not alias the layer-1 mixer buffers");
constexpr int CVT_T1 = (D_MODEL / 64) * (D_FF / 128);
constexpr int CVT_T2 = (D_FF / 64) * (D_MODEL / 128);
constexpr int CVT_NDN = N_EXPERTS * CVT_T2, CVT_NTOT = CVT_NDN + N_EXPERTS * 2 * CVT_T1;
template <int LAYER> __device__ void convert_expert_weights(const Params& p, int unit_begin, int unit_stride, unsigned char* smem, int v_lo, int v_hi) {
    bf16_t* wgu = reinterpret_cast<bf16_t*>(p.ws + WS_WGU); bf16_t* wdn = reinterpret_cast<bf16_t*>(p.ws + WS_WDN);
    constexpr int T1 = CVT_T1, T2 = CVT_T2;
    for (int v = v_lo + unit_begin; v < v_hi; v += unit_stride) {
        if (v >= CVT_NDN) {
            const int u = v - CVT_NDN, e = u / (2 * T1), r = u - e * (2 * T1);
            const int is_up = r / T1, t = r - is_up * T1, kt = t / (D_FF / 128), nt_ = t - kt * (D_FF / 128);
            const float* src = (is_up ? p.exp_w_up : p.exp_w_gate) + ((size_t)LAYER * N_EXPERTS + e) * D_MODEL * D_FF;
            cvt_tile_lds(src, D_FF, D_MODEL, kt * 64, nt_ * 128, wgu + (size_t)e * 2 * D_FF * D_MODEL,
                         [=](int n) { return gu_row(n, is_up); }, smem);
        } else {
            const int e = v / T2, t = v - e * T2, kt = t / (D_MODEL / 128), nt_ = t - kt * (D_MODEL / 128);
            const float* src = p.exp_w_down + ((size_t)LAYER * N_EXPERTS + e) * D_FF * D_MODEL;
            cvt_tile_lds(src, D_MODEL, D_FF, kt * 64, nt_ * 128, wdn + (size_t)e * D_MODEL * D_FF, [](int n) { return n; }, smem);
        }
    }
}

__device__ void phase_prologue(const Params& p, unsigned char* smem) {
    const int tid = opaque_tid(), bid = blockIdx.x, nb = gridDim.x;
    if (bid == 0) { int* cnt = reinterpret_cast<int*>(p.ws + WS_CNT); if (tid < 2 * N_EXPERTS) cnt[tid] = 0; }
    if (bid == (1 % nb)) {
        float* lb = reinterpret_cast<float*>(p.ws + WS_LB);
        for (int i = tid; i < HG_KW; i += NT) {
            float a0 = p.hgrn_lower_bounds[i], a1 = p.hgrn_lower_bounds[HG_KW + i], a2 = p.hgrn_lower_bounds[2 * HG_KW + i];
            float m = fmaxf(a0, fmaxf(a1, a2));
            float e0 = fexp(a0 - m), e1 = fexp(a1 - m), e2 = fexp(a2 - m);
            lb[i] = e0 / (e0 + e1 + e2);
        }
    }
    {
        float* mod = reinterpret_cast<float*>(p.ws + WS_MOD);
        float* sc = reinterpret_cast<float*>(smem);
        for (int i = tid; i < (BATCH + 1) * D_MODEL; i += NT) {
            int bb = i / D_MODEL, d = i - bb * D_MODEL;
            float v = bb < BATCH ? p.c[bb * D_MODEL + d] : p.c_ctx[d];
            sc[i] = siluf_(v);
        }
        __syncthreads();
        constexpr int NCOL = DEPTH * N_MOD * D_MODEL, KS = D_MODEL / 8;
        float* part = sc + (BATCH + 1) * D_MODEL;
        const int w8 = tid >> 6, ln = tid & 63;
        for (int u = bid; u < NCOL / 64; u += nb) {
            const int col = u * 64 + ln, l = col / (N_MOD * D_MODEL), j = col - l * (N_MOD * D_MODEL);
            const float* w = p.ada_w + (size_t)l * D_MODEL * N_MOD * D_MODEL + j;
            float acc[BATCH + 1];
#pragma unroll
            for (int bb = 0; bb <= BATCH; ++bb) acc[bb] = 0.f;
#pragma unroll 8
            for (int i = w8 * KS; i < (w8 + 1) * KS; ++i) {
                const float wv = w[(size_t)i * (N_MOD * D_MODEL)];
#pragma unroll
                for (int bb = 0; bb <= BATCH; ++bb) acc[bb] += sc[bb * D_MODEL + i] * wv;
            }
#pragma unroll
            for (int bb = 0; bb <= BATCH; ++bb) part[(w8 * (BATCH + 1) + bb) * 64 + ln] = acc[bb];
            __syncthreads();
            for (int o = tid; o < (BATCH + 1) * 64; o += NT) {
                const int bb = o >> 6, c = o & 63, cc = u * 64 + c, ll = cc / (N_MOD * D_MODEL), jj = cc - ll * (N_MOD * D_MODEL);
                float t = p.ada_b[ll * N_MOD * D_MODEL + jj];
#pragma unroll
                for (int q = 0; q < 8; ++q) t += part[(q * (BATCH + 1) + bb) * 64 + c];
                mod[((size_t)ll * (BATCH + 1) + bb) * (N_MOD * D_MODEL) + jj] = t;
            }
            __syncthreads();
        }
        __syncthreads();
    }
    {
        bf16_t* lrw = reinterpret_cast<bf16_t*>(p.ws + WS_LRW);
        constexpr int TOT = RWKV_W * (2 * RWKV_DR + 2 * RWKV_AR + RWKV_GR);
        for (int i = bid * NT + tid; i < TOT; i += nb * NT) {
            int kind, rem;
            if (i < 2 * RWKV_W * RWKV_DR) { kind = i / (RWKV_W * RWKV_DR); rem = i - kind * RWKV_W * RWKV_DR; }
            else if (i < 2 * RWKV_W * RWKV_DR + 2 * RWKV_W * RWKV_AR) { const int q = i - 2 * RWKV_W * RWKV_DR; kind = 2 + q / (RWKV_W * RWKV_AR); rem = q - (kind - 2) * RWKV_W * RWKV_AR; }
            else { kind = 4; rem = i - 2 * RWKV_W * RWKV_DR - 2 * RWKV_W * RWKV_AR; }
            const int rank = kind < 2 ? RWKV_DR : (kind < 4 ? RWKV_AR : RWKV_GR);
            const int c = rem / rank, r = rem - c * rank;
            const float* src = kind < 2 ? p.rwkv_w2 + (size_t)kind * RWKV_DR * RWKV_W : (kind < 4 ? p.rwkv_a2 + (size_t)(kind - 2) * RWKV_AR * RWKV_W : p.rwkv_g2);
            lrw[i] = f2bf(src[(size_t)r * RWKV_W + c]);
        }
    }
    {
        constexpr int KT = D_MODEL / 64;
        constexpr int U0 = KT * (EVEN_PROJ_PAD / 64), U1 = KT * (ODD_PROJ_PAD / 64);
        constexpr int U2 = (EVEN_OUT / 64) * (D_MODEL / 64), U3 = (ODD_OUT / 64) * (D_MODEL / 64);
        for (int u = bid; u < U0 + U1 + U2 + U3; u += nb) {
            if (u < U0) { int kt = u % KT, nt_ = u / KT; cvt_tile(p.even_w_in, EVEN_PROJ, D_MODEL, kt * 64, nt_ * 64, reinterpret_cast<bf16_t*>(p.ws + WS_WIN0), [](int n) { return n; }, EVEN_PROJ); }
            else if (u < U0 + U1) { int v = u - U0; int kt = v % KT, nt_ = v / KT; cvt_tile(p.odd_w_in, ODD_PROJ, D_MODEL, kt * 64, nt_ * 64, reinterpret_cast<bf16_t*>(p.ws + WS_WIN1), [](int n) { return n; }, ODD_PROJ); }
            else if (u < U0 + U1 + U2) { int v = u - U0 - U1; int kt = v % (EVEN_OUT / 64), nt_ = v / (EVEN_OUT / 64); cvt_tile(p.even_w_out, D_MODEL, EVEN_OUT, kt * 64, nt_ * 64, reinterpret_cast<bf16_t*>(p.ws + WS_WOUT0), [](int n) { return n; }, D_MODEL); }
            else { int v = u - U0 - U1 - U2; int kt = v % (ODD_OUT / 64), nt_ = v / (ODD_OUT / 64); cvt_tile(p.odd_w_out, D_MODEL, ODD_OUT, kt * 64, nt_ * 64, reinterpret_cast<bf16_t*>(p.ws + WS_WOUT1), [](int n) { return n; }, D_MODEL); }
        }
    }
}

template <int LAYER> __device__ void phase_norm1(const Params& p) {
    const int tid = opaque_tid(), lane = tid & 63, wv = (blockIdx.x * NT + tid) >> 6, nwv = gridDim.x * (NT / 64);
    const float* mod = reinterpret_cast<const float*>(p.ws + WS_MOD) + (size_t)LAYER * (BATCH + 1) * N_MOD * D_MODEL;
    const float* xc = LAYER == 0 ? p.ctx : reinterpret_cast<const float*>(p.ws + WS_XC);
    const float* xl = LAYER == 0 ? p.x : p.out;
    bf16_t* h = reinterpret_cast<bf16_t*>(p.ws + WS_H);
    const float* g = p.norm1_w + LAYER * D_MODEL;
    constexpr int NV = D_MODEL / 256;
    for (int row = wv; row < T_ALL; row += nwv) {
        const int b = row / LSEQ, s = row - b * LSEQ;
        const float* src; const float* md;
        if (s < CTX_LEN) { src = xc + ((size_t)b * CTX_LEN + s) * D_MODEL; md = mod + (size_t)BATCH * N_MOD * D_MODEL; }
        else { src = xl + ((size_t)b * SEQ + lat_nat<LAYER>(s - CTX_LEN)) * D_MODEL; md = mod + (size_t)b * N_MOD * D_MODEL; }
        F4 v[NV]; float ss = 0.f;
#pragma unroll
        for (int i = 0; i < NV; ++i) { v[i] = ldf4(src + i * 256 + lane * 4); ss += v[i].x * v[i].x + v[i].y * v[i].y + v[i].z * v[i].z + v[i].w * v[i].w; }
        ss = wave_sum(ss);
        const float rs = rsqrtf(ss * (1.0f / D_MODEL) + EPS);
#pragma unroll
        for (int i = 0; i < NV; ++i) {
            const int c = i * 256 + lane * 4;
            F4 gg = ldf4(g + c), m0 = ldf4(md + c), m1 = ldf4(md + D_MODEL + c);
            float o0 = v[i].x * rs * gg.x * (1.f + m1.x) + m0.x, o1 = v[i].y * rs * gg.y * (1.f + m1.y) + m0.y;
            float o2 = v[i].z * rs * gg.z * (1.f + m1.z) + m0.z, o3 = v[i].w * rs * gg.w * (1.f + m1.w) + m0.w;
            unsigned* dst = reinterpret_cast<unsigned*>(h + (size_t)row * D_MODEL + c);
            dst[0] = pack2(o0, o1); dst[1] = pack2(o2, o3);
        }
    }
}

constexpr int PREP_TOK = 64;
constexpr int LR_K[5] = {RWKV_DR, RWKV_DR, RWKV_AR, RWKV_AR, RWKV_GR};
constexpr int LR_OFF[5] = {0, RWKV_DR, 2 * RWKV_DR, 2 * RWKV_DR + RWKV_AR, 2 * RWKV_DR + 2 * RWKV_AR};
constexpr int LR_WOFF[5] = {0, RWKV_W * RWKV_DR, 2 * RWKV_W * RWKV_DR, 2 * RWKV_W * RWKV_DR + RWKV_W * RWKV_AR, 2 * RWKV_W * RWKV_DR + 2 * RWKV_W * RWKV_AR};
__device__ void hgrn_unit(const Params& p, unsigned char* smem, int u);
__device__ void phase_prep0(const Params& p, unsigned char* smem) {
    constexpr int NU_H = 2 * BATCH * HGRN_HEADS;
    const int nb = gridDim.x, bid = blockIdx.x;
    const bool split = nb > NU_H;
    const int hu_first = bid, hu_stride = split ? nb : nb, hu_end = split ? (bid < NU_H ? bid + 1 : 0) : NU_H;
    const int u_first = split ? (bid < NU_H ? (T_ALL / PREP_TOK) : bid - NU_H) : bid, u_stride = split ? nb - NU_H : nb;
#pragma unroll 1
    for (int u = hu_first; u < hu_end; u += hu_stride) { for (int rep = 0; rep < PROBE_REPS_B; ++rep) { hgrn_unit(p, smem, u); __syncthreads(); } }
    constexpr int W = RWKV_W, NP = EVEN_PROJ_PAD, NACT = 2 * RWKV_DR + 2 * RWKV_AR + RWKV_GR;
    constexpr int ALD = NACT + 8;
    constexpr int NG = RWKV_PROJ / 8;
    static_assert(RWKV_PROJ % 8 == 0 && W % 64 == 0, "prep0 layout");
    const bf16_t* P = reinterpret_cast<const bf16_t*>(p.ws + WS_P);
    bf16_t* AUX = reinterpret_cast<bf16_t*>(p.ws + WS_AUX0);
    const bf16_t* LRW = reinterpret_cast<const bf16_t*>(p.ws + WS_LRW);
    bf16_t* act = reinterpret_cast<bf16_t*>(smem);
    const int tid = opaque_tid(), wid = tid >> 6, lane = tid & 63, fr = lane & 15, fq = lane >> 4;
    for (int rep0 = 0; rep0 < PROBE_PREP0; ++rep0)
    for (int u = u_first; u < T_ALL / PREP_TOK; u += u_stride) {
        const int row0 = u * PREP_TOK;
        constexpr int PF = 5, NITEM = PREP_TOK * NG;
        static_assert(NITEM % (NT * PF) == 0 || true, "");
#pragma unroll 1
        for (int base = tid; base < NITEM; base += NT * PF) {
            U4 cu[PF], pv[PF], nx[PF]; F4 m0[PF], m1[PF];
#pragma unroll
            for (int k = 0; k < PF; ++k) {
                const int idx = base + k * NT;
                cu[k] = U4{0u, 0u, 0u, 0u}; pv[k] = cu[k]; nx[k] = cu[k]; m0[k] = F4{0.f, 0.f, 0.f, 0.f}; m1[k] = m0[k];
                if (idx < NITEM) {
                    const int t = idx / NG, col = (idx - t * NG) * 8, row = row0 + t;
                    const int sq = row % LSEQ;
                    const bool has_prev = (sq != 0) && (sq != CTX_LEN), has_next = (sq != CTX_LEN - 1) && (sq != LSEQ - 1);
                    cu[k] = ld16(P + (size_t)row * NP + col);
                    if (has_prev) pv[k] = ld16(P + (size_t)(row - 1) * NP + col);
                    if (has_next) nx[k] = ld16(P + (size_t)(row + 1) * NP + col);
                    m0[k] = ldf4(p.rwkv_mu + col); m1[k] = ldf4(p.rwkv_mu + col + 4);
                }
            }
#pragma unroll
            for (int k = 0; k < PF; ++k) {
                const int idx = base + k * NT;
                if (idx < NITEM) {
                    const int t = idx / NG, col = (idx - t * NG) * 8, row = row0 + t;
                    const unsigned cw[4] = {cu[k].x, cu[k].y, cu[k].z, cu[k].w}, pw[4] = {pv[k].x, pv[k].y, pv[k].z, pv[k].w}, nw[4] = {nx[k].x, nx[k].y, nx[k].z, nx[k].w};
                    const float mu[8] = {m0[k].x, m0[k].y, m0[k].z, m0[k].w, m1[k].x, m1[k].y, m1[k].z, m1[k].w};
                    float mx[8];
#pragma unroll
                    for (int q = 0; q < 4; ++q) {
                        const float c0 = lo2f(cw[q]), c1 = hi2f(cw[q]);
                        mx[2 * q] = c0 + (0.5f * (lo2f(pw[q]) + lo2f(nw[q])) - c0) * mu[2 * q];
                        mx[2 * q + 1] = c1 + (0.5f * (hi2f(pw[q]) + hi2f(nw[q])) - c1) * mu[2 * q + 1];
                    }
                    if (col < 3 * W) {
                        st16(AUX + (size_t)row * AUX0_W + col, pack8f(mx));
                    } else {
                        const int a = col - 3 * W;
#pragma unroll
                        for (int q = 0; q < 8; ++q) {
                            if (a < 2 * RWKV_DR) mx[q] = 2.f * sigmoidf_(2.f * mx[q]) - 1.f;
                            else if (a >= 2 * RWKV_DR + 2 * RWKV_AR) mx[q] = sigmoidf_(mx[q]);
                        }
                        st16(act + t * ALD + a, pack8f(mx));
                    }
                }
            }
        }
        __syncthreads();
#pragma unroll 1
        for (int ct = wid; ct < W / 16; ct += NT / 64) {
#pragma unroll
            for (int kind = 0; kind < 5; ++kind) {
#ifndef EMU
                __builtin_amdgcn_sched_barrier(0);
#endif
                f32x4 acc[4];
#pragma unroll
                for (int m = 0; m < 4; ++m) acc[m] = f32x4{0.f, 0.f, 0.f, 0.f};
#pragma unroll
                for (int ks = 0; ks < LR_K[kind] / 32; ++ks) {
                    const bf16x8 wf = *reinterpret_cast<const bf16x8*>(LRW + LR_WOFF[kind] + (size_t)(ct * 16 + fr) * LR_K[kind] + ks * 32 + fq * 8);
#pragma unroll
                    for (int m = 0; m < 4; ++m) {
                        const bf16x8 af = *reinterpret_cast<const bf16x8*>(act + (m * 16 + fr) * ALD + LR_OFF[kind] + ks * 32 + fq * 8);
                        acc[m] = mfma16(wf, af, acc[m]);
                    }
                }
                const int c0 = ct * 16 + fq * 4;
                float bias[4] = {0.f, 0.f, 0.f, 0.f};
                if (kind < 2) { const F4 b = ldf4(p.rwkv_w0 + kind * W + c0); bias[0] = b.x; bias[1] = b.y; bias[2] = b.z; bias[3] = b.w; }
                else if (kind < 4) { const F4 b = ldf4(p.rwkv_a0 + (kind - 2) * W + c0); bias[0] = b.x; bias[1] = b.y; bias[2] = b.z; bias[3] = b.w; }
#pragma unroll
                for (int m = 0; m < 4; ++m) {
                    float o[4];
#pragma unroll
                    for (int j = 0; j < 4; ++j) {
                        const float v = acc[m][j] + bias[j];
                        if (kind < 2) o[j] = -0.6065306597126334f * sigmoidf_(v);
                        else if (kind < 4) o[j] = sigmoidf_(v);
                        else o[j] = v;
                    }
                    unsigned* dst = reinterpret_cast<unsigned*>(AUX + (size_t)(row0 + m * 16 + fr) * AUX0_W + (3 + kind) * W + c0);
                    dst[0] = pack2(o[0], o[1]); dst[1] = pack2(o[2], o[3]);
                }
            }
        }
        __syncthreads();
    }
    if (split) { if (bid >= NU_H) convert_expert_weights<0>(p, bid - NU_H, nb - NU_H, smem, 0, CVT_NTOT); }
    else convert_expert_weights<0>(p, bid, nb, smem, 0, CVT_NTOT);
}


__device__ __forceinline__ U4 scale8(U4 v, float s) {
    U4 o; o.x = pack2(lo2f(v.x) * s, hi2f(v.x) * s); o.y = pack2(lo2f(v.y) * s, hi2f(v.y) * s);
    o.z = pack2(lo2f(v.z) * s, hi2f(v.z) * s); o.w = pack2(lo2f(v.w) * s, hi2f(v.w) * s); return o;
}
__device__ __forceinline__ U4 gather8(const bf16_t* base, int ld) {
    unsigned v[8];
#pragma unroll
    for (int i = 0; i < 8; ++i) v[i] = base[i * ld];
    U4 o; o.x = v[0] | (v[1] << 16); o.y = v[2] | (v[3] << 16); o.z = v[4] | (v[5] << 16); o.w = v[6] | (v[7] << 16); return o;
}
template <int CTRL> __device__ __forceinline__ float dpp_f(float v) {
#ifdef EMU
    auto r = emu_wave_exchange(&v, 4); const int l = emu_cur->lane; int s;
    if (CTRL == 0xB1) s = l ^ 1; else if (CTRL == 0x4E) s = l ^ 2; else if (CTRL == 0x1B) s = l ^ 3; else if (CTRL == 0x141) s = (l & ~7) | (7 - (l & 7));
    else if (CTRL == 0x128) s = l ^ 8; else s = (l & ~15) | (15 - (l & 15));
    float o; memcpy(&o, r[s], 4); return o;
#else
    return __builtin_bit_cast(float, __builtin_amdgcn_update_dpp(0, __builtin_bit_cast(int, v), CTRL, 0xF, 0xF, true));
#endif
}
__device__ __forceinline__ float sum8(float v) { v += dpp_f<0xB1>(v); v += dpp_f<0x4E>(v); v += dpp_f<0x141>(v); return v; }
__device__ __forceinline__ float sum16(float v) {
    const float q = (v + dpp_f<0xB1>(v)) + (dpp_f<0x4E>(v) + dpp_f<0x1B>(v));
    return (q + dpp_f<0x141>(q)) + (dpp_f<0x140>(q) + dpp_f<0x128>(q));
}

template <int GV> __device__ __forceinline__ float group_sum_v(float v) {
    static_assert(GV == 8 || GV == 16 || GV == 32 || GV == 64, "group size");
    if (GV == 8) return sum8(v);
    v = sum16(v);
    if (GV >= 32) v += __shfl_xor(v, 16, 64);
    if (GV >= 64) v += __shfl_xor(v, 32, 64);
    return v;
}
template <bool DRY> __device__ __forceinline__ void finish0_hgrn_row(const Params& p, int row, int lane) {
    constexpr int W = RWKV_W, NP = EVEN_PROJ_PAD, NVH = HG_VW / 8;
    const bf16_t* P = reinterpret_cast<const bf16_t*>(p.ws + WS_P);
    bf16_t* O0 = reinterpret_cast<bf16_t*>(p.ws + WS_O0);
    const bf16_t* O1 = O0 + (size_t)T_ALL * OW0;
    const bool acth = lane < NVH; const int ch = (acth ? lane : 0) * 8;
    float hw[8]; ldf8(p.hgrn_norm_w + ch, hw);
    bf16_t* o0 = O0 + (size_t)row * OW0; const bf16_t* o1 = O1 + (size_t)row * OW0;
    const U4 h0 = ld16(o0 + W + ch), h1 = ld16(o1 + W + ch), hg = ld16(P + (size_t)row * NP + RWKV_PROJ + 3 * HG_KW + HG_VW + ch);
    float x0[8], x1[8], g[8], o[8];
    unpack8(h0, x0); unpack8(h1, x1); unpack8(hg, g);
    float ss = 0.f;
#pragma unroll
    for (int i = 0; i < 8; ++i) { o[i] = x0[i] + x1[i]; ss += o[i] * o[i]; }
    ss = group_sum_v<HG_DV / 8>(acth ? ss : 0.f) * (1.f / HG_DV);
    const float rs = rsqrtf(ss + EPS);
    float y[8];
#pragma unroll
    for (int i = 0; i < 8; ++i) y[i] = o[i] * rs * hw[i] * siluf_(g[i]);
    if (acth) { if (DRY) { sink(y[0]); sink(y[7]); } else st16(o0 + W + ch, pack8f(y)); }
}
constexpr int RW_NB = LSEQ / 64;
constexpr int RW_NU = 2 * BATCH * RWKV_HEADS * 2;
constexpr int FIN_RPS = (T_ALL + RW_NB * RW_NU * 4 - 1) / (RW_NB * RW_NU * 4);

typedef float f32x2 __attribute__((ext_vector_type(2)));
struct V2x4 { f32x2 v[4]; };
__device__ __forceinline__ V2x4 ldv8(const float* p) {
    const F4 a = *reinterpret_cast<const F4*>(p), b = *reinterpret_cast<const F4*>(p + 4);
    V2x4 r; r.v[0] = f32x2{a.x, a.y}; r.v[1] = f32x2{a.z, a.w}; r.v[2] = f32x2{b.x, b.y}; r.v[3] = f32x2{b.z, b.w}; return r;
}
constexpr int RW_TB = 64;
__device__ void rwkv_unit(const Params& p, unsigned char* smem, int u) {
    constexpr int W = RWKV_W;
    const int half = u & 1, uu = u >> 1;
    const int dir = uu / (BATCH * RWKV_HEADS), b = (uu / RWKV_HEADS) % BATCH, h = uu % RWKV_HEADS;
    const int tid = opaque_tid(), rl = (tid >> 3) & 31, kq = tid & 7;
    const int si = tid >> 3, part = tid & 7;
    const bf16_t* AUX = reinterpret_cast<const bf16_t*>(p.ws + WS_AUX0);
    bf16_t* O = reinterpret_cast<bf16_t*>(p.ws + WS_O0) + (size_t)dir * T_ALL * OW0;
    float* srec = reinterpret_cast<float*>(smem);
    float* sv = srec + RW_TB * 320; float* so = sv + RW_TB * 64;
    float* sdummy = so + RW_TB * 64; const int t2d = tid & 255;
    f32x2 S2[4];
#pragma unroll
    for (int j = 0; j < 4; ++j) S2[j] = f32x2{0.f, 0.f};
    const int ch0 = h * 64 + part * 8;
    float kkg[8], kag[8];
    { const F4 a = ldf4(p.rwkv_k_k + ch0), c = ldf4(p.rwkv_k_k + ch0 + 4), d = ldf4(p.rwkv_k_a + ch0), e = ldf4(p.rwkv_k_a + ch0 + 4);
      kkg[0] = a.x; kkg[1] = a.y; kkg[2] = a.z; kkg[3] = a.w; kkg[4] = c.x; kkg[5] = c.y; kkg[6] = c.z; kkg[7] = c.w;
      kag[0] = d.x; kag[1] = d.y; kag[2] = d.z; kag[3] = d.w; kag[4] = e.x; kag[5] = e.y; kag[6] = e.z; kag[7] = e.w; }
    U4 raw[5];
    {
        const bf16_t* a = AUX + ((size_t)b * LSEQ + step_pos(dir, si)) * AUX0_W + ch0;
        raw[0] = ld16(a); raw[1] = ld16(a + W); raw[2] = ld16(a + 2 * W); raw[3] = ld16(a + (3 + dir) * W); raw[4] = ld16(a + (5 + dir) * W);
    }
    for (int j0 = 0; j0 < LSEQ; j0 += RW_TB) {
        {
            const unsigned rr[4] = {raw[0].x, raw[0].y, raw[0].z, raw[0].w}, kr[4] = {raw[1].x, raw[1].y, raw[1].z, raw[1].w}, vr[4] = {raw[2].x, raw[2].y, raw[2].z, raw[2].w};
            const unsigned wr_[4] = {raw[3].x, raw[3].y, raw[3].z, raw[3].w}, ar[4] = {raw[4].x, raw[4].y, raw[4].z, raw[4].w};
            float r[8], k[8], v[8], lw[8], av[8], kk[8];
            float nrm = 0.f;
#pragma unroll
            for (int q = 0; q < 4; ++q) {
                r[2 * q] = lo2f(rr[q]); r[2 * q + 1] = hi2f(rr[q]); k[2 * q] = lo2f(kr[q]); k[2 * q + 1] = hi2f(kr[q]);
                v[2 * q] = lo2f(vr[q]); v[2 * q + 1] = hi2f(vr[q]); lw[2 * q] = lo2f(wr_[q]); lw[2 * q + 1] = hi2f(wr_[q]);
                av[2 * q] = lo2f(ar[q]); av[2 * q + 1] = hi2f(ar[q]);
            }
#pragma unroll
            for (int j = 0; j < 8; ++j) { kk[j] = k[j] * kkg[j]; nrm += kk[j] * kk[j]; }
            nrm = sum8(nrm);
            const float rn = rsqrtf(nrm + 1e-12f);
            const int o = si * 320 + part * 8, ov = si * 64 + part * 8;
#pragma unroll
            for (int hq = 0; hq < 2; ++hq) {
                F4 t;
                t.x = fexp(lw[4 * hq]); t.y = fexp(lw[4 * hq + 1]); t.z = fexp(lw[4 * hq + 2]); t.w = fexp(lw[4 * hq + 3]);
                *reinterpret_cast<F4*>(srec + o + 4 * hq) = t;
                t.x = k[4 * hq] * (1.f + (av[4 * hq] - 1.f) * kag[4 * hq]); t.y = k[4 * hq + 1] * (1.f + (av[4 * hq + 1] - 1.f) * kag[4 * hq + 1]);
                t.z = k[4 * hq + 2] * (1.f + (av[4 * hq + 2] - 1.f) * kag[4 * hq + 2]); t.w = k[4 * hq + 3] * (1.f + (av[4 * hq + 3] - 1.f) * kag[4 * hq + 3]);
                *reinterpret_cast<F4*>(srec + o + 64 + 4 * hq) = t;
                F4 kn; kn.x = kk[4 * hq] * rn; kn.y = kk[4 * hq + 1] * rn; kn.z = kk[4 * hq + 2] * rn; kn.w = kk[4 * hq + 3] * rn;
                *reinterpret_cast<F4*>(srec + o + 128 + 4 * hq) = kn;
                t.x = kn.x * av[4 * hq]; t.y = kn.y * av[4 * hq + 1]; t.z = kn.z * av[4 * hq + 2]; t.w = kn.w * av[4 * hq + 3];
                *reinterpret_cast<F4*>(srec + o + 192 + 4 * hq) = t;
                t.x = r[4 * hq]; t.y = r[4 * hq + 1]; t.z = r[4 * hq + 2]; t.w = r[4 * hq + 3];
                *reinterpret_cast<F4*>(srec + o + 256 + 4 * hq) = t;
                t.x = v[4 * hq]; t.y = v[4 * hq + 1]; t.z = v[4 * hq + 2]; t.w = v[4 * hq + 3];
                *reinterpret_cast<F4*>(sv + ov + 4 * hq) = t;
            }
        }
        lds_barrier();
        if (j0 + RW_TB < LSEQ) {
            const bf16_t* a = AUX + ((size_t)b * LSEQ + step_pos(dir, j0 + RW_TB + si)) * AUX0_W + ch0;
            raw[0] = ld16(a); raw[1] = ld16(a + W); raw[2] = ld16(a + 2 * W); raw[3] = ld16(a + (3 + dir) * W); raw[4] = ld16(a + (5 + dir) * W);
        }
        if (tid < 256) {
            const int base0 = kq * 8;
            V2x4 kkc = ldv8(srec + base0 + 128), wc = ldv8(srec + base0), bc = ldv8(srec + base0 + 192), kc = ldv8(srec + base0 + 64), rc = ldv8(srec + base0 + 256);
            float v0 = sv[32 * half + rl];
#pragma unroll 2
            for (int i = 0; i < RW_TB; ++i) {
                const int i1 = (i + 1 < RW_TB ? i + 1 : i);
                const float* rn_ = srec + i1 * 320 + base0;
                const V2x4 nkk = ldv8(rn_ + 128), nw = ldv8(rn_), nbb = ldv8(rn_ + 192), nk = ldv8(rn_ + 64), nr = ldv8(rn_ + 256);
                const float nv0 = sv[i1 * 64 + 32 * half + rl];
                f32x2 t = S2[0] * kkc.v[0]; t = S2[1] * kkc.v[1] + t; t = S2[2] * kkc.v[2] + t; t = S2[3] * kkc.v[3] + t;
                const float sa = sum8(t.x + t.y);
                const f32x2 sav = f32x2{sa, sa}, vv = f32x2{v0, v0};
#pragma unroll
                for (int q = 0; q < 4; ++q) { f32x2 u2 = S2[q] * wc.v[q]; u2 = u2 - sav * bc.v[q]; S2[q] = vv * kc.v[q] + u2; }
                f32x2 o2 = S2[0] * rc.v[0]; o2 = S2[1] * rc.v[1] + o2; o2 = S2[2] * rc.v[2] + o2; o2 = S2[3] * rc.v[3] + o2;
                const float o0 = sum8(o2.x + o2.y);
                *((kq == 0) ? (so + i * 32 + rl) : (sdummy + t2d)) = o0;
                kkc = nkk; wc = nw; bc = nbb; kc = nk; rc = nr; v0 = nv0;
            }
        } else {
            const int slot = ((j0 / RW_TB) * RW_NU + u) * 4 + ((tid >> 6) - 4);
#pragma unroll 1
            for (int q = 0; q < FIN_RPS; ++q) { const int row = slot * FIN_RPS + q; if (row < T_ALL) finish0_hgrn_row<false>(p, row, tid & 63); }
        }
        lds_barrier();
        if (part < 4) {
            const size_t rowg = (size_t)b * LSEQ + step_pos(dir, j0 + si);
            const F4 a = *reinterpret_cast<const F4*>(so + si * 32 + part * 8), c = *reinterpret_cast<const F4*>(so + si * 32 + part * 8 + 4);
            U4 o; o.x = pack2(a.x, a.y); o.y = pack2(a.z, a.w); o.z = pack2(c.x, c.y); o.w = pack2(c.z, c.w);
            st16(O + rowg * OW0 + h * 64 + 32 * half + part * 8, o);
        }
    }
    lds_barrier();
}

__device__ void hgrn_unit(const Params& p, unsigned char* smem, int u) {
    constexpr int NP = EVEN_PROJ_PAD, CH = HG_CH, LDK = 136, LDC = 40;
    const int dir = u / (BATCH * HGRN_HEADS), b = (u / HGRN_HEADS) % BATCH, h = u % HGRN_HEADS;
    const int tid = opaque_tid(), wid = tid >> 6, lane = tid & 63, fr = lane & 15, fq = lane >> 4;
    const bf16_t* P = reinterpret_cast<const bf16_t*>(p.ws + WS_P);
    const float* lb = reinterpret_cast<const float*>(p.ws + WS_LB);
    bf16_t* O = reinterpret_cast<bf16_t*>(p.ws + WS_O0) + (size_t)dir * T_ALL * OW0;
    float* lfS = reinterpret_cast<float*>(smem);
    bf16_t* qsS = reinterpret_cast<bf16_t*>(lfS + CH * 128);
    bf16_t* kfS = qsS + CH * LDK;
    bf16_t* vS = kfS + CH * LDK;
    bf16_t* qin = vS + CH * LDK;
    bf16_t* kin = qin + CH * LDK;
    bf16_t* kendT = kin + CH * LDK;
    bf16_t* vT = kendT + 128 * LDC;
    float* eblast = reinterpret_cast<float*>(vT + 128 * LDC);
    f32x4 S[8];
#pragma unroll
    for (int n = 0; n < 8; ++n) S[n] = f32x4{0.f, 0.f, 0.f, 0.f};
    const int lt = tid >> 4, lc = (tid & 15) * 8;
    float lbv[8];
    { const F4 a = ldf4(lb + h * 128 + lc), c = ldf4(lb + h * 128 + lc + 4); lbv[0] = a.x; lbv[1] = a.y; lbv[2] = a.z; lbv[3] = a.w; lbv[4] = c.x; lbv[5] = c.y; lbv[6] = c.z; lbv[7] = c.w; }
    struct Regs { U4 rq, rf, rv; };
    Regs setA, setB;
    auto issue = [&](Regs& r, int j0) {
        const bf16_t* pr = P + ((size_t)b * LSEQ + step_pos(dir, j0 + lt)) * NP + RWKV_PROJ + h * 128 + lc;
        r.rq = ld16(pr); r.rf = ld16(pr + HG_KW + dir * HG_KW); r.rv = ld16(pr + 3 * HG_KW);
    };
    issue(setA, 0); issue(setB, CH);
    const int g = tid >> 7, d = tid & 127;
    static_assert((LSEQ / HG_CH) % 2 == 0, "even chunk count");
    auto chunk = [&](Regs& r, int j0) {
        const U4 rq = r.rq, rf = r.rf, rv = r.rv;
        for (int repA = 0; repA < PROBE_HG_A; ++repA) {
            #ifndef EMU
            if (PROBE_HG_A > 1) { asm volatile("" ::: "memory"); }
#endif
            const unsigned qw[4] = {rq.x, rq.y, rq.z, rq.w}, fw[4] = {rf.x, rf.y, rf.z, rf.w};
            float lf[8], kf[8], qs[8];
#pragma unroll
            for (int q = 0; q < 4; ++q) {
#pragma unroll
                for (int e = 0; e < 2; ++e) {
                    const int i = 2 * q + e;
                    const float fv = e ? hi2f(fw[q]) : lo2f(fw[q]), qv = e ? hi2f(qw[q]) : lo2f(qw[q]);
                    const float sg = sigmoidf_(fv);
                    lf[i] = flog(lbv[i] + (1.f - lbv[i]) * sg); kf[i] = (1.f - lbv[i]) * (1.f - sg);
                    qs[i] = siluf_(qv) * 0.08838834764831845f;
                }
            }
            F4 t0, t1; t0.x = lf[0]; t0.y = lf[1]; t0.z = lf[2]; t0.w = lf[3]; t1.x = lf[4]; t1.y = lf[5]; t1.z = lf[6]; t1.w = lf[7];
            *reinterpret_cast<F4*>(lfS + lt * 128 + lc) = t0; *reinterpret_cast<F4*>(lfS + lt * 128 + lc + 4) = t1;
            U4 o; o.x = pack2(qs[0], qs[1]); o.y = pack2(qs[2], qs[3]); o.z = pack2(qs[4], qs[5]); o.w = pack2(qs[6], qs[7]);
            st16(qsS + lt * LDK + lc, o);
            o.x = pack2(kf[0], kf[1]); o.y = pack2(kf[2], kf[3]); o.z = pack2(kf[4], kf[5]); o.w = pack2(kf[6], kf[7]);
            st16(kfS + lt * LDK + lc, o);
            st16(vS + lt * LDK + lc, rv);
        }
        lds_barrier();
        if (j0 + 2 * CH < LSEQ) issue(r, j0 + 2 * CH);
        for (int repB = 0; repB < PROBE_HG_B; ++repB) {
            float off = 0.f, bl = 0.f, cs[8];
#pragma unroll
            for (int t = 0; t < CH; ++t) {
                const float v = lfS[t * 128 + d];
                if (t < 8 * g) off += v;
                bl += v;
            }
            float run = off;
#pragma unroll
            for (int tt = 0; tt < 8; ++tt) { run += lfS[(8 * g + tt) * 128 + d]; cs[tt] = run; }
            const U4 kf8 = gather8(kfS + (8 * g) * LDK + d, LDK), qs8 = gather8(qsS + (8 * g) * LDK + d, LDK), v8 = gather8(vS + (8 * g) * LDK + d, LDK);
            const unsigned kw[4] = {kf8.x, kf8.y, kf8.z, kf8.w}, qw[4] = {qs8.x, qs8.y, qs8.z, qs8.w};
            float ke[8];
#pragma unroll
            for (int tt = 0; tt < 8; ++tt) {
                const float kfv = (tt & 1) ? hi2f(kw[tt >> 1]) : lo2f(kw[tt >> 1]), qsv = (tt & 1) ? hi2f(qw[tt >> 1]) : lo2f(qw[tt >> 1]);
                qin[(8 * g + tt) * LDK + d] = f2bf(qsv * fexp(cs[tt]));
                kin[(8 * g + tt) * LDK + d] = f2bf(kfv * fexp(-cs[tt]));
                ke[tt] = kfv * fexp(bl - cs[tt]);
            }
            U4 o; o.x = pack2(ke[0], ke[1]); o.y = pack2(ke[2], ke[3]); o.z = pack2(ke[4], ke[5]); o.w = pack2(ke[6], ke[7]);
            st16(kendT + d * LDC + 8 * g, o);
            st16(vT + d * LDC + 8 * g, v8);
            if (g == 0) eblast[d] = fexp(bl);
        }
        lds_barrier();
        bf16x8 fk0[4], fk1[4];
#pragma unroll
        for (int ks = 0; ks < 4; ++ks) {
            fk0[ks] = *reinterpret_cast<const bf16x8*>(kin + (fr) * LDK + ks * 32 + fq * 8);
            fk1[ks] = *reinterpret_cast<const bf16x8*>(kin + (16 + fr) * LDK + ks * 32 + fq * 8);
        }
        for (int repC = 0; repC < PROBE_HG_C; ++repC)
#pragma unroll
        for (int ti = 0; ti < 2; ++ti) {
#ifndef EMU
            if (PROBE_HG_C > 1) { asm volatile("" ::: "memory"); }
#endif
            f32x4 a0 = f32x4{0.f, 0.f, 0.f, 0.f}, a1 = f32x4{0.f, 0.f, 0.f, 0.f};
#pragma unroll
            for (int ks = 0; ks < 4; ++ks) {
                const bf16x8 fq_ = *reinterpret_cast<const bf16x8*>(qin + (ti * 16 + fr) * LDK + ks * 32 + fq * 8);
                a0 = mfma16(fk0[ks], fq_, a0);
                a1 = mfma16(fk1[ks], fq_, a1);
            }
            const int t = ti * 16 + fr, s0 = fq * 4;
            U4 au;
            au.x = pack2(s0 <= t ? a0[0] : 0.f, s0 + 1 <= t ? a0[1] : 0.f); au.y = pack2(s0 + 2 <= t ? a0[2] : 0.f, s0 + 3 <= t ? a0[3] : 0.f);
            au.z = pack2(s0 + 16 <= t ? a1[0] : 0.f, s0 + 17 <= t ? a1[1] : 0.f); au.w = pack2(s0 + 18 <= t ? a1[2] : 0.f, s0 + 19 <= t ? a1[3] : 0.f);
            const bf16x8 af = __builtin_bit_cast(bf16x8, au);
            const unsigned long long v0 = *reinterpret_cast<const unsigned long long*>(vT + (wid * 16 + fr) * LDC + 4 * fq);
            const unsigned long long v1 = *reinterpret_cast<const unsigned long long*>(vT + (wid * 16 + fr) * LDC + 16 + 4 * fq);
            U4 vu; vu.x = (unsigned)v0; vu.y = (unsigned)(v0 >> 32); vu.z = (unsigned)v1; vu.w = (unsigned)(v1 >> 32);
            f32x4 oa = f32x4{0.f, 0.f, 0.f, 0.f};
            oa = mfma16(__builtin_bit_cast(bf16x8, vu), af, oa);
#pragma unroll
            for (int ks = 0; ks < 4; ++ks) {
                U4 su; su.x = pack2(S[2 * ks][0], S[2 * ks][1]); su.y = pack2(S[2 * ks][2], S[2 * ks][3]);
                su.z = pack2(S[2 * ks + 1][0], S[2 * ks + 1][1]); su.w = pack2(S[2 * ks + 1][2], S[2 * ks + 1][3]);
                const unsigned long long q0 = *reinterpret_cast<const unsigned long long*>(qin + (ti * 16 + fr) * LDK + ks * 32 + 4 * fq);
                const unsigned long long q1 = *reinterpret_cast<const unsigned long long*>(qin + (ti * 16 + fr) * LDK + ks * 32 + 16 + 4 * fq);
                U4 qu; qu.x = (unsigned)q0; qu.y = (unsigned)(q0 >> 32); qu.z = (unsigned)q1; qu.w = (unsigned)(q1 >> 32);
                oa = mfma16(__builtin_bit_cast(bf16x8, su), __builtin_bit_cast(bf16x8, qu), oa);
            }
            const size_t rowg = (size_t)b * LSEQ + step_pos(dir, j0 + t);
            unsigned* dst = reinterpret_cast<unsigned*>(O + rowg * OW0 + RWKV_W + h * 128 + wid * 16 + fq * 4);
            dst[0] = pack2(oa[0], oa[1]); dst[1] = pack2(oa[2], oa[3]);
        }
        {
            bf16x8 fv = *reinterpret_cast<const bf16x8*>(vT + (wid * 16 + fr) * LDC + fq * 8);
#pragma unroll
            for (int n = 0; n < 8; ++n) {
                const F4 e = ldf4(eblast + n * 16 + fq * 4);
                f32x4 c = S[n]; c[0] *= e.x; c[1] *= e.y; c[2] *= e.z; c[3] *= e.w;
                bf16x8 fk = *reinterpret_cast<const bf16x8*>(kendT + (n * 16 + fr) * LDC + fq * 8);
                S[n] = mfma16(fk, fv, c);
            }
        }
        lds_barrier();
    };
#pragma unroll 1
    for (int j0 = 0; j0 < LSEQ; j0 += 2 * CH) { chunk(setA, j0); chunk(setB, j0 + CH); }
}

template <int MODE = 0> __device__ void phase_scan0(const Params& p, unsigned char* smem) {
    constexpr int NU_R = 2 * BATCH * RWKV_HEADS * 2;
    for (int u = blockIdx.x; u < NU_R; u += gridDim.x) { for (int rep = 0; rep < PROBE_REPS_A; ++rep) { rwkv_unit(p, smem, u); __syncthreads(); } }
}

template <bool DRY> __device__ void phase_finish0(const Params& p) {
    constexpr int W = RWKV_W, NP = EVEN_PROJ_PAD;
    constexpr int NVR = W / 8, NVH = HG_VW / 8;
    static_assert(NVR <= 64 && NVH <= 64, "finish0 layout");
    const int tid = opaque_tid(), lane = tid & 63, wv = (blockIdx.x * NT + tid) >> 6, nwv = gridDim.x * (NT / 64);
    const bf16_t* P = reinterpret_cast<const bf16_t*>(p.ws + WS_P);
    const bf16_t* AUX = reinterpret_cast<const bf16_t*>(p.ws + WS_AUX0);
    bf16_t* O0 = reinterpret_cast<bf16_t*>(p.ws + WS_O0);
    const bf16_t* O1 = O0 + (size_t)T_ALL * OW0;
    const bool actr = lane < NVR, acth = lane < NVH;
    const int c = (actr ? lane : 0) * 8, ch = (acth ? lane : 0) * 8;
    float ka[8], rk[8], lw[8], lbv[8], hw[8];
    ldf8(p.rwkv_k_a + c, ka); ldf8(p.rwkv_r_k + c, rk); ldf8(p.rwkv_ln_w + c, lw); ldf8(p.rwkv_ln_b + c, lbv);
    for (int row = wv; row < T_ALL; row += nwv) {
        bf16_t* o0 = O0 + (size_t)row * OW0; const bf16_t* o1 = O1 + (size_t)row * OW0;
        const bf16_t* a = AUX + (size_t)row * AUX0_W;
        const U4 u0 = ld16(o0 + c), u1 = ld16(o1 + c), ur = ld16(a + c), uk = ld16(a + W + c), uv = ld16(a + 2 * W + c);
        const U4 ua0 = ld16(a + 5 * W + c), ua1 = ld16(a + 6 * W + c), ug = ld16(a + 7 * W + c);
        {
            float x0[8], x1[8], r[8], k[8], v[8], a0[8], a1[8], g[8], o[8];
            unpack8(u0, x0); unpack8(u1, x1); unpack8(ur, r); unpack8(uk, k); unpack8(uv, v); unpack8(ua0, a0); unpack8(ua1, a1); unpack8(ug, g);
            float sum = 0.f, bon = 0.f;
#pragma unroll
            for (int i = 0; i < 8; ++i) {
                o[i] = x0[i] + x1[i]; sum += o[i];
                const float km = k[i] * (1.f + (a0[i] - 1.f) * ka[i]) + k[i] * (1.f + (a1[i] - 1.f) * ka[i]);
                bon += r[i] * km * rk[i];
            }
            if (!actr) { sum = 0.f; bon = 0.f; }
            const float mu = sum8(sum) * (1.f / 64.f);
            bon = sum8(bon);
            float var = 0.f;
#pragma unroll
            for (int i = 0; i < 8; ++i) { const float dd = o[i] - mu; var += dd * dd; }
            var = sum8(actr ? var : 0.f) * (1.f / 64.f);
            const float rs = rsqrtf(var + RWKV_GN_EPS);
            float y[8];
#pragma unroll
            for (int i = 0; i < 8; ++i) y[i] = ((o[i] - mu) * rs * lw[i] + lbv[i] + bon * v[i]) * g[i];
            if (actr) { if (DRY) { sink(y[0]); sink(y[7]); } else st16(o0 + c, pack8f(y)); }
        }
    }
}

__device__ __forceinline__ U4 pack8(const f32x4& a, const f32x4& b) { U4 o; o.x = pack2(a[0], a[1]); o.y = pack2(a[2], a[3]); o.z = pack2(b[0], b[1]); o.w = pack2(b[2], b[3]); return o; }

template <int LAYER> struct ProbInproj {
    static constexpr int K = D_MODEL; static constexpr bool PERM = true;
    static constexpr int NP = LAYER == 0 ? EVEN_PROJ_PAD : ODD_PROJ_PAD;
    const char* A; const char* Bt; bf16_t* P;
    __device__ __forceinline__ int nM() const { return T_ALL / 256; }
    __device__ __forceinline__ int nN() const { return NP / 256; }
    __device__ __forceinline__ const char* a_base() const { return A; }
    __device__ __forceinline__ unsigned a_off(int pm, int r) const { return (unsigned)(pm * 256 + r) * (unsigned)(K * 2); }
    __device__ __forceinline__ const char* b_base(int, int pn) const { return Bt + (size_t)pn * 256 * K * 2; }
    __device__ __forceinline__ void epi(const f32x4 (&acc)[2][2][4][2], int pm, int pn, int wr, int wc, int fr, int fq) const {
#pragma unroll
        for (int ai = 0; ai < 2; ++ai)
#pragma unroll
            for (int m = 0; m < 4; ++m) {
                bf16_t* rowp = P + (size_t)(pm * 256 + ai * 128 + wr * 64 + m * 16 + fr) * NP + pn * 256 + wc * 32 + fq * 8;
#pragma unroll
                for (int bj = 0; bj < 2; ++bj) st16(rowp + bj * 128, pack8(acc[ai][bj][m][0], acc[ai][bj][m][1]));
            }
    }
};
template <int LAYER> __device__ void phase_inproj(const Params& p, unsigned char* smem) {
    ProbInproj<LAYER> pr;
    pr.A = reinterpret_cast<const char*>(p.ws + WS_H); pr.Bt = reinterpret_cast<const char*>(p.ws + (LAYER == 0 ? WS_WIN0 : WS_WIN1));
    pr.P = reinterpret_cast<bf16_t*>(p.ws + WS_P);
    g8::gemm_phase(smem, pr);
}

template <int LAYER> struct ProbOutproj {
    static constexpr int K = LAYER == 0 ? EVEN_OUT : ODD_OUT; static constexpr bool PERM = false;
    static constexpr int OWL = LAYER == 0 ? OW0 : OW1, MROWS = LAYER == 0 ? T_ALL : T_LAT;
    const char* A; const char* Bt; const float* mod; const float* x_in; const float* ctx_in; float* xl; float* xc;
    __device__ __forceinline__ int nM() const { return MROWS / 256; }
    __device__ __forceinline__ int nN() const { return D_MODEL / 256; }
    __device__ __forceinline__ const char* a_base() const { return A; }
    __device__ __forceinline__ unsigned a_off(int pm, int r) const {
        const int m = pm * 256 + r;
        if (LAYER == 0) return (unsigned)m * (unsigned)(OWL * 2);
        const int b = m / SEQ, j = m - b * SEQ; return (unsigned)(b * LSEQ + CTX_LEN + j) * (unsigned)(OWL * 2);
    }
    __device__ __forceinline__ const char* b_base(int, int pn) const { return Bt + (size_t)pn * 256 * K * 2; }
    __device__ __forceinline__ void epi(const f32x4 (&acc)[2][2][4][2], int pm, int pn, int wr, int wc, int fr, int fq) const {
#pragma unroll
        for (int ai = 0; ai < 2; ++ai)
#pragma unroll
            for (int m = 0; m < 4; ++m) {
                const int row = pm * 256 + ai * 128 + wr * 64 + m * 16 + fr;
                const float* src; float* dst; const float* md;
                if (LAYER == 0) {
                    const int b = row / LSEQ, s = row - b * LSEQ;
                    if (s < CTX_LEN) { const size_t o = ((size_t)b * CTX_LEN + s) * D_MODEL; src = ctx_in + o; dst = xc + o; md = mod + ((size_t)BATCH * N_MOD + 2) * D_MODEL; }
                    else { const size_t o = ((size_t)b * SEQ + (s - CTX_LEN)) * D_MODEL; src = x_in + o; dst = xl + o; md = mod + ((size_t)b * N_MOD + 2) * D_MODEL; }
                } else {
                    const int b = row / SEQ, jj = row - b * SEQ;
                    const size_t o = ((size_t)b * SEQ + lat_nat<1>(jj)) * D_MODEL; src = xl + o; dst = xl + o; md = mod + ((size_t)b * N_MOD + 2) * D_MODEL;
                }
#pragma unroll
                for (int bj = 0; bj < 2; ++bj)
#pragma unroll
                    for (int n = 0; n < 2; ++n) {
                        const int col = pn * 256 + bj * 128 + wc * 32 + n * 16 + fq * 4;
                        const F4 sv = ldf4(src + col), mv = ldf4(md + col);
                        F4 o; o.x = sv.x + mv.x * acc[ai][bj][m][n][0]; o.y = sv.y + mv.y * acc[ai][bj][m][n][1];
                        o.z = sv.z + mv.z * acc[ai][bj][m][n][2]; o.w = sv.w + mv.w * acc[ai][bj][m][n][3];
                        *reinterpret_cast<F4*>(dst + col) = o;
                    }
            }
    }
};
template <int LAYER> __device__ void phase_outproj(const Params& p, unsigned char* smem) {
    ProbOutproj<LAYER> pr;
    pr.A = reinterpret_cast<const char*>(p.ws + (LAYER == 0 ? WS_O0 : WS_O1)); pr.Bt = reinterpret_cast<const char*>(p.ws + (LAYER == 0 ? WS_WOUT0 : WS_WOUT1));
    pr.mod = reinterpret_cast<const float*>(p.ws + WS_MOD) + (size_t)LAYER * (BATCH + 1) * N_MOD * D_MODEL;
    pr.x_in = p.x; pr.ctx_in = p.ctx; pr.xl = p.out; pr.xc = reinterpret_cast<float*>(p.ws + WS_XC);
    g8::gemm_phase(smem, pr);
}

template <int CTRL> __device__ __forceinline__ int dpp_i(int v) {
#ifdef EMU
    auto r = emu_wave_exchange(&v, 4); const int l = emu_cur->lane; int s;
    if (CTRL == 0xB1) s = l ^ 1; else if (CTRL == 0x4E) s = l ^ 2; else if (CTRL == 0x141) s = (l & ~7) | (7 - (l & 7)); else s = (l & ~15) | (15 - (l & 15));
    int o; memcpy(&o, r[s], 4); return o;
#else
    return __builtin_amdgcn_update_dpp(0, v, CTRL, 0xF, 0xF, true);
#endif
}
template <int LAYER, bool DRY> __device__ void phase_router(const Params& p, unsigned char* smem) {
    constexpr int TM = LAYER == 0 ? T_MOE0 : T_MOE1;
    constexpr int EPL = 4, LPG = N_EXPERTS / EPL, NG = 64 / LPG, DG = D_MODEL / NG;
    constexpr int TB4 = 4;
    constexpr int ROWF = D_MODEL + NG * 4;
    static_assert(N_EXPERTS % EPL == 0 && LPG <= 8 && 64 % LPG == 0 && D_MODEL % NG == 0, "router layout");
    const int tid = opaque_tid(), lane = tid & 63, wl = tid >> 6, wv = (blockIdx.x * NT + tid) >> 6, nwv = gridDim.x * (NT / 64);
    const float* mod = reinterpret_cast<const float*>(p.ws + WS_MOD) + (size_t)LAYER * (BATCH + 1) * N_MOD * D_MODEL;
    const float* xcw = reinterpret_cast<const float*>(p.ws + WS_XC);
    bf16_t* h2 = reinterpret_cast<bf16_t*>(p.ws + WS_H);
    int* tope = reinterpret_cast<int*>(p.ws + WS_TOPE); float* topp = reinterpret_cast<float*>(p.ws + WS_TOPP);
    int* rank = reinterpret_cast<int*>(p.ws + WS_RANK); int* cnt = reinterpret_cast<int*>(p.ws + WS_CNT) + LAYER * N_EXPERTS;
    float* hrow = reinterpret_cast<float*>(smem) + wl * (TB4 * ROWF);
    constexpr int RT_MAXTOK = 1024;
    int* lcount = reinterpret_cast<int*>(smem + 8 * TB4 * ROWF * sizeof(float));
    int* lbase = lcount + N_EXPERTS;
    short* lrec = reinterpret_cast<short*>(lbase + N_EXPERTS);
    if (tid < N_EXPERTS) lcount[tid] = 0;
    __syncthreads();
    const float* g = p.norm2_w + LAYER * D_MODEL;
    const float* rw = p.router_w + (size_t)LAYER * D_MODEL * N_EXPERTS;
    constexpr int NV = D_MODEL / 256;
    const int eg = lane % LPG, dg = lane / LPG;
    const F4 rb = ldf4(p.router_b + LAYER * N_EXPERTS + eg * EPL);
    int itg = 0;
    for (int tok0 = wv; tok0 < TM; tok0 += TB4 * nwv, ++itg) {
#pragma unroll
        for (int q = 0; q < TB4; ++q) {
            const int tok = tok0 + q * nwv;
            if (tok < TM) {
                const float* src; const float* md;
                if (LAYER == 0 && tok < T_CTX) { src = xcw + (size_t)tok * D_MODEL; md = mod + (size_t)BATCH * N_MOD * D_MODEL; }
                else { const int n = LAYER == 0 ? tok - T_CTX : tok; src = p.out + (size_t)n * D_MODEL; md = mod + (size_t)(n / SEQ) * N_MOD * D_MODEL; }
                F4 v[NV]; float ss = 0.f;
#pragma unroll
                for (int i = 0; i < NV; ++i) { v[i] = ldf4(src + i * 256 + lane * 4); ss += v[i].x * v[i].x + v[i].y * v[i].y + v[i].z * v[i].z + v[i].w * v[i].w; }
                ss = wave_sum(ss);
                const float rs = rsqrtf(ss * (1.0f / D_MODEL) + EPS);
#pragma unroll
                for (int i = 0; i < NV; ++i) {
                    const int c = i * 256 + lane * 4;
                    F4 gg = ldf4(g + c), m3 = ldf4(md + 3 * D_MODEL + c), m4 = ldf4(md + 4 * D_MODEL + c);
                    F4 o; o.x = v[i].x * rs * gg.x * (1.f + m4.x) + m3.x; o.y = v[i].y * rs * gg.y * (1.f + m4.y) + m3.y;
                    o.z = v[i].z * rs * gg.z * (1.f + m4.z) + m3.z; o.w = v[i].w * rs * gg.w * (1.f + m4.w) + m3.w;
                    unsigned* dst = reinterpret_cast<unsigned*>(h2 + (size_t)tok * D_MODEL + c);
                    if (!DRY) { dst[0] = pack2(o.x, o.y); dst[1] = pack2(o.z, o.w); }
                    *reinterpret_cast<F4*>(hrow + q * ROWF + c + (c / DG) * 4) = o;
                }
            }
        }
        wave_sync();
        float lg[TB4][EPL];
#pragma unroll
        for (int q = 0; q < TB4; ++q)
#pragma unroll
            for (int e = 0; e < EPL; ++e) lg[q][e] = 0.f;
        const float* rwp = rw + (size_t)dg * DG * N_EXPERTS + eg * EPL; const float* hp = hrow + dg * (DG + 4);
        constexpr int WB = DG >= 16 ? 16 : DG;
        static_assert(DG % WB == 0, "router batch");
#pragma unroll 1
        for (int d0 = 0; d0 < DG; d0 += WB) {
            F4 w[WB];
#pragma unroll
            for (int u = 0; u < WB; ++u) w[u] = ldf4(rwp + (size_t)(d0 + u) * N_EXPERTS);
#ifndef EMU
            __builtin_amdgcn_sched_barrier(0);
#endif
#pragma unroll
            for (int u = 0; u < WB; ++u) {
#pragma unroll
                for (int q = 0; q < TB4; ++q) {
                    const float hv = hp[q * ROWF + d0 + u];
                    lg[q][0] += hv * w[u].x; lg[q][1] += hv * w[u].y; lg[q][2] += hv * w[u].z; lg[q][3] += hv * w[u].w;
                }
            }
        }
#pragma unroll
        for (int q = 0; q < TB4; ++q) {
#pragma unroll
            for (int m = LPG; m < 64; m <<= 1) {
#pragma unroll
                for (int e = 0; e < EPL; ++e) lg[q][e] += __shfl_xor(lg[q][e], m, 64);
            }
            lg[q][0] += rb.x; lg[q][1] += rb.y; lg[q][2] += rb.z; lg[q][3] += rb.w;
            float tv[TOP_K]; int ti[TOP_K];
#pragma unroll
            for (int k = 0; k < TOP_K; ++k) {
                float bv = lg[q][0]; int bi = eg * EPL;
#pragma unroll
                for (int e = 1; e < EPL; ++e) if (lg[q][e] > bv) { bv = lg[q][e]; bi = eg * EPL + e; }
                if (LPG > 1) { const float ov = dpp_f<0xB1>(bv); const int oi = dpp_i<0xB1>(bi); if (ov > bv || (ov == bv && oi < bi)) { bv = ov; bi = oi; } }
                if (LPG > 2) { const float ov = dpp_f<0x4E>(bv); const int oi = dpp_i<0x4E>(bi); if (ov > bv || (ov == bv && oi < bi)) { bv = ov; bi = oi; } }
                if (LPG > 4) { const float ov = dpp_f<0x141>(bv); const int oi = dpp_i<0x141>(bi); if (ov > bv || (ov == bv && oi < bi)) { bv = ov; bi = oi; } }
                tv[k] = bv; ti[k] = bi;
#pragma unroll
                for (int e = 0; e < EPL; ++e) if (eg * EPL + e == bi) lg[q][e] = -INFINITY;
            }
            const int tok = tok0 + q * nwv;
            if (lane == 0 && tok < TM) {
                float s = 0.f, pe[TOP_K];
#pragma unroll
                for (int k = 0; k < TOP_K; ++k) { pe[k] = fexp(tv[k] - tv[0]); s += pe[k]; }
                const int itk = itg * TB4 + q;
#pragma unroll
                for (int k = 0; k < TOP_K; ++k) {
                    if (DRY) { sink(ti[k]); sink(pe[k] / s); }
                    else {
                        tope[(size_t)tok * TOP_K + k] = ti[k]; topp[(size_t)tok * TOP_K + k] = pe[k] / s;
                        const int lr = atomicAdd(&lcount[ti[k]], 1);
                        const int slot = ((itk * (NT / 64) + wl) * TOP_K + k) * 2;
                        lrec[slot] = (short)ti[k]; lrec[slot + 1] = (short)lr;
                    }
                }
            }
        }
        wave_sync();
    }
    if (!DRY) {
        __syncthreads();
        if (tid < N_EXPERTS) lbase[tid] = atomicAdd(&cnt[tid], lcount[tid]);
        __syncthreads();
        const int wv0 = (blockIdx.x * NT) >> 6;
        const int itmax = wv0 < TM ? (TM - 1 - wv0) / nwv + 1 : 0;
        for (int q = tid; q < itmax * (NT / 64) * TOP_K; q += NT) {
            const int itq = q / ((NT / 64) * TOP_K), rem = q - itq * ((NT / 64) * TOP_K), wq = rem / TOP_K, kq2 = rem - wq * TOP_K;
            const int tokq = wv0 + wq + itq * nwv;
            if (tokq < TM) rank[(size_t)tokq * TOP_K + kq2] = lbase[lrec[q * 2]] + lrec[q * 2 + 1];
        }
    }
}

struct MoeTab { int poff[N_EXPERTS + 1]; int cnt[N_EXPERTS]; int tile_e[MAX_MTILES]; int ntiles; };
template <int LAYER> __device__ __forceinline__ void build_moe_tab(const Params& p, MoeTab* tab) {
    const int* cnt = reinterpret_cast<const int*>(p.ws + WS_CNT) + LAYER * N_EXPERTS;
    const int tid = opaque_tid();
    if (tid < N_EXPERTS) tab->cnt[tid] = cnt[tid];
    __syncthreads();
    if (tid == 0) {
        int off = 0, nt = 0;
        for (int e = 0; e < N_EXPERTS; ++e) { tab->poff[e] = off; const int tl = (tab->cnt[e] + BM - 1) / BM; off += tl * BM; nt += tl; }
        tab->poff[N_EXPERTS] = off; tab->ntiles = nt;
    }
    __syncthreads();
    if (tid < N_EXPERTS) {
        const int t0 = tab->poff[tid] / BM, t1 = tab->poff[tid + 1] / BM;
        for (int t = t0; t < t1; ++t) tab->tile_e[t] = tid;
    }
    __syncthreads();
}

template <int LAYER> __device__ void phase_scatter(const Params& p, unsigned char* smem) {
    constexpr int TM = LAYER == 0 ? T_MOE0 : T_MOE1;
    MoeTab* tab = reinterpret_cast<MoeTab*>(smem);
    build_moe_tab<LAYER>(p, tab);
    const int* tope = reinterpret_cast<const int*>(p.ws + WS_TOPE); const int* rank = reinterpret_cast<const int*>(p.ws + WS_RANK);
    int* posof = reinterpret_cast<int*>(p.ws + WS_POSOF); int* tokof = reinterpret_cast<int*>(p.ws + WS_TOKOF);
    for (int i = blockIdx.x * NT + opaque_tid(); i < TM * TOP_K; i += gridDim.x * NT) {
        const int pos = tab->poff[tope[i]] + rank[i];
        posof[i] = pos; tokof[pos] = i / TOP_K;
    }
    __syncthreads();
    if (LAYER == 1) convert_expert_weights<1>(p, blockIdx.x, gridDim.x, smem, (int)gridDim.x > SCAN1_UNITS ? CVT_NDN : 0, CVT_NTOT);
}

constexpr int MOE1_MAX_UNITS = 24;
template <int LAYER, bool DRYE = false> struct ProbMoe1 {
    static constexpr int K = D_MODEL; static constexpr bool PERM = true;
    const MoeTab* tab; const char* A; const char* W; const int* toklds; bf16_t* H1; const float* bg; const float* bu; int G, c, nNv;
    __device__ __forceinline__ int nM() const { return tab->ntiles; }
    __device__ __forceinline__ int nN() const { return 2 * D_FF / 256; }
    __device__ __forceinline__ const char* a_base() const { return A; }
    __device__ __forceinline__ unsigned a_off(int pm, int r) const {
        int slot = 0;
        for (int i = 0; i < MOE1_MAX_UNITS; ++i) { if (toklds[MOE1_MAX_UNITS * 256 + i] == pm) { slot = i; break; } }
        return (unsigned)toklds[slot * 256 + r] * (unsigned)(K * 2);
    }
    __device__ __forceinline__ const char* b_base(int pm, int pn) const { return W + ((size_t)tab->tile_e[pm] * 2 * D_FF + (size_t)pn * 256) * K * 2; }
    __device__ __forceinline__ void epi(const f32x4 (&acc)[2][2][4][2], int pm, int pn, int wr, int wc, int fr, int fq) const {
        if (DRYE) { float t = 0.f; for (int a = 0; a < 2; ++a) for (int b = 0; b < 2; ++b) for (int m = 0; m < 4; ++m) for (int n = 0; n < 2; ++n) t += acc[a][b][m][n][0] + acc[a][b][m][n][1] + acc[a][b][m][n][2] + acc[a][b][m][n][3]; sink(t); return; }
        const int e = tab->tile_e[pm], col = pn * 128 + wc * 32 + fq * 8;
        const float* bgp = bg + (size_t)e * D_FF + col; const float* bup = bu + (size_t)e * D_FF + col;
        float bgv[8], buv[8];
#pragma unroll
        for (int i = 0; i < 2; ++i) { const F4 a = ldf4(bgp + 4 * i), b = ldf4(bup + 4 * i); bgv[4 * i] = a.x; bgv[4 * i + 1] = a.y; bgv[4 * i + 2] = a.z; bgv[4 * i + 3] = a.w; buv[4 * i] = b.x; buv[4 * i + 1] = b.y; buv[4 * i + 2] = b.z; buv[4 * i + 3] = b.w; }
#pragma unroll
        for (int ai = 0; ai < 2; ++ai)
#pragma unroll
            for (int m = 0; m < 4; ++m) {
                const int row = pm * 256 + ai * 128 + wr * 64 + m * 16 + fr;
                f32x4 hv[2];
#pragma unroll
                for (int n = 0; n < 2; ++n)
#pragma unroll
                    for (int j = 0; j < 4; ++j) {
                        const float gv = fminf(acc[ai][0][m][n][j] + bgv[4 * n + j], SWIGLU_LIMIT);
                        const float uv = fminf(fmaxf(acc[ai][1][m][n][j] + buv[4 * n + j], -SWIGLU_LIMIT), SWIGLU_LIMIT);
                        hv[n][j] = gv * sigmoidf_(SWIGLU_ALPHA * gv) * (uv + 1.f);
                    }
                st16(H1 + (size_t)row * D_FF + col, pack8(hv[0], hv[1]));
            }
    }
};
template <int LAYER, bool DRYE = false> __device__ void phase_moe1(const Params& p, unsigned char* smem) {
    MoeTab* tab = reinterpret_cast<MoeTab*>(smem + g8::STAGE_BYTES);
    build_moe_tab<LAYER>(p, tab);
    ProbMoe1<LAYER, DRYE> pr;
    pr.tab = tab; pr.A = reinterpret_cast<const char*>(p.ws + WS_H); pr.W = reinterpret_cast<const char*>(p.ws + WS_WGU);
    pr.H1 = reinterpret_cast<bf16_t*>(p.ws + WS_H1);
    {
        int* toklds = reinterpret_cast<int*>(smem + g8::STAGE_BYTES + 4096);
        int* slot_pm = toklds + MOE1_MAX_UNITS * 256;
        const int* tokof = reinterpret_cast<const int*>(p.ws + WS_TOKOF);
        const int tid = opaque_tid(), nM = tab->ntiles, nN = 2 * D_FF / 256;
        if (tid < MOE1_MAX_UNITS) slot_pm[tid] = -1;
        __syncthreads();
        if (tid == 0) {
            int nslot = 0;
            for (int i = 0; i < MOE1_MAX_UNITS * 4; ++i) {
                int pm, pn; if (!g8::unit_of(i * (int)gridDim.x + (int)blockIdx.x, nM, nN, pm, pn)) break;
                bool seen = false;
                for (int q = 0; q < nslot; ++q) seen = seen || (slot_pm[q] == pm);
                if (!seen && nslot < MOE1_MAX_UNITS) slot_pm[nslot++] = pm;
            }
            slot_pm[MOE1_MAX_UNITS] = nslot;
        }
        __syncthreads();
        const int nslot = slot_pm[MOE1_MAX_UNITS];
        for (int idx = tid; idx < nslot * 256; idx += NT) {
            const int pm = slot_pm[idx >> 8], e = tab->tile_e[pm], pbase = tab->poff[e], pos = pm * 256 + (idx & 255);
            toklds[idx] = tokof[(pos - pbase < tab->cnt[e]) ? pos : pbase];
        }
        __syncthreads();
        pr.toklds = toklds;
    }
    pr.bg = p.exp_b_gate + (size_t)LAYER * N_EXPERTS * D_FF; pr.bu = p.exp_b_up + (size_t)LAYER * N_EXPERTS * D_FF;
    g8::gemm_phase(smem, pr);
}

template <int LAYER, bool DRYE = false> struct ProbMoe2 {
    static constexpr int K = D_FF; static constexpr bool PERM = true;
    const MoeTab* tab; const char* A; const char* W; bf16_t* Y; const float* bd;
    __device__ __forceinline__ int nM() const { return tab->ntiles; }
    __device__ __forceinline__ int nN() const { return D_MODEL / 256; }
    __device__ __forceinline__ const char* a_base() const { return A; }
    __device__ __forceinline__ unsigned a_off(int pm, int r) const { return (unsigned)(pm * 256 + r) * (unsigned)(K * 2); }
    __device__ __forceinline__ const char* b_base(int pm, int pn) const { return W + ((size_t)tab->tile_e[pm] * D_MODEL + (size_t)pn * 256) * K * 2; }
    __device__ __forceinline__ void epi(const f32x4 (&acc)[2][2][4][2], int pm, int pn, int wr, int wc, int fr, int fq) const {
        if (DRYE) { float t = 0.f; for (int a = 0; a < 2; ++a) for (int b = 0; b < 2; ++b) for (int m = 0; m < 4; ++m) for (int n = 0; n < 2; ++n) t += acc[a][b][m][n][0] + acc[a][b][m][n][1] + acc[a][b][m][n][2] + acc[a][b][m][n][3]; sink(t); return; }
        const int e = tab->tile_e[pm];
#pragma unroll
        for (int bj = 0; bj < 2; ++bj) {
            const int col = pn * 256 + bj * 128 + wc * 32 + fq * 8;
            const F4 b0 = ldf4(bd + (size_t)e * D_MODEL + col), b1 = ldf4(bd + (size_t)e * D_MODEL + col + 4);
#pragma unroll
            for (int ai = 0; ai < 2; ++ai)
#pragma unroll
                for (int m = 0; m < 4; ++m) {
                    const int row = pm * 256 + ai * 128 + wr * 64 + m * 16 + fr;
                    f32x4 v0 = acc[ai][bj][m][0], v1 = acc[ai][bj][m][1];
                    v0[0] += b0.x; v0[1] += b0.y; v0[2] += b0.z; v0[3] += b0.w; v1[0] += b1.x; v1[1] += b1.y; v1[2] += b1.z; v1[3] += b1.w;
                    st16(Y + (size_t)row * D_MODEL + col, pack8(v0, v1));
                }
        }
    }
};
template <int LAYER, bool DRYE = false> __device__ void phase_moe2(const Params& p, unsigned char* smem) {
    MoeTab* tab = reinterpret_cast<MoeTab*>(smem + g8::STAGE_BYTES);
    build_moe_tab<LAYER>(p, tab);
    ProbMoe2<LAYER, DRYE> pr;
    pr.tab = tab; pr.A = reinterpret_cast<const char*>(p.ws + WS_H1); pr.W = reinterpret_cast<const char*>(p.ws + WS_WDN);
    pr.Y = reinterpret_cast<bf16_t*>(p.ws + WS_Y); pr.bd = p.exp_b_down + (size_t)LAYER * N_EXPERTS * D_MODEL;
    g8::gemm_phase(smem, pr);
}

template <int LAYER, bool DRY> __device__ void phase_combine(const Params& p) {
    constexpr int TM = LAYER == 0 ? T_MOE0 : T_MOE1;
    const int tid = opaque_tid(), lane = tid & 63, wv = (blockIdx.x * NT + tid) >> 6, nwv = gridDim.x * (NT / 64);
    const float* mod = reinterpret_cast<const float*>(p.ws + WS_MOD) + (size_t)LAYER * (BATCH + 1) * N_MOD * D_MODEL;
    float* xcw = reinterpret_cast<float*>(p.ws + WS_XC);
    const bf16_t* Y = reinterpret_cast<const bf16_t*>(p.ws + WS_Y);
    const int* posof = reinterpret_cast<const int*>(p.ws + WS_POSOF); const float* topp = reinterpret_cast<const float*>(p.ws + WS_TOPP);
    constexpr int NV = D_MODEL / 256;
    for (int tok = wv; tok < TM; tok += nwv) {
        float* xr; const float* md;
        if (LAYER == 0 && tok < T_CTX) { xr = xcw + (size_t)tok * D_MODEL; md = mod + ((size_t)BATCH * N_MOD + 5) * D_MODEL; }
        else { const int n = LAYER == 0 ? tok - T_CTX : tok; xr = p.out + (size_t)n * D_MODEL; md = mod + ((size_t)(n / SEQ) * N_MOD + 5) * D_MODEL; }
        int pos[TOP_K]; float pr[TOP_K];
#pragma unroll
        for (int k = 0; k < TOP_K; ++k) { pos[k] = posof[(size_t)tok * TOP_K + k]; pr[k] = topp[(size_t)tok * TOP_K + k]; }
        F4 xo[NV]; float ss = 0.f;
#pragma unroll
        for (int i = 0; i < NV; ++i) {
            const int c = i * 256 + lane * 4;
            float f0 = 0.f, f1 = 0.f, f2 = 0.f, f3 = 0.f;
#pragma unroll
            for (int k = 0; k < TOP_K; ++k) {
                const unsigned* yp = reinterpret_cast<const unsigned*>(Y + (size_t)pos[k] * D_MODEL + c);
                const unsigned u0 = yp[0], u1 = yp[1];
                f0 += pr[k] * lo2f(u0); f1 += pr[k] * hi2f(u0); f2 += pr[k] * lo2f(u1); f3 += pr[k] * hi2f(u1);
            }
            F4 xv = ldf4(xr + c), m5 = ldf4(md + c);
            xv.x += m5.x * f0; xv.y += m5.y * f1; xv.z += m5.z * f2; xv.w += m5.w * f3;
            xo[i] = xv; ss += xv.x * xv.x + xv.y * xv.y + xv.z * xv.z + xv.w * xv.w;
        }
        if (LAYER == 0 && !DRY) {
            const float rs1 = rsqrtf(wave_sum(ss) * (1.0f / D_MODEL) + EPS);
            const float* mod1 = reinterpret_cast<const float*>(p.ws + WS_MOD) + (size_t)(BATCH + 1) * N_MOD * D_MODEL;
            const float* md1; size_t drow;
            if (tok < T_CTX) { md1 = mod1 + (size_t)BATCH * N_MOD * D_MODEL; drow = (size_t)(tok / CTX_LEN) * LSEQ + tok % CTX_LEN; }
            else {
                const int n = tok - T_CTX, bb = n / SEQ, nn = n - bb * SEQ, r = nn / GRID_W, w = nn - r * GRID_W;
                md1 = mod1 + (size_t)bb * N_MOD * D_MODEL; drow = (size_t)bb * LSEQ + CTX_LEN + w * GRID_ROWS + r;
            }
            bf16_t* hrow1 = reinterpret_cast<bf16_t*>(p.ws + WS_H) + drow * D_MODEL;
#pragma unroll
            for (int i = 0; i < NV; ++i) {
                const int c = i * 256 + lane * 4;
                const F4 gg = ldf4(p.norm1_w + D_MODEL + c), m0 = ldf4(md1 + c), m1 = ldf4(md1 + D_MODEL + c);
                unsigned* dst = reinterpret_cast<unsigned*>(hrow1 + c);
                dst[0] = pack2(xo[i].x * rs1 * gg.x * (1.f + m1.x) + m0.x, xo[i].y * rs1 * gg.y * (1.f + m1.y) + m0.y);
                dst[1] = pack2(xo[i].z * rs1 * gg.z * (1.f + m1.z) + m0.z, xo[i].w * rs1 * gg.w * (1.f + m1.w) + m0.w);
            }
        }
        if (LAYER == 1) {
            ss = wave_sum(ss);
            const float rs = rsqrtf(ss * (1.0f / D_MODEL) + EPS);
#pragma unroll
            for (int i = 0; i < NV; ++i) {
                const int c = i * 256 + lane * 4; F4 gg = ldf4(p.final_norm_w + c);
                xo[i].x *= rs * gg.x; xo[i].y *= rs * gg.y; xo[i].z *= rs * gg.z; xo[i].w *= rs * gg.w;
            }
        }
#pragma unroll
        for (int i = 0; i < NV; ++i) { if (DRY) { sink(xo[i].x); sink(xo[i].y); sink(xo[i].z); sink(xo[i].w); } else *reinterpret_cast<F4*>(xr + i * 256 + lane * 4) = xo[i]; }
    }
}
__device__ void phase_prep1(const Params& p) {
    constexpr int NP = ODD_PROJ_PAD, RB = 32;
    constexpr int NCG = XC_W / 8;
    static_assert(SSD_CONV_CH % 8 == 0 && XC_W % 8 == 0 && SSD_INNER % 8 == 0 && SSD_PROJ % 8 == 0, "prep1 alignment");
    const bf16_t* P = reinterpret_cast<const bf16_t*>(p.ws + WS_P);
    bf16_t* XC = reinterpret_cast<bf16_t*>(p.ws + WS_AUX1);
    const int tid = opaque_tid();
    for (int task = blockIdx.x * NT + tid; task < (T_ALL / RB) * NCG; task += gridDim.x * NT) {
        const int rb = task / NCG, cg = task - rb * NCG, c = cg * 8, row0 = rb * RB;
        const int s0 = row0 % LSEQ;
        const int lo = s0 < CTX_LEN ? 0 : CTX_LEN, hi = s0 < CTX_LEN ? CTX_LEN : LSEQ;
        int pc; const float* cw; const float* cb; int cc, cwid;
        if (c < SSD_CONV_CH) { pc = SSD_INNER + c; cw = p.ssd_conv_w; cb = p.ssd_conv_b; cc = c; cwid = SSD_CONV_CH; }
        else { cc = c - SSD_CONV_CH; pc = SSD_PROJ + cc; cw = p.mlstm_conv_w; cb = p.mlstm_conv_b; cwid = 2 * ML_QKW; }
        float w[5][8], bias[8];
#pragma unroll
        for (int j = 0; j < 5; ++j) { const F4 a = ldf4(cw + j * cwid + cc), b = ldf4(cw + j * cwid + cc + 4); w[j][0] = a.x; w[j][1] = a.y; w[j][2] = a.z; w[j][3] = a.w; w[j][4] = b.x; w[j][5] = b.y; w[j][6] = b.z; w[j][7] = b.w; }
        { const F4 a = ldf4(cb + cc), b = ldf4(cb + cc + 4); bias[0] = a.x; bias[1] = a.y; bias[2] = a.z; bias[3] = a.w; bias[4] = b.x; bias[5] = b.y; bias[6] = b.z; bias[7] = b.w; }
        const bf16_t* src = P + (size_t)row0 * NP + pc;
        U4 win[5];
        const U4 zero = U4{0u, 0u, 0u, 0u};
        win[0] = zero; win[1] = zero;
        if (s0 - 2 >= lo) win[0] = ld16(src - 2 * (size_t)NP);
        if (s0 - 1 >= lo) win[1] = ld16(src - (size_t)NP);
        win[2] = ld16(src); win[3] = ld16(src + NP);
#pragma unroll 4
        for (int r = 0; r < RB; ++r) {
            win[4] = (s0 + r + 2 < hi) ? ld16(src + (size_t)(r + 2) * NP) : zero;
            float acc[8];
#pragma unroll
            for (int q = 0; q < 8; ++q) acc[q] = bias[q];
#pragma unroll
            for (int j = 0; j < 5; ++j) {
                const unsigned uu[4] = {win[j].x, win[j].y, win[j].z, win[j].w};
#pragma unroll
                for (int q = 0; q < 4; ++q) { acc[2 * q] += lo2f(uu[q]) * w[j][2 * q]; acc[2 * q + 1] += hi2f(uu[q]) * w[j][2 * q + 1]; }
            }
            U4 o; o.x = pack2(siluf_(acc[0]), siluf_(acc[1])); o.y = pack2(siluf_(acc[2]), siluf_(acc[3]));
            o.z = pack2(siluf_(acc[4]), siluf_(acc[5])); o.w = pack2(siluf_(acc[6]), siluf_(acc[7]));
            st16(XC + (size_t)(row0 + r) * XC_W + c, o);
            win[0] = win[1]; win[1] = win[2]; win[2] = win[3]; win[3] = win[4];
        }
    }
}

#ifdef EMU
__device__ __forceinline__ float wave_incl_scan_add(float v, int lane) {
#pragma unroll
    for (int d = 1; d < 64; d <<= 1) { const float o = __shfl_up(v, d, 64); if (lane >= d) v += o; }
    return v;
}
__device__ __forceinline__ float wave_incl_scan_max(float v, int lane) {
#pragma unroll
    for (int d = 1; d < 64; d <<= 1) { const float o = __shfl_up(v, d, 64); if (lane >= d) v = fmaxf(v, o); }
    return v;
}
__device__ __forceinline__ float wave_last(float v) { return __shfl(v, 63, 64); }
#else
template <int CTRL, int ROWMASK> __device__ __forceinline__ float dpp_or(float oldv, float v) {
    return __builtin_bit_cast(float, __builtin_amdgcn_update_dpp(__builtin_bit_cast(int, oldv), __builtin_bit_cast(int, v), CTRL, ROWMASK, 0xF, false));
}
__device__ __forceinline__ float wave_incl_scan_add(float v, int) {
    v += dpp_or<0x111, 0xF>(0.f, v); v += dpp_or<0x112, 0xF>(0.f, v); v += dpp_or<0x114, 0xF>(0.f, v); v += dpp_or<0x118, 0xF>(0.f, v);
    v += dpp_or<0x142, 0xA>(0.f, v); v += dpp_or<0x143, 0xC>(0.f, v);
    return v;
}
__device__ __forceinline__ float wave_incl_scan_max(float v, int) {
    const float ninf = -INFINITY;
    v = fmaxf(v, dpp_or<0x111, 0xF>(ninf, v)); v = fmaxf(v, dpp_or<0x112, 0xF>(ninf, v)); v = fmaxf(v, dpp_or<0x114, 0xF>(ninf, v)); v = fmaxf(v, dpp_or<0x118, 0xF>(ninf, v));
    v = fmaxf(v, dpp_or<0x142, 0xA>(ninf, v)); v = fmaxf(v, dpp_or<0x143, 0xC>(ninf, v));
    return v;
}
__device__ __forceinline__ float wave_last(float v) { return __builtin_bit_cast(float, __builtin_amdgcn_readlane(__builtin_bit_cast(int, v), 63)); }
#endif

__device__ void ssd_unit(const Params& p, unsigned char* smem, int u) {
    constexpr int NP = ODD_PROJ_PAD, CH = SSD_CH, HP = SSD_HG / 2, LDN = 136, LDS_ = 72;
    const int dir = u / (BATCH * SSD_G * HP), b = (u / (SSD_G * HP)) % BATCH, g = (u / HP) % SSD_G, hp = u % HP;
    const int tid = opaque_tid(), wid = tid >> 6, lane = tid & 63, fr = lane & 15, fq = lane >> 4;
    const int hh = wid >> 2, wq = wid & 3, head0 = g * SSD_HG + hp * 2, head = head0 + hh;
    const bf16_t* P = reinterpret_cast<const bf16_t*>(p.ws + WS_P);
    const bf16_t* XC = reinterpret_cast<const bf16_t*>(p.ws + WS_AUX1);
    bf16_t* O = reinterpret_cast<bf16_t*>(p.ws + WS_O1) + (size_t)dir * T_ALL * OW1;
    bf16_t* Cm = reinterpret_cast<bf16_t*>(smem);
    bf16_t* Bm = Cm + CH * LDN;
    bf16_t* BT = Bm + CH * LDN;
    bf16_t* xL = BT + 128 * LDS_;
    bf16_t* Gb = xL + CH * 128;
    bf16_t* xdtTb = Gb + 2 * CH * LDS_;
    bf16_t* xdtETb = xdtTb + 2 * 64 * LDS_;
    float* acumb = reinterpret_cast<float*>(xdtETb + 2 * 64 * LDS_);
    f32x4 hs[8];
#pragma unroll
    for (int n = 0; n < 8; ++n) hs[n] = f32x4{0.f, 0.f, 0.f, 0.f};
    const float dtb = p.ssd_dt_bias[dir * SSD_HEADS + head], aneg = -fexp(p.ssd_a_log[dir * SSD_HEADS + head]);
    const int lt = tid >> 4, lc = (tid & 15) * 8;
    U4 rB[2], rC[2], rX[2]; float rdt = 0.f;
    auto issue = [&](int j0) {
#pragma unroll
        for (int i = 0; i < 2; ++i) {
            const bf16_t* xr = XC + ((size_t)b * LSEQ + step_pos(dir, j0 + lt + 32 * i)) * XC_W;
            rB[i] = ld16(xr + SSD_INNER + g * SSD_N + lc); rC[i] = ld16(xr + SSD_INNER + SSD_G * SSD_N + g * SSD_N + lc);
            rX[i] = ld16(xr + head0 * SSD_P + lc);
        }
        if (wq == 0) rdt = bf2f(P[((size_t)b * LSEQ + step_pos(dir, j0 + lane)) * NP + SSD_INNER + SSD_CONV_CH + dir * SSD_HEADS + head]);
    };
    issue(0);
    for (int j0 = 0; j0 < LSEQ; j0 += CH) {
#pragma unroll
        for (int i = 0; i < 2; ++i) {
            const int t = lt + 32 * i;
            st16(Bm + t * LDN + lc, rB[i]); st16(Cm + t * LDN + lc, rC[i]); st16(xL + t * 128 + lc, rX[i]);
        }
        if (wq == 0) {
            const float dt = softplusf_(rdt + dtb);
            const float ac = wave_incl_scan_add(dt * aneg, lane);
            acumb[hh * 128 + lane] = ac; acumb[hh * 128 + 64 + lane] = dt;
        }
        lds_barrier();
        if (j0 + CH < LSEQ) issue(j0 + CH);
#pragma unroll
        for (int i = 0; i < 2; ++i) {
            const int it = tid + 512 * i;
            { const int sg = it >> 7, n = it & 127; st16(BT + n * LDS_ + 8 * sg, gather8(Bm + (8 * sg) * LDN + n, LDN)); }
            {
                const int h2 = it >> 9, sg = (it >> 6) & 7, pp = it & 63;
                const U4 x8 = gather8(xL + (8 * sg) * 128 + h2 * 64 + pp, 128);
                const float* ac = acumb + h2 * 128;
                const F4 a0 = ldf4(ac + 8 * sg), a1 = ldf4(ac + 8 * sg + 4), d0 = ldf4(ac + 64 + 8 * sg), d1 = ldf4(ac + 64 + 8 * sg + 4);
                const float al = ac[63];
                const float xv[8] = {lo2f(x8.x) * d0.x, hi2f(x8.x) * d0.y, lo2f(x8.y) * d0.z, hi2f(x8.y) * d0.w, lo2f(x8.z) * d1.x, hi2f(x8.z) * d1.y, lo2f(x8.w) * d1.z, hi2f(x8.w) * d1.w};
                const float ev[8] = {fexp(al - a0.x), fexp(al - a0.y), fexp(al - a0.z), fexp(al - a0.w), fexp(al - a1.x), fexp(al - a1.y), fexp(al - a1.z), fexp(al - a1.w)};
                U4 o; o.x = pack2(xv[0], xv[1]); o.y = pack2(xv[2], xv[3]); o.z = pack2(xv[4], xv[5]); o.w = pack2(xv[6], xv[7]);
                st16(xdtTb + h2 * (64 * LDS_) + pp * LDS_ + 8 * sg, o);
                o.x = pack2(xv[0] * ev[0], xv[1] * ev[1]); o.y = pack2(xv[2] * ev[2], xv[3] * ev[3]); o.z = pack2(xv[4] * ev[4], xv[5] * ev[5]); o.w = pack2(xv[6] * ev[6], xv[7] * ev[7]);
                st16(xdtETb + h2 * (64 * LDS_) + pp * LDS_ + 8 * sg, o);
            }
        }
#pragma unroll
        for (int q = 0; q < 2; ++q) {
            const int tile = wid * 2 + q, ti = tile >> 2, si = tile & 3;
            f32x4 a = f32x4{0.f, 0.f, 0.f, 0.f};
#pragma unroll
            for (int ks = 0; ks < 4; ++ks) {
                bf16x8 fa = *reinterpret_cast<const bf16x8*>(Cm + (ti * 16 + fr) * LDN + ks * 32 + fq * 8);
                bf16x8 fb = *reinterpret_cast<const bf16x8*>(Bm + (si * 16 + fr) * LDN + ks * 32 + fq * 8);
                a = mfma16(fb, fa, a);
            }
            const int t = ti * 16 + fr, s0 = si * 16 + fq * 4;
#pragma unroll
            for (int h2 = 0; h2 < 2; ++h2) {
                const float* ac = acumb + h2 * 128;
                const float at = ac[t]; const F4 as = ldf4(ac + s0);
                const float e0 = s0 <= t ? a[0] * fexp(at - as.x) : 0.f, e1 = s0 + 1 <= t ? a[1] * fexp(at - as.y) : 0.f;
                const float e2 = s0 + 2 <= t ? a[2] * fexp(at - as.z) : 0.f, e3 = s0 + 3 <= t ? a[3] * fexp(at - as.w) : 0.f;
                unsigned* dst = reinterpret_cast<unsigned*>(Gb + h2 * (CH * LDS_) + t * LDS_ + s0);
                dst[0] = pack2(e0, e1); dst[1] = pack2(e2, e3);
            }
        }
        lds_barrier();
        {
            const bf16_t* Gm = Gb + hh * (CH * LDS_); const bf16_t* xdtT = xdtTb + hh * (64 * LDS_); const bf16_t* xdtET = xdtETb + hh * (64 * LDS_);
            const float* ac = acumb + hh * 128;
            const bool lat = step_pos(dir, j0) >= CTX_LEN;
#pragma unroll
            for (int ti = 0; ti < 4; ++ti) {
                f32x4 a1 = f32x4{0.f, 0.f, 0.f, 0.f}, a2 = f32x4{0.f, 0.f, 0.f, 0.f};
#pragma unroll
                for (int ks = 0; ks < 2; ++ks) {
                    bf16x8 fa = *reinterpret_cast<const bf16x8*>(Gm + (ti * 16 + fr) * LDS_ + ks * 32 + fq * 8);
                    bf16x8 fb = *reinterpret_cast<const bf16x8*>(xdtT + (wq * 16 + fr) * LDS_ + ks * 32 + fq * 8);
                    a1 = mfma16(fb, fa, a1);
                }
#pragma unroll
                for (int ks = 0; ks < 4; ++ks) {
                    U4 su; su.x = pack2(hs[2 * ks][0], hs[2 * ks][1]); su.y = pack2(hs[2 * ks][2], hs[2 * ks][3]);
                    su.z = pack2(hs[2 * ks + 1][0], hs[2 * ks + 1][1]); su.w = pack2(hs[2 * ks + 1][2], hs[2 * ks + 1][3]);
                    const unsigned long long c0 = *reinterpret_cast<const unsigned long long*>(Cm + (ti * 16 + fr) * LDN + ks * 32 + 4 * fq);
                    const unsigned long long c1 = *reinterpret_cast<const unsigned long long*>(Cm + (ti * 16 + fr) * LDN + ks * 32 + 16 + 4 * fq);
                    U4 cu; cu.x = (unsigned)c0; cu.y = (unsigned)(c0 >> 32); cu.z = (unsigned)c1; cu.w = (unsigned)(c1 >> 32);
                    a2 = mfma16(__builtin_bit_cast(bf16x8, su), __builtin_bit_cast(bf16x8, cu), a2);
                }
                if (lat) {
                    const int t = ti * 16 + fr;
                    const float ea = fexp(ac[t]);
                    const size_t rowg = (size_t)b * LSEQ + step_pos(dir, j0 + t);
                    unsigned* dst = reinterpret_cast<unsigned*>(O + rowg * OW1 + head * SSD_P + wq * 16 + fq * 4);
                    dst[0] = pack2(a1[0] + ea * a2[0], a1[1] + ea * a2[1]); dst[1] = pack2(a1[2] + ea * a2[2], a1[3] + ea * a2[3]);
                }
            }
            const float ea = fexp(ac[63]);
            bf16x8 fa0 = *reinterpret_cast<const bf16x8*>(xdtET + (wq * 16 + fr) * LDS_ + fq * 8);
            bf16x8 fa1 = *reinterpret_cast<const bf16x8*>(xdtET + (wq * 16 + fr) * LDS_ + 32 + fq * 8);
#pragma unroll
            for (int n = 0; n < 8; ++n) {
                f32x4 c = hs[n]; c[0] *= ea; c[1] *= ea; c[2] *= ea; c[3] *= ea;
                bf16x8 fb0 = *reinterpret_cast<const bf16x8*>(BT + (n * 16 + fr) * LDS_ + fq * 8);
                bf16x8 fb1 = *reinterpret_cast<const bf16x8*>(BT + (n * 16 + fr) * LDS_ + 32 + fq * 8);
                c = mfma16(fb0, fa0, c);
                hs[n] = mfma16(fb1, fa1, c);
            }
        }
        lds_barrier();
    }
}

__device__ void mlstm_unit(const Params& p, unsigned char* smem, int u) {
    constexpr int NP = ODD_PROJ_PAD, CH = ML_CH, VH = ML_DV / 2, LDD = 136, LDS_ = 72;
    const int dir = u / (BATCH * MLSTM_HEADS * 2), b = (u / (MLSTM_HEADS * 2)) % BATCH, h = (u >> 1) % MLSTM_HEADS, half = u & 1;
    const int tid = opaque_tid(), wid = tid >> 6, lane = tid & 63, fr = lane & 15, fq = lane >> 4;
    const bf16_t* P = reinterpret_cast<const bf16_t*>(p.ws + WS_P);
    const bf16_t* XC = reinterpret_cast<const bf16_t*>(p.ws + WS_AUX1);
    bf16_t* O = reinterpret_cast<bf16_t*>(p.ws + WS_O1) + (size_t)dir * T_ALL * OW1;
    bf16_t* qL = reinterpret_cast<bf16_t*>(smem);
    bf16_t* kL = qL + CH * LDD;
    bf16_t* vL = kL + CH * LDD;
    bf16_t* vT = vL + CH * LDD;
    bf16_t* kET = vT + VH * LDS_;
    bf16_t* Sc = kET + 128 * LDS_;
    float* Fv = reinterpret_cast<float*>(Sc + CH * LDS_);
    float* gv = Fv + 64; float* Mv = gv + 64; float* wint = Mv + 64; float* coef = wint + 64; float* den = coef + 64;
    float* nsv = den + 64;
    float* scal = nsv + 128;
    f32x4 Ct[8];
#pragma unroll
    for (int n = 0; n < 8; ++n) Ct[n] = f32x4{0.f, 0.f, 0.f, 0.f};
    if (tid < 128) nsv[tid] = 0.f;
    if (tid == 0) scal[0] = ML_M_INIT;
    const float ib = p.mlstm_i_bias[dir * MLSTM_HEADS + h], fb_ = p.mlstm_f_bias[dir * MLSTM_HEADS + h];
    const int lt = tid >> 4, lc = (tid & 15) * 8;
    U4 rq[2], rk[2], rv[2]; float rli = 0.f, rfg = 0.f;
    auto issue = [&](int j0) {
#pragma unroll
        for (int i = 0; i < 2; ++i) {
            const size_t rowg = (size_t)b * LSEQ + step_pos(dir, j0 + lt + 32 * i);
            const bf16_t* xr = XC + rowg * XC_W + SSD_CONV_CH + h * ML_DK + lc;
            rq[i] = ld16(xr); rk[i] = ld16(xr + ML_QKW);
            rv[i] = ld16(P + rowg * NP + SSD_PROJ + 2 * ML_QKW + h * ML_DV + half * VH + lc);
        }
        if (wid == 0) {
            const bf16_t* gr = P + ((size_t)b * LSEQ + step_pos(dir, j0 + lane)) * NP + SSD_PROJ + 2 * ML_QKW + 2 * ML_VW;
            rli = bf2f(gr[dir * MLSTM_HEADS + h]); rfg = bf2f(gr[2 * MLSTM_HEADS + dir * MLSTM_HEADS + h]);
        }
    };
    issue(0);
    lds_barrier();
    for (int j0 = 0; j0 < LSEQ; j0 += CH) {
#pragma unroll
        for (int i = 0; i < 2; ++i) {
            const int t = lt + 32 * i;
            st16(qL + t * LDD + lc, rq[i]); st16(kL + t * LDD + lc, scale8(rk[i], 0.08838834764831845f)); st16(vL + t * LDD + lc, rv[i]);
        }
        if (wid == 0) {
            const float li = rli + ib, fx = rfg + fb_;
            const float lf = -softplusf_(-fx);
            const float F = wave_incl_scan_add(lf, lane);
            const float gg = li - F;
            const float pm = wave_incl_scan_max(gg, lane);
            const float mc = scal[0];
            const float M = fmaxf(pm, mc);
            const float F63 = wave_last(F), pm63 = wave_last(pm);
            const float m_end = F63 + pm63, m_new = fmaxf(F63 + mc, m_end);
            Fv[lane] = F; gv[lane] = gg; Mv[lane] = M; wint[lane] = fexp(mc - M);
            coef[lane] = fexp(gg + F63 - m_new);
            if (lane == 0) { scal[1] = fexp(F63 + mc - m_new); scal[2] = m_new; }
        }
        lds_barrier();
        if (j0 + CH < LSEQ) issue(j0 + CH);
#pragma unroll
        for (int i = 0; i < 2; ++i) {
            const int it = tid + 512 * i, sg = it >> 7, d = it & 127;
            U4 kk = gather8(kL + (8 * sg) * LDD + d, LDD);
            const F4 c0 = ldf4(coef + 8 * sg), c1 = ldf4(coef + 8 * sg + 4);
            U4 ke; ke.x = pack2(lo2f(kk.x) * c0.x, hi2f(kk.x) * c0.y); ke.y = pack2(lo2f(kk.y) * c0.z, hi2f(kk.y) * c0.w);
            ke.z = pack2(lo2f(kk.z) * c1.x, hi2f(kk.z) * c1.y); ke.w = pack2(lo2f(kk.w) * c1.z, hi2f(kk.w) * c1.w);
            st16(kET + d * LDS_ + 8 * sg, ke);
            st16(vT + d * LDS_ + 8 * sg, gather8(vL + (8 * sg) * LDD + d, LDD));
        }
#pragma unroll
        for (int q = 0; q < 2; ++q) {
            const int tile = wid * 2 + q, ti = tile >> 2, si = tile & 3;
            f32x4 a = f32x4{0.f, 0.f, 0.f, 0.f};
#pragma unroll
            for (int ks = 0; ks < 4; ++ks) {
                bf16x8 fa = *reinterpret_cast<const bf16x8*>(qL + (ti * 16 + fr) * LDD + ks * 32 + fq * 8);
                bf16x8 fb = *reinterpret_cast<const bf16x8*>(kL + (si * 16 + fr) * LDD + ks * 32 + fq * 8);
                a = mfma16(fb, fa, a);
            }
            const int t = ti * 16 + fr, s0 = si * 16 + fq * 4;
            const float mt = Mv[t]; const F4 g4 = ldf4(gv + s0);
            const float e0 = s0 <= t ? a[0] * fexp(g4.x - mt) : 0.f, e1 = s0 + 1 <= t ? a[1] * fexp(g4.y - mt) : 0.f;
            const float e2 = s0 + 2 <= t ? a[2] * fexp(g4.z - mt) : 0.f, e3 = s0 + 3 <= t ? a[3] * fexp(g4.w - mt) : 0.f;
            unsigned* dst = reinterpret_cast<unsigned*>(Sc + t * LDS_ + s0);
            dst[0] = pack2(e0, e1); dst[1] = pack2(e2, e3);
        }
        lds_barrier();
        {
            const int t = tid >> 3, part = tid & 7;
            const U4 sv = ld16(Sc + t * LDS_ + part * 8);
            float rsum = (lo2f(sv.x) + hi2f(sv.x)) + (lo2f(sv.y) + hi2f(sv.y)) + (lo2f(sv.z) + hi2f(sv.z)) + (lo2f(sv.w) + hi2f(sv.w));
            const U4 q0 = ld16(qL + t * LDD + part * 16), q1 = ld16(qL + t * LDD + part * 16 + 8);
            const F4 n0 = ldf4(nsv + part * 16), n1 = ldf4(nsv + part * 16 + 4), n2 = ldf4(nsv + part * 16 + 8), n3 = ldf4(nsv + part * 16 + 12);
            float qn = lo2f(q0.x) * n0.x + hi2f(q0.x) * n0.y + lo2f(q0.y) * n0.z + hi2f(q0.y) * n0.w + lo2f(q0.z) * n1.x + hi2f(q0.z) * n1.y + lo2f(q0.w) * n1.z + hi2f(q0.w) * n1.w
                     + lo2f(q1.x) * n2.x + hi2f(q1.x) * n2.y + lo2f(q1.y) * n2.z + hi2f(q1.y) * n2.w + lo2f(q1.z) * n3.x + hi2f(q1.z) * n3.y + lo2f(q1.w) * n3.z + hi2f(q1.w) * n3.w;
            const float dsum = sum8(rsum + wint[t] * qn);
            if (part == 0) den[t] = dsum;
        }
        float nsnew;
        {
            const int d = tid >> 2, part = tid & 3;
            const U4 k0 = ld16(kET + d * LDS_ + part * 16), k1 = ld16(kET + d * LDS_ + part * 16 + 8);
            float acc = (lo2f(k0.x) + hi2f(k0.x)) + (lo2f(k0.y) + hi2f(k0.y)) + (lo2f(k0.z) + hi2f(k0.z)) + (lo2f(k0.w) + hi2f(k0.w))
                      + (lo2f(k1.x) + hi2f(k1.x)) + (lo2f(k1.y) + hi2f(k1.y)) + (lo2f(k1.z) + hi2f(k1.z)) + (lo2f(k1.w) + hi2f(k1.w));
            acc += dpp_f<0xB1>(acc); acc += dpp_f<0x4E>(acc);
            nsnew = scal[1] * nsv[d] + acc;
        }
        f32x4 num[4];
#pragma unroll
        for (int ti = 0; ti < 4; ++ti) {
            f32x4 a1 = f32x4{0.f, 0.f, 0.f, 0.f}, a2 = f32x4{0.f, 0.f, 0.f, 0.f};
#pragma unroll
            for (int ks = 0; ks < 2; ++ks) {
                bf16x8 fa = *reinterpret_cast<const bf16x8*>(Sc + (ti * 16 + fr) * LDS_ + ks * 32 + fq * 8);
                bf16x8 fb = *reinterpret_cast<const bf16x8*>(vT + (wid * 16 + fr) * LDS_ + ks * 32 + fq * 8);
                a1 = mfma16(fb, fa, a1);
            }
#pragma unroll
            for (int ks = 0; ks < 4; ++ks) {
                U4 su; su.x = pack2(Ct[2 * ks][0], Ct[2 * ks][1]); su.y = pack2(Ct[2 * ks][2], Ct[2 * ks][3]);
                su.z = pack2(Ct[2 * ks + 1][0], Ct[2 * ks + 1][1]); su.w = pack2(Ct[2 * ks + 1][2], Ct[2 * ks + 1][3]);
                const unsigned long long q0 = *reinterpret_cast<const unsigned long long*>(qL + (ti * 16 + fr) * LDD + ks * 32 + 4 * fq);
                const unsigned long long q1 = *reinterpret_cast<const unsigned long long*>(qL + (ti * 16 + fr) * LDD + ks * 32 + 16 + 4 * fq);
                U4 qu; qu.x = (unsigned)q0; qu.y = (unsigned)(q0 >> 32); qu.z = (unsigned)q1; qu.w = (unsigned)(q1 >> 32);
                a2 = mfma16(__builtin_bit_cast(bf16x8, su), __builtin_bit_cast(bf16x8, qu), a2);
            }
            const float wi = wint[ti * 16 + fr];
#pragma unroll
            for (int j = 0; j < 4; ++j) num[ti][j] = a1[j] + wi * a2[j];
        }
        lds_barrier();
        if ((tid & 3) == 0) nsv[tid >> 2] = nsnew;
        if (tid == 0) scal[0] = scal[2];
        if (step_pos(dir, j0) >= CTX_LEN) {
#pragma unroll
            for (int ti = 0; ti < 4; ++ti) {
                const int t = ti * 16 + fr;
                const size_t rowg = (size_t)b * LSEQ + step_pos(dir, j0 + t);
                const float inv = 1.0f / fmaxf(fabsf(den[t]), fexp(-(Mv[t] + Fv[t])));
                unsigned* dst = reinterpret_cast<unsigned*>(O + rowg * OW1 + SSD_INNER + h * ML_DV + half * VH + wid * 16 + fq * 4);
                dst[0] = pack2(num[ti][0] * inv, num[ti][1] * inv); dst[1] = pack2(num[ti][2] * inv, num[ti][3] * inv);
            }
        }
        {
            const float so = scal[1];
            bf16x8 fa0 = *reinterpret_cast<const bf16x8*>(vT + (wid * 16 + fr) * LDS_ + fq * 8);
            bf16x8 fa1 = *reinterpret_cast<const bf16x8*>(vT + (wid * 16 + fr) * LDS_ + 32 + fq * 8);
#pragma unroll
            for (int n = 0; n < 8; ++n) {
                f32x4 c = Ct[n]; c[0] *= so; c[1] *= so; c[2] *= so; c[3] *= so;
                bf16x8 fb0 = *reinterpret_cast<const bf16x8*>(kET + (n * 16 + fr) * LDS_ + fq * 8);
                bf16x8 fb1 = *reinterpret_cast<const bf16x8*>(kET + (n * 16 + fr) * LDS_ + 32 + fq * 8);
                c = mfma16(fb0, fa0, c);
                Ct[n] = mfma16(fb1, fa1, c);
            }
        }
        lds_barrier();
    }
}

template <int MODE = 0> __device__ void phase_scan1(const Params& p, unsigned char* smem) {
    constexpr int NU_S = 2 * BATCH * SSD_G * (SSD_HG / 2), NU_M = 2 * BATCH * MLSTM_HEADS * 2;
    static_assert(NU_S + NU_M == SCAN1_UNITS, "scan-1 units");
    if ((int)gridDim.x > SCAN1_UNITS && (int)blockIdx.x >= SCAN1_UNITS) convert_expert_weights<1>(p, blockIdx.x - SCAN1_UNITS, gridDim.x - SCAN1_UNITS, smem, 0, CVT_NDN);
    for (int u = blockIdx.x; u < NU_S + NU_M; u += gridDim.x) {
#ifndef PROBE_REPS_C
#define PROBE_REPS_C 1
#define PROBE_REPS_D 1
#endif
        if (u < NU_M) { for (int rep = 0; rep < PROBE_REPS_C; ++rep) mlstm_unit(p, smem, u); } else { for (int rep = 0; rep < PROBE_REPS_D; ++rep) ssd_unit(p, smem, u - NU_M); }
        __syncthreads();
    }
}

template <bool DRY> __device__ void phase_finish1(const Params& p) {
    constexpr int NP = ODD_PROJ_PAD;
    constexpr int NVS = SSD_INNER / 8, NIS = (NVS + 63) / 64, GVS = (SSD_INNER / SSD_G) / 8;
    constexpr int NVM = ML_VW / 8, NIM = (NVM + 63) / 64, GVM = ML_DV / 8;
    static_assert(GVS <= 64 && GVM <= 64 && (NVS % 64 == 0 || NVS < 64) && (NVM % 64 == 0 || NVM < 64), "finish1 layout");
    const int tid = opaque_tid(), lane = tid & 63, wv = (blockIdx.x * NT + tid) >> 6, nwv = gridDim.x * (NT / 64);
    const bf16_t* P = reinterpret_cast<const bf16_t*>(p.ws + WS_P);
    const bf16_t* XC = reinterpret_cast<const bf16_t*>(p.ws + WS_AUX1);
    bf16_t* O0 = reinterpret_cast<bf16_t*>(p.ws + WS_O1);
    const bf16_t* O1 = O0 + (size_t)T_ALL * OW1;
    for (int m = wv; m < T_LAT; m += nwv) {
        const int b = m / SEQ, j = m - b * SEQ;
        const size_t row = (size_t)b * LSEQ + CTX_LEN + j;
        bf16_t* o0 = O0 + row * OW1; const bf16_t* o1 = O1 + row * OW1;
        const bf16_t* pr = P + row * NP; const bf16_t* xr = XC + row * XC_W;
#pragma unroll
        for (int it = 0; it < NIS; ++it) {
            const int vi = lane + 64 * it; const bool act = vi < NVS; const int c = (act ? vi : 0) * 8;
            float x0[8], x1[8], xs[8], zg[8], nw[8], y[8];
            unpack8(ld16(o0 + c), x0); unpack8(ld16(o1 + c), x1); unpack8(ld16(xr + c), xs); unpack8(ld16(pr + c), zg); ldf8(p.ssd_norm_w + c, nw);
            const float dsk = p.ssd_d[c / SSD_P];
            float ss = 0.f;
#pragma unroll
            for (int i = 0; i < 8; ++i) { y[i] = (x0[i] + x1[i] + dsk * xs[i]) * siluf_(zg[i]); ss += y[i] * y[i]; }
            ss = group_sum_v<GVS>(act ? ss : 0.f) * (1.f / (SSD_INNER / SSD_G));
            const float rs = rsqrtf(ss + EPS);
#pragma unroll
            for (int i = 0; i < 8; ++i) y[i] *= rs * nw[i];
            if (act) { if (DRY) { sink(y[0]); sink(y[7]); } else st16(o0 + c, pack8f(y)); }
        }
#pragma unroll
        for (int it = 0; it < NIM; ++it) {
            const int vi = lane + 64 * it; const bool act = vi < NVM; const int c = (act ? vi : 0) * 8;
            float x0[8], x1[8], og[8], nw[8], y[8];
            unpack8(ld16(o0 + SSD_INNER + c), x0); unpack8(ld16(o1 + SSD_INNER + c), x1); unpack8(ld16(pr + SSD_PROJ + 2 * ML_QKW + ML_VW + c), og); ldf8(p.mlstm_norm_w + c, nw);
            float ss = 0.f;
#pragma unroll
            for (int i = 0; i < 8; ++i) { y[i] = x0[i] + x1[i]; ss += y[i] * y[i]; }
            ss = group_sum_v<GVM>(act ? ss : 0.f) * (1.f / ML_DV);
            const float rs = rsqrtf(ss + EPS);
#pragma unroll
            for (int i = 0; i < 8; ++i) y[i] *= rs * nw[i] * sigmoidf_(og[i]);
            if (act) { if (DRY) { sink(y[0]); sink(y[7]); } else st16(o0 + SSD_INNER + c, pack8f(y)); }
        }
    }
}

enum { PH_PRO = 0,
       PH_NORM1_0, PH_INPROJ_0, PH_PREP_0, PH_SCAN_0, PH_FIN_0, PH_OUTPROJ_0, PH_ROUTER_0, PH_SCATTER_0, PH_MOE1_0, PH_MOE2_0, PH_COMBINE_0,
       PH_INPROJ_1, PH_PREP_1, PH_SCAN_1, PH_FIN_1, PH_OUTPROJ_1, PH_ROUTER_1, PH_SCATTER_1, PH_MOE1_1, PH_MOE2_1, PH_COMBINE_1,
       PH_COUNT };

template <int PH, bool DRY = false> __device__ __forceinline__ void run_phase(const Params& p, unsigned char* smem) {
    if (PH == PH_PRO) phase_prologue(p, smem);
    else if (PH == PH_NORM1_0) phase_norm1<0>(p);
    else if (PH == PH_INPROJ_0) phase_inproj<0>(p, smem);
    else if (PH == PH_PREP_0) phase_prep0(p, smem);
#ifndef PROBE_SCAN_MODE
#define PROBE_SCAN_MODE 0
#endif
    else if (PH == PH_SCAN_0) { if (DRY) phase_scan0<PROBE_SCAN_MODE>(p, smem); else phase_scan0<0>(p, smem); }
    else if (PH == PH_FIN_0) phase_finish0<DRY>(p);
    else if (PH == PH_OUTPROJ_0) phase_outproj<0>(p, smem);
    else if (PH == PH_ROUTER_0) phase_router<0, DRY>(p, smem);
    else if (PH == PH_SCATTER_0) phase_scatter<0>(p, smem);
    else if (PH == PH_MOE1_0) phase_moe1<0, DRY>(p, smem);
    else if (PH == PH_MOE2_0) phase_moe2<0, DRY>(p, smem);
    else if (PH == PH_COMBINE_0) phase_combine<0, DRY>(p);
    else if (PH == PH_INPROJ_1) phase_inproj<1>(p, smem);
    else if (PH == PH_PREP_1) phase_prep1(p);
    else if (PH == PH_SCAN_1) { if (DRY) phase_scan1<PROBE_SCAN_MODE>(p, smem); else phase_scan1<0>(p, smem); }
    else if (PH == PH_FIN_1) phase_finish1<DRY>(p);
    else if (PH == PH_OUTPROJ_1) phase_outproj<1>(p, smem);
    else if (PH == PH_ROUTER_1) phase_router<1, DRY>(p, smem);
    else if (PH == PH_SCATTER_1) phase_scatter<1>(p, smem);
    else if (PH == PH_MOE1_1) phase_moe1<1>(p, smem);
    else if (PH == PH_MOE2_1) phase_moe2<1>(p, smem);
    else if (PH == PH_COMBINE_1) phase_combine<1, DRY>(p);
}

template <int PH> __global__ void __launch_bounds__(NT, 2) k_phase(Params p) {
    SMEM_DECL;
    run_phase<PH>(p, smem);
}

constexpr int SMEM_BYTES = 160 * 1024;

#ifdef EMU
struct GridBar { int dummy; };
__device__ __forceinline__ void grid_sync(const GridBar&) { emu_grid_barrier(); }
#else
typedef XcdBarrier GridBar;
__device__ __forceinline__ void grid_sync(const GridBar& b) { xcd_barrier(b); }
#endif
#ifndef PROBE_MASK
#define PROBE_MASK 0u
#endif
#ifndef PROBE_DRY_MASK
#define PROBE_DRY_MASK 0u
#endif
#ifndef PROBE_BAR2
#define PROBE_BAR2 0
#endif
template <int PH> __device__ __forceinline__ void run_from(const Params& p, unsigned char* smem, const GridBar& bar) {
    if constexpr ((PROBE_DRY_MASK >> PH) & 1u) { run_phase<PH, true>(p, smem); grid_sync(bar); }
    run_phase<PH>(p, smem);
    if constexpr ((PROBE_MASK >> PH) & 1u) { grid_sync(bar); run_phase<PH>(p, smem); }
    if constexpr (PH + 1 < PH_COUNT) { grid_sync(bar); if (PROBE_BAR2) grid_sync(bar); run_from<PH + 1>(p, smem, bar); }
}
__global__ void __launch_bounds__(NT, 2) k_mega(Params p) {
    SMEM_DECL;
#ifdef EMU
    GridBar bar{0};
#else
    if (threadIdx.x == 0) *reinterpret_cast<U4*>(smem + SMEM_BYTES - 16) = U4{0u, 0u, 0u, 0u};
    __syncthreads();
    GridBar bar = xcd_barrier_post(reinterpret_cast<unsigned*>(p.ws + WS_BAR), (volatile LAS unsigned*)(smem + SMEM_BYTES - 16));
#endif
    run_from<0>(p, smem, bar);
}

static Params make_params(void* const* d_in, void* d_out, void* d_ws) {
    Params p{};
    const float** f = reinterpret_cast<const float**>(&p);
    for (int i = 0; i < 45; ++i) f[i] = (const float*)d_in[i];
    p.out = (float*)d_out; p.ws = (unsigned char*)d_ws;
    return p;
}

#ifdef EMU
int emu_last_phase = PH_COUNT;
#endif
template <int PH> static void launch_phases(const Params& p, int grid, hipStream_t stream) {
    if constexpr (PH < PH_COUNT) {
#ifdef EMU
        if (PH >= emu_last_phase) return;
#else
        (void)hipFuncSetAttribute((const void*)k_phase<PH>, hipFuncAttributeMaxDynamicSharedMemorySize, SMEM_BYTES);
#endif
        hipLaunchKernelGGL(k_phase<PH>, dim3(grid), dim3(NT), SMEM_BYTES, stream, p);
        launch_phases<PH + 1>(p, grid, stream);
    }
}

#ifndef MK_MULTI
#define MK_MULTI 0
#endif
extern "C" void kernel_launch(void* const* d_in, const int* in_sizes, int n_in, void* d_out, int out_size, void* d_ws, size_t ws_size,
                              hipStream_t stream) {
    Params p = make_params(d_in, d_out, d_ws);
#ifdef EMU
    int grid = getenv("EMU_GRID") ? atoi(getenv("EMU_GRID")) : 4;
    if (emu_last_phase < PH_COUNT) { launch_phases<0>(p, grid, stream); return; }
    hipLaunchKernelGGL(k_mega, dim3(grid), dim3(NT), SMEM_BYTES, stream, p);
#else
    static int grid = 0;
    if (!grid) {
        int dev = 0, cus = 0, per_cu = 0;
        (void)hipGetDevice(&dev);
        (void)hipDeviceGetAttribute(&cus, hipDeviceAttributeMultiprocessorCount, dev);
        (void)hipFuncSetAttribute((const void*)k_mega, hipFuncAttributeMaxDynamicSharedMemorySize, SMEM_BYTES);
        (void)hipOccupancyMaxActiveBlocksPerMultiprocessor(&per_cu, k_mega, NT, SMEM_BYTES);
        grid = (per_cu >= 1) ? cus : 0;
        if (grid > 256) grid = 256;
    }
    if (MK_MULTI || grid == 0) { launch_phases<0>(p, 256, stream); return; }
    (void)hipMemsetAsync((unsigned char*)d_ws + WS_BAR, 0, XCD_BAR_WORDS * sizeof(unsigned), stream);
    hipLaunchKernelGGL(k_mega, dim3(grid), dim3(NT), SMEM_BYTES, stream, p);
#endif
}
```

```cpp
#ifdef EMU
#include "hipemu.h"
#else
#include <hip/hip_runtime.h>
#include <cstdio>
#include <cstdint>
#endif

#ifdef SMALL_CFG
constexpr int D_MODEL = 256, BATCH = 2, SEQ = 256, GRID_W = 16, CTX_LEN = 128;
constexpr int RWKV_HEADS = 2, HGRN_HEADS = 1, SSD_HEADS = 4, MLSTM_HEADS = 1, N_EXPERTS = 8, D_FF = 256;
#else
constexpr int D_MODEL = 1024, BATCH = 8, SEQ = 4096, GRID_W = 64, CTX_LEN = 256;
constexpr int RWKV_HEADS = 8, HGRN_HEADS = 4, SSD_HEADS = 16, MLSTM_HEADS = 4, N_EXPERTS = 32, D_FF = 1024;
#endif
#ifndef PROBE_PREP0
#define PROBE_PREP0 1
#endif
#ifndef PROBE_HG_C
#define PROBE_HG_C 1
#endif
#ifndef PROBE_HG_A
#define PROBE_HG_A 1
#define PROBE_HG_B 1
#endif
#ifndef PROBE_REPS_A
#define PROBE_REPS_A 1
#define PROBE_REPS_B 1
#endif
constexpr int DEPTH = 2, N_MOD = 6;
constexpr float EPS = 1e-6f;
constexpr int GRID_ROWS = SEQ / GRID_W;
constexpr int LSEQ = CTX_LEN + SEQ;
constexpr int T_CTX = BATCH * CTX_LEN, T_LAT = BATCH * SEQ, T_ALL = BATCH * LSEQ;
constexpr int RWKV_N = 64, RWKV_W = RWKV_HEADS * RWKV_N, RWKV_DR = 64, RWKV_AR = 64, RWKV_GR = 128;
constexpr float RWKV_GN_EPS = 64e-5f;
constexpr int RWKV_PROJ = 3 * RWKV_W + 2 * RWKV_DR + 2 * RWKV_AR + RWKV_GR;
constexpr int HG_DK = 128, HG_DV = 128, HG_KW = HGRN_HEADS * HG_DK, HG_VW = HGRN_HEADS * HG_DV, HG_CH = 32;
constexpr int HGRN_PROJ = HG_KW + 2 * HG_KW + 2 * HG_VW;
constexpr int EVEN_PROJ = RWKV_PROJ + HGRN_PROJ, EVEN_OUT = RWKV_W + HG_VW;
constexpr int SSD_P = 64, SSD_INNER = SSD_HEADS * SSD_P, SSD_G = 2, SSD_N = 128, SSD_CH = 64, SSD_HG = SSD_HEADS / SSD_G;
constexpr int SSD_CONV_CH = SSD_INNER + 2 * SSD_G * SSD_N, SSD_PROJ = SSD_INNER + SSD_CONV_CH + 2 * SSD_HEADS;
constexpr int ML_DK = 128, ML_DV = 256, ML_QKW = MLSTM_HEADS * ML_DK, ML_VW = MLSTM_HEADS * ML_DV, ML_CH = 64;
constexpr float ML_M_INIT = -1e30f;
constexpr int MLSTM_PROJ = 2 * ML_QKW + 2 * ML_VW + 4 * MLSTM_HEADS;
constexpr int ODD_PROJ = SSD_PROJ + MLSTM_PROJ, ODD_OUT = SSD_INNER + ML_VW;
constexpr int TOP_K = 4;
constexpr float SWIGLU_LIMIT = 7.0f, SWIGLU_ALPHA = 1.702f;

constexpr int NT = 512;
constexpr int BM = 256, BN = 256;
constexpr int rup(int a, int b) { return (a + b - 1) / b * b; }
constexpr int EVEN_PROJ_PAD = rup(EVEN_PROJ, BN), ODD_PROJ_PAD = rup(ODD_PROJ, BN);
constexpr int PROJ_PAD_MAX = EVEN_PROJ_PAD > ODD_PROJ_PAD ? EVEN_PROJ_PAD : ODD_PROJ_PAD;
constexpr int AUX0_W = 8 * RWKV_W;
constexpr int XC_W = SSD_CONV_CH + 2 * ML_QKW;
constexpr int OW0 = EVEN_OUT, OW1 = ODD_OUT, OW_MAX = OW0 > OW1 ? OW0 : OW1;
constexpr int T_MOE0 = T_ALL, T_MOE1 = T_LAT;
constexpr int MOE_ROWS_MAX = T_MOE0 * TOP_K + N_EXPERTS * BM;
constexpr int MAX_MTILES = MOE_ROWS_MAX / BM;
static_assert(T_ALL % BM == 0 && T_LAT % BM == 0, "row tiles");
static_assert(CTX_LEN % 64 == 0 && SEQ % 64 == 0, "chunk alignment");
static_assert(D_MODEL % BN == 0 && (2 * D_FF) % BN == 0 && D_MODEL % 128 == 0 && D_FF % 128 == 0, "tiles");

typedef unsigned short bf16_t;
#ifndef EMU
typedef short bf16x8 __attribute__((ext_vector_type(8)));
typedef float f32x4 __attribute__((ext_vector_type(4)));
#define mfma16(a, b, c) __builtin_amdgcn_mfma_f32_16x16x32_bf16(a, b, c, 0, 0, 0)
#define SMEM_DECL extern __shared__ __attribute__((aligned(16))) unsigned char smem[]
#else
#define mfma16(a, b, c) emu_mfma_16x16x32_bf16(a, b, c)
#define SMEM_DECL unsigned char* smem = emu_cur->blk->smem
#endif

constexpr size_t al256(size_t x) { return (x + 255) / 256 * 256; }
constexpr size_t WS_BAR = 0;
constexpr size_t WS_CNT = 16384;
constexpr size_t WS_MOD = WS_CNT + 4096;
constexpr size_t WS_LB = al256(WS_MOD + sizeof(float) * 2 * (BATCH + 1) * N_MOD * D_MODEL);
constexpr size_t WS_WIN0 = al256(WS_LB + sizeof(float) * HG_KW);
constexpr size_t WS_WIN1 = al256(WS_WIN0 + 2ull * EVEN_PROJ_PAD * D_MODEL);
constexpr size_t WS_WOUT0 = al256(WS_WIN1 + 2ull * ODD_PROJ_PAD * D_MODEL);
constexpr size_t WS_WOUT1 = al256(WS_WOUT0 + 2ull * D_MODEL * EVEN_OUT);
constexpr size_t WS_XC = al256(WS_WOUT1 + 2ull * D_MODEL * ODD_OUT);
constexpr size_t WS_LRW = al256(WS_XC + 4ull * T_CTX * D_MODEL);
constexpr size_t WS_TOPE = al256(WS_LRW + 2ull * RWKV_W * (2 * RWKV_DR + 2 * RWKV_AR + RWKV_GR));
constexpr size_t WS_TOPP = al256(WS_TOPE + 4ull * T_MOE0 * TOP_K);
constexpr size_t WS_RANK = al256(WS_TOPP + 4ull * T_MOE0 * TOP_K);
constexpr size_t WS_POSOF = al256(WS_RANK + 4ull * T_MOE0 * TOP_K);
constexpr size_t WS_TOKOF = al256(WS_POSOF + 4ull * T_MOE0 * TOP_K);
constexpr size_t WS_H = al256(WS_TOKOF + 4ull * MOE_ROWS_MAX);
constexpr size_t WS_BIG = al256(WS_H + 2ull * T_ALL * D_MODEL);
constexpr size_t WS_P = WS_BIG;
constexpr size_t WS_AUX0 = al256(WS_P + 2ull * T_ALL * EVEN_PROJ_PAD);
constexpr size_t WS_O0 = al256(WS_AUX0 + 2ull * T_ALL * AUX0_W);
constexpr size_t WS_END0 = al256(WS_O0 + 2ull * 2 * T_ALL * OW0);
constexpr size_t WS_AUX1 = al256(WS_P + 2ull * T_ALL * ODD_PROJ_PAD);
constexpr size_t WS_O1 = al256(WS_AUX1 + 2ull * T_ALL * XC_W);
constexpr size_t WS_END1 = al256(WS_O1 + 2ull * 2 * T_ALL * OW1);
constexpr size_t WS_END_MIX = WS_END0 > WS_END1 ? WS_END0 : WS_END1;
constexpr size_t WS_H1 = WS_BIG;
constexpr size_t WS_Y = al256(WS_H1 + 2ull * MOE_ROWS_MAX * D_FF);
constexpr size_t WS_YEND = al256(WS_Y + 2ull * MOE_ROWS_MAX * D_MODEL);
constexpr size_t WS_WGU = WS_END0 > WS_YEND ? WS_END0 : WS_YEND;
constexpr size_t WS_WDN = al256(WS_WGU + 2ull * N_EXPERTS * 2 * D_FF * D_MODEL);
constexpr size_t WS_END_MOE = al256(WS_WDN + 2ull * N_EXPERTS * D_MODEL * D_FF);
constexpr size_t WS_TOTAL = WS_END_MIX > WS_END_MOE ? WS_END_MIX : WS_END_MOE;
#ifndef SMALL_CFG
static_assert(WS_TOTAL <= (1ull << 30), "workspace exceeds 1 GiB");
#endif

struct Params {
    const float *x, *c, *ctx, *c_ctx, *ada_w, *ada_b, *norm1_w, *norm2_w, *even_w_in, *even_w_out, *rwkv_mu, *rwkv_w0,
        *rwkv_w2, *rwkv_a0, *rwkv_a2, *rwkv_g2, *rwkv_k_k, *rwkv_k_a, *rwkv_r_k, *rwkv_ln_w, *rwkv_ln_b,
        *hgrn_lower_bounds, *hgrn_norm_w, *odd_w_in, *odd_w_out, *ssd_conv_w, *ssd_conv_b, *ssd_dt_bias,
        *ssd_a_log, *ssd_d, *ssd_norm_w, *mlstm_conv_w, *mlstm_conv_b, *mlstm_i_bias, *mlstm_f_bias,
        *mlstm_norm_w, *router_w, *router_b, *exp_w_gate, *exp_b_gate, *exp_w_up, *exp_b_up, *exp_w_down,
        *exp_b_down, *final_norm_w;
    float* out;
    unsigned char* ws;
};

#ifdef EMU
__device__ __forceinline__ bf16_t f2bf(float f) {
    unsigned u = __builtin_bit_cast(unsigned, f);
    u += 0x7FFFu + ((u >> 16) & 1u);
    return (bf16_t)(u >> 16);
}
#else
__device__ __forceinline__ bf16_t f2bf(float f) { return __builtin_bit_cast(bf16_t, (__bf16)f); }
#endif
__device__ __forceinline__ float bf2f(bf16_t h) { return __builtin_bit_cast(float, ((unsigned)h) << 16); }
#ifdef EMU
__device__ __forceinline__ unsigned pack2(float a, float b) { return (unsigned)f2bf(a) | ((unsigned)f2bf(b) << 16); }
__device__ __forceinline__ float flog(float x) { return logf(x); }
#else
typedef __bf16 bf16x2_hw __attribute__((ext_vector_type(2)));
typedef float f32x2_hw __attribute__((ext_vector_type(2)));
__device__ __forceinline__ unsigned pack2(float a, float b) {
    return __builtin_bit_cast(unsigned, __builtin_convertvector(f32x2_hw{a, b}, bf16x2_hw));
}
__device__ __forceinline__ float flog(float x) { return __builtin_amdgcn_logf(x) * 0.6931471805599453f; }
#endif
__device__ __forceinline__ float lo2f(unsigned u) { return __builtin_bit_cast(float, u << 16); }
__device__ __forceinline__ float hi2f(unsigned u) { return __builtin_bit_cast(float, u & 0xFFFF0000u); }
#ifdef EMU
__device__ __forceinline__ float fexp(float x) { return expf(x); }
__device__ __forceinline__ float frcp(float x) { return 1.0f / x; }
#else
__device__ __forceinline__ float fexp(float x) { return __builtin_amdgcn_exp2f(x * 1.4426950408889634f); }
__device__ __forceinline__ float frcp(float x) { return __builtin_amdgcn_rcpf(x); }
#endif
__device__ __forceinline__ float sigmoidf_(float x) { return frcp(1.0f + fexp(-x)); }
__device__ __forceinline__ float siluf_(float x) { return x * frcp(1.0f + fexp(-x)); }
__device__ __forceinline__ float softplusf_(float x) { return x > 20.f ? x : log1pf(expf(x)); }
__device__ __forceinline__ float wave_sum(float v) {
#pragma unroll
    for (int m = 32; m >= 1; m >>= 1) v += __shfl_xor(v, m, 64);
    return v;
}
#ifdef EMU
__device__ __forceinline__ void wave_sync() { int z = 0; (void)emu_wave_exchange(&z, 4); }
#else
__device__ __forceinline__ void wave_sync() { __builtin_amdgcn_fence(__ATOMIC_RELEASE, "wavefront"); __builtin_amdgcn_wave_barrier(); __builtin_amdgcn_fence(__ATOMIC_ACQUIRE, "wavefront"); }
#endif
__device__ __forceinline__ int opaque_tid() {
    int t = threadIdx.x;
#ifndef EMU
    asm volatile("" : "+v"(t));
#endif
    return t;
}
template <class T> __device__ __forceinline__ void sink(T v) {
#ifndef EMU
    asm volatile("" :: "v"(v));
#endif
}
__device__ __forceinline__ void lds_barrier() {
#ifdef EMU
    __syncthreads();
#else
    asm volatile("s_waitcnt lgkmcnt(0)" ::: "memory");
    __builtin_amdgcn_s_barrier();
    asm volatile("" ::: "memory");
#endif
}
struct alignas(16) U4 { unsigned x, y, z, w; };
__device__ __forceinline__ U4 ld16(const void* p) { return *reinterpret_cast<const U4*>(p); }
__device__ __forceinline__ void st16(void* p, U4 v) { *reinterpret_cast<U4*>(p) = v; }
struct alignas(16) F4 { float x, y, z, w; };
__device__ __forceinline__ F4 ldf4(const float* p) { return *reinterpret_cast<const F4*>(p); }

__device__ __forceinline__ void unpack8(const U4& u, float (&f)[8]) {
    f[0] = lo2f(u.x); f[1] = hi2f(u.x); f[2] = lo2f(u.y); f[3] = hi2f(u.y); f[4] = lo2f(u.z); f[5] = hi2f(u.z); f[6] = lo2f(u.w); f[7] = hi2f(u.w);
}
__device__ __forceinline__ void ldf8(const float* p, float (&f)[8]) {
    const F4 a = ldf4(p), b = ldf4(p + 4); f[0] = a.x; f[1] = a.y; f[2] = a.z; f[3] = a.w; f[4] = b.x; f[5] = b.y; f[6] = b.z; f[7] = b.w;
}
__device__ __forceinline__ U4 pack8f(const float (&f)[8]) { U4 o; o.x = pack2(f[0], f[1]); o.y = pack2(f[2], f[3]); o.z = pack2(f[4], f[5]); o.w = pack2(f[6], f[7]); return o; }

template <int LAYER> __device__ __forceinline__ int lat_nat(int j) {
    if (LAYER == 0) return j;
    int w = j / GRID_ROWS, r = j - w * GRID_ROWS;
    return r * GRID_W + w;
}
__device__ __forceinline__ int step_pos(int dir, int j) {
    if (dir == 0) return j;
    return j < CTX_LEN ? CTX_LEN - 1 - j : LSEQ + CTX_LEN - 1 - j;
}

#ifndef EMU
#define XB_TMO      128
#define XB_XCNT(j)  (256  + 64 * (j))
#define XB_XSUB(j)  (1280 + 64 * (j))
#define XB_XGEN(j)  (2304 + 64 * (j))
#define XB_TOP      3328
#define XB_TOPGEN   3392
#define XCD_BAR_WORDS 3456
#define XB_SPIN_CAP (1u << 22)
#define LAS __attribute__((address_space(3)))
__device__ __forceinline__ unsigned xb_ld(unsigned* p)              { return __hip_atomic_load(p, __ATOMIC_RELAXED, __HIP_MEMORY_SCOPE_AGENT); }
__device__ __forceinline__ unsigned xb_add(unsigned* p, unsigned v) { return __hip_atomic_fetch_add(p, v, __ATOMIC_RELAXED, __HIP_MEMORY_SCOPE_AGENT); }
__device__ __forceinline__ unsigned xb_xcc_id() { return (unsigned)__builtin_amdgcn_s_getreg((3 << 11) | 20) & 0xFu; }
#define XB_SPIN(cond, bar) do { unsigned _sp = 0; while (cond) { __builtin_amdgcn_s_sleep(1); \
    if ((++_sp & 255u) == 0u) { if (xb_ld(&(bar)[XB_TMO])) break; if (_sp > XB_SPIN_CAP) { atomicAdd(&(bar)[XB_TMO], 1u); break; } } } } while (0)
struct XcdBarrier { unsigned* bar; unsigned x; volatile LAS unsigned* st; };
__device__ __forceinline__ XcdBarrier xcd_barrier_post(unsigned* bar, volatile LAS unsigned* st) {
    XcdBarrier b; b.bar = bar; b.x = xb_xcc_id(); b.st = st;
    if (threadIdx.x == 0) (void)xb_add(&bar[XB_XCNT(b.x)], 1u);
    return b;
}
__device__ __forceinline__ void xcd_barrier_complete(unsigned* bar, unsigned x, unsigned& nloc, unsigned& nx) {
    const unsigned G = gridDim.x * gridDim.y * gridDim.z;
    unsigned sum, cnt, mine, sp = 0u;
    for (;;) {
        sum = 0u; cnt = 0u; mine = 0u;
#pragma unroll
        for (unsigned j = 0; j < 16; ++j) { const unsigned c = xb_ld(&bar[XB_XCNT(j)]); sum += c; cnt += (c > 0u) ? 1u : 0u; mine = (j == x) ? c : mine; }
        if (sum == G) break;
        __builtin_amdgcn_s_sleep(1);
        if ((++sp & 255u) == 0u) { if (xb_ld(&bar[XB_TMO])) break; if (sp > XB_SPIN_CAP) { atomicAdd(&bar[XB_TMO], 1u); break; } }
    }
    nloc = mine > 0u ? mine : 1u; nx = cnt > 0u ? cnt : 1u;
}
__device__ __forceinline__ void xcd_barrier(const XcdBarrier& b) {
    asm volatile("s_waitcnt vmcnt(0)" ::: "memory");
    __syncthreads();
    if (threadIdx.x == 0) {
        unsigned* bar = b.bar;
        __builtin_amdgcn_s_waitcnt(0);
        unsigned nloc = b.st[0], nx = b.st[1];
        if (nloc == 0u) { xcd_barrier_complete(bar, b.x, nloc, nx); b.st[0] = nloc; b.st[1] = nx; }
        const unsigned old = xb_add(&bar[XB_XSUB(b.x)], 1u);
        const unsigned gen = old / nloc;
        if (old + 1u == (gen + 1u) * nloc) {
            __builtin_amdgcn_fence(__ATOMIC_RELEASE, "agent");
            asm volatile("s_waitcnt vmcnt(0)" ::: "memory");
            const unsigned og = xb_add(&bar[XB_TOP], 1u);
            const unsigned tg = og / nx;
            if (og + 1u == (tg + 1u) * nx) xb_add(&bar[XB_TOPGEN], 1u);
            else XB_SPIN(xb_ld(&bar[XB_TOPGEN]) == tg, bar);
            __builtin_amdgcn_fence(__ATOMIC_ACQUIRE, "agent");
            xb_add(&bar[XB_XGEN(b.x)], 1u);
            asm volatile("s_waitcnt vmcnt(0)" ::: "memory");
        } else {
            XB_SPIN(xb_ld(&bar[XB_XGEN(b.x)]) == gen, bar);
            __builtin_amdgcn_fence(__ATOMIC_ACQUIRE, "agent");
            asm volatile("s_waitcnt vmcnt(0)" ::: "memory");
        }
    }
    __syncthreads();
}
#endif

namespace g8 {
#ifdef EMU
#define G8_LAS
__device__ __forceinline__ void glds16(const void* g, unsigned char* l) { memcpy(l + emu_cur->lane * 16, g, 16); }
#define G8_WAIT_V(n) do {} while (0)
#define G8_WAIT_L(n) do {} while (0)
#define G8_BAR __syncthreads()
#define G8_SCHED do {} while (0)
#define G8_PRIO(x) do {} while (0)
#else
#define G8_LAS __attribute__((address_space(3)))
__device__ __forceinline__ void glds16(const void* g, G8_LAS unsigned char* l) { __builtin_amdgcn_global_load_lds((const unsigned*)g, (G8_LAS unsigned*)l, 16, 0, 0); }
#define G8_WAIT_V(n) asm volatile("s_waitcnt vmcnt(" #n ")" ::: "memory")
#define G8_WAIT_L(n) asm volatile("s_waitcnt lgkmcnt(" #n ")" ::: "memory")
#define G8_BAR __builtin_amdgcn_s_barrier()
#define G8_SCHED __builtin_amdgcn_sched_barrier(0)
#define G8_PRIO(x) __builtin_amdgcn_s_setprio(x)
#endif
constexpr int TM = 256, TK = 64, HALF = 128, HTB = HALF * TK * 2, STAGE_BYTES = 8 * HTB, NXCD = 8, WGM = 8;
__device__ __forceinline__ int lds_byte(int r, int c) { const int st = (r >> 4) * 2 + (c >> 5), rr = r & 15, cc = c & 31, ob = rr * 64 + cc * 2; return st * 1024 + (ob ^ (((ob >> 9) & 1) << 5)); }
__device__ __forceinline__ void stage_rc(int b, int& R, int& C) { const int st = b / 1024, sb = b % 1024, swz = sb ^ (((sb >> 9) & 1) << 5); R = (st >> 1) * 16 + swz / 64; C = (st & 1) * 32 + (swz % 64) / 2; }
__device__ __forceinline__ int perm32(int rho) { const int n = rho >> 4, i = rho & 15; return 8 * (i >> 2) + 4 * n + (i & 3); }
__device__ __forceinline__ bool unit_of(int L, int nM, int nN, int& pm, int& pn) {
    const int nwg = nM * nN; if (L >= nwg) return false;
    int wgid = L; { const int q = nwg / NXCD, r = nwg % NXCD, xcd = wgid % NXCD, off = wgid / NXCD; wgid = (xcd < r ? xcd * (q + 1) : r * (q + 1) + (xcd - r) * q) + off; }
    const int nig = WGM * nN, gid = wgid / nig, fm = gid * WGM, gsz = (nM - fm) < WGM ? (nM - fm) : WGM;
    pm = fm + ((wgid % nig) % gsz); pn = (wgid % nig) / gsz; return true;
}

template <class Prob>
__device__ __forceinline__ void gemm_phase(unsigned char* smem, const Prob& pr) {
#ifdef EMU
    unsigned char* lds = smem;
#else
    G8_LAS unsigned char* lds = (G8_LAS unsigned char*)smem;
#endif
    const int tid = opaque_tid(), lane = tid & 63, fr = lane & 15, fq = lane >> 4;
#ifdef EMU
    const int wid = tid >> 6;
#else
    const int wid = __builtin_amdgcn_readfirstlane(tid >> 6);
#endif
    const int wr = wid >> 2, wc = wid & 3;
    constexpr int K = Prob::K, nt = K / TK;
    static_assert(K % 128 == 0 && K >= 256, "K");
    const int nM = pr.nM(), nN = pr.nN(), G = gridDim.x, c = blockIdx.x;
    int Rp[2], Cp[2]; unsigned voffB[2];
#pragma unroll
    for (int i = 0; i < 2; ++i) { int R, C; stage_rc(tid * 16 + i * 8192, R, C); Rp[i] = R; Cp[i] = C; const int Rb = Prob::PERM ? ((R & ~31) + perm32(R & 31)) : R; voffB[i] = (unsigned)(Rb * K + C) * 2u; }
    constexpr size_t kstep = (size_t)(TK * 2), hstepB = (size_t)HALF * K * 2, tstepB = 2 * hstepB;
    const unsigned ldsw = (unsigned)wid * 1024u;
    const int aoff = lds_byte(wr * 64 + fr, fq * 8), boff = lds_byte(wc * 32 + fr, fq * 8);
#define G8_SA(b, h) (((b) * 2 + (h)) * HTB)
#define G8_SB(b, h) ((4 + (b) * 2 + (h)) * HTB)
#define G8_STAGE(bufoff, gbase, voff) do { _Pragma("unroll") for (int _i = 0; _i < 2; ++_i) glds16((const char*)(gbase) + (voff)[_i], lds + (bufoff) + ldsw + _i * 8192); } while (0)
#define G8_LDA(dst, b, h) do { _Pragma("unroll") for (int m = 0; m < 4; ++m) _Pragma("unroll") for (int k = 0; k < 2; ++k) dst[m][k] = *(const G8_LAS bf16x8*)(lds + G8_SA(b, h) + aoff + m * 2048 + k * 1024); } while (0)
#define G8_LDB(dst, b, h) do { _Pragma("unroll") for (int n = 0; n < 2; ++n) _Pragma("unroll") for (int k = 0; k < 2; ++k) dst[n][k] = *(const G8_LAS bf16x8*)(lds + G8_SB(b, h) + boff + n * 2048 + k * 1024); } while (0)
#define G8_MMA(ai, bj, At, Bt) do { G8_PRIO(1); _Pragma("unroll") for (int m = 0; m < 4; ++m) _Pragma("unroll") for (int n = 0; n < 2; ++n) _Pragma("unroll") for (int k = 0; k < 2; ++k) \
        acc[ai][bj][m][n] = mfma16(Bt[n][k], At[m][k], acc[ai][bj][m][n]); G8_PRIO(0); } while (0)
    int pm, pn, npm = 0, npn = 0, ui = 0;
    if (!unit_of(c, nM, nN, pm, pn)) return;
    f32x4 acc[2][2][4][2];
#pragma unroll
    for (int a = 0; a < 2; ++a)
#pragma unroll
        for (int b = 0; b < 2; ++b)
#pragma unroll
            for (int m = 0; m < 4; ++m)
#pragma unroll
                for (int n = 0; n < 2; ++n) acc[a][b][m][n] = f32x4{0.f, 0.f, 0.f, 0.f};
    bf16x8 At[4][2], B0[2][2], B1[2][2];
    const char* const Ab = pr.a_base();
    unsigned ca0[2], ca1[2], na0[2], na1[2];
#pragma unroll
    for (int i = 0; i < 2; ++i) { ca0[i] = pr.a_off(pm, Rp[i]) + (unsigned)Cp[i] * 2u; ca1[i] = pr.a_off(pm, HALF + Rp[i]) + (unsigned)Cp[i] * 2u; na0[i] = ca0[i]; na1[i] = ca1[i]; }
    const char* cB = pr.b_base(pm, pn);
    G8_STAGE(G8_SB(0, 0), cB, voffB); G8_STAGE(G8_SA(0, 0), Ab, ca0); G8_STAGE(G8_SB(0, 1), cB + hstepB, voffB); G8_STAGE(G8_SA(0, 1), Ab, ca1);
    if (wr == 1) G8_BAR;
    G8_WAIT_V(4); G8_BAR;
    G8_STAGE(G8_SB(1, 0), cB + kstep, voffB); G8_STAGE(G8_SA(1, 0), Ab + kstep, ca0); G8_STAGE(G8_SB(1, 1), cB + hstepB + kstep, voffB);
    G8_WAIT_V(6); G8_BAR;
    for (;;) {
        const bool has_next = unit_of((ui + 1) * G + c, nM, nN, npm, npn);
        const char* nB = has_next ? pr.b_base(npm, npn) : cB;
        for (int t = 0; t < nt; t += 2) {
            const bool last = (t == nt - 2);
            if (last) {
                if (has_next) {
#pragma unroll
                    for (int i = 0; i < 2; ++i) { na0[i] = pr.a_off(npm, Rp[i]) + (unsigned)Cp[i] * 2u; na1[i] = pr.a_off(npm, HALF + Rp[i]) + (unsigned)Cp[i] * 2u; }
                } else {
#pragma unroll
                    for (int i = 0; i < 2; ++i) { na0[i] = ca0[i]; na1[i] = ca1[i]; }
                }
            }
            const char* a1 = Ab + (size_t)(t + 1) * kstep;
            const char* a2 = last ? Ab : Ab + (size_t)(t + 2) * kstep; const char* b2 = last ? nB : cB + (size_t)(t + 2) * kstep;
            const char* a3 = a2 + kstep; const char* b3 = b2 + kstep;
            G8_LDB(B0, 0, 0); G8_SCHED; G8_LDA(At, 0, 0); G8_STAGE(G8_SA(1, 1), a1, ca1);
            G8_WAIT_L(8); G8_BAR; G8_WAIT_L(0); G8_MMA(0, 0, At, B0); G8_BAR; G8_SCHED;
            G8_LDB(B1, 0, 1); G8_STAGE(G8_SB(0, 0), b2, voffB);
            G8_BAR; G8_WAIT_L(0); G8_MMA(0, 1, At, B1); G8_BAR;
            G8_LDA(At, 0, 1); if (last) { G8_STAGE(G8_SA(0, 0), a2, na0); } else { G8_STAGE(G8_SA(0, 0), a2, ca0); }
            G8_BAR; G8_WAIT_L(0); G8_MMA(1, 0, At, B0); G8_BAR; G8_SCHED;
            G8_STAGE(G8_SB(0, 1), b2 + hstepB, voffB);
            G8_WAIT_V(6); G8_BAR; G8_MMA(1, 1, At, B1); G8_BAR;
            G8_LDB(B0, 1, 0); G8_SCHED; G8_LDA(At, 1, 0); if (last) { G8_STAGE(G8_SA(0, 1), a2, na1); } else { G8_STAGE(G8_SA(0, 1), a2, ca1); }
            G8_WAIT_L(8); G8_BAR; G8_WAIT_L(0); G8_MMA(0, 0, At, B0); G8_BAR; G8_SCHED;
            G8_LDB(B1, 1, 1); G8_STAGE(G8_SB(1, 0), b3, voffB);
            G8_BAR; G8_WAIT_L(0); G8_MMA(0, 1, At, B1); G8_BAR;
            G8_LDA(At, 1, 1); if (last) { G8_STAGE(G8_SA(1, 0), a3, na0); } else { G8_STAGE(G8_SA(1, 0), a3, ca0); }
            G8_BAR; G8_WAIT_L(0); G8_MMA(1, 0, At, B0); G8_BAR; G8_SCHED;
            G8_STAGE(G8_SB(1, 1), b3 + hstepB, voffB);
            G8_WAIT_V(6); G8_BAR; G8_MMA(1, 1, At, B1); G8_BAR;
        }
        pr.epi(acc, pm, pn, wr, wc, fr, fq);
        if (!has_next) break;
#pragma unroll
        for (int a = 0; a < 2; ++a)
#pragma unroll
            for (int b = 0; b < 2; ++b)
#pragma unroll
                for (int m = 0; m < 4; ++m)
#pragma unroll
                    for (int n = 0; n < 2; ++n) acc[a][b][m][n] = f32x4{0.f, 0.f, 0.f, 0.f};
        pm = npm; pn = npn; cB = nB; ++ui;
#pragma unroll
        for (int i = 0; i < 2; ++i) { ca0[i] = na0[i]; ca1[i] = na1[i]; }
    }
    G8_WAIT_V(0);
    if (wr == 0) G8_BAR;
    G8_BAR;
#undef G8_SA
#undef G8_SB
#undef G8_STAGE
#undef G8_LDA
#undef G8_LDB
#undef G8_MMA
}
}

template <class RowMap>
__device__ __forceinline__ void cvt_tile(const float* src, int N, int K, int k0, int n0, bf16_t* dst, RowMap dst_row, int n_valid) {
    const int tid = opaque_tid(), n = n0 + (tid & 63), kg = tid >> 6;
    float v[8];
#pragma unroll
    for (int j = 0; j < 8; ++j) v[j] = (n < n_valid) ? src[(size_t)(k0 + kg * 8 + j) * N + n] : 0.f;
    U4 o; o.x = pack2(v[0], v[1]); o.y = pack2(v[2], v[3]); o.z = pack2(v[4], v[5]); o.w = pack2(v[6], v[7]);
    st16(dst + (size_t)dst_row(n) * K + k0 + kg * 8, o);
}
__device__ __forceinline__ int gu_row(int col, int is_up) { return (col >> 7) * 256 + is_up * 128 + (col & 127); }

template <class RowMap>
__device__ __forceinline__ void cvt_tile_lds(const float* src, int N, int K, int k0, int n0, bf16_t* dst, RowMap dst_row, unsigned char* smem) {
    constexpr int LD = 68;
    bf16_t* tile = reinterpret_cast<bf16_t*>(smem);
    const int tid = opaque_tid();
    {
        const int kp = tid >> 7, n = tid & 127;
        float a[8], b[8];
#pragma unroll
        for (int i = 0; i < 8; ++i) { const int k = 2 * (kp + 4 * i); a[i] = src[(size_t)(k0 + k) * N + n0 + n]; b[i] = src[(size_t)(k0 + k + 1) * N + n0 + n]; }
#pragma unroll
        for (int i = 0; i < 8; ++i) *reinterpret_cast<unsigned*>(tile + n * LD + 2 * (kp + 4 * i)) = pack2(a[i], b[i]);
    }
    __syncthreads();
    {
        const int n = tid >> 2, kq = tid & 3;
        const unsigned long long* rp = reinterpret_cast<const unsigned long long*>(tile + n * LD + kq * 16);
        const unsigned long long q0 = rp[0], q1 = rp[1], q2 = rp[2], q3 = rp[3];
        U4 o0, o1; o0.x = (unsigned)q0; o0.y = (unsigned)(q0 >> 32); o0.z = (unsigned)q1; o0.w = (unsigned)(q1 >> 32);
        o1.x = (unsigned)q2; o1.y = (unsigned)(q2 >> 32); o1.z = (unsigned)q3; o1.w = (unsigned)(q3 >> 32);
        bf16_t* d = dst + (size_t)dst_row(n0 + n) * K + k0 + kq * 16;
        st16(d, o0); st16(d + 8, o1);
    }
    __syncthreads();
}

constexpr int SCAN1_UNITS = 2 * BATCH * SSD_G * (SSD_HG / 2) + 2 * BATCH * MLSTM_HEADS * 2;
static_assert(WS_WDN >= WS_END1, "WS_WDN must not alias the layer-1 mixer buffers");
constexpr int CVT_T1 = (D_MODEL / 64) * (D_FF / 128);
constexpr int CVT_T2 = (D_FF / 64) * (D_MODEL / 128);
constexpr int CVT_NDN = N_EXPERTS * CVT_T2, CVT_NTOT = CVT_NDN + N_EXPERTS * 2 * CVT_T1;
template <int LAYER> __device__ void convert_expert_weights(const Params& p, int unit_begin, int unit_stride, unsigned char* smem, int v_lo, int v_hi) {
    bf16_t* wgu = reinterpret_cast<bf16_t*>(p.ws + WS_WGU); bf16_t* wdn = reinterpret_cast<bf16_t*>(p.ws + WS_WDN);
    constexpr int T1 = CVT_T1, T2 = CVT_T2;
    for (int v = v_lo + unit_begin; v < v_hi; v += unit_stride) {
        if (v >= CVT_NDN) {
            const int u = v - CVT_NDN, e = u / (2 * T1), r = u - e * (2 * T1);
            const int is_up = r / T1, t = r - is_up * T1, kt = t / (D_FF / 128), nt_ = t - kt * (D_FF / 128);
            const float* src = (is_up ? p.exp_w_up : p.exp_w_gate) + ((size_t)LAYER * N_EXPERTS + e) * D_MODEL * D_FF;
            cvt_tile_lds(src, D_FF, D_MODEL, kt * 64, nt_ * 128, wgu + (size_t)e * 2 * D_FF * D_MODEL,
                         [=](int n) { return gu_row(n, is_up); }, smem);
        } else {
            const int e = v / T2, t = v - e * T2, kt = t / (D_MODEL / 128), nt_ = t - kt * (D_MODEL / 128);
            const float* src = p.exp_w_down + ((size_t)LAYER * N_EXPERTS + e) * D_FF * D_MODEL;
            cvt_tile_lds(src, D_MODEL, D_FF, kt * 64, nt_ * 128, wdn + (size_t)e * D_MODEL * D_FF, [](int n) { return n; }, smem);
        }
    }
}

__device__ void phase_prologue(const Params& p, unsigned char* smem) {
    const int tid = opaque_tid(), bid = blockIdx.x, nb = gridDim.x;
    if (bid == 0) { int* cnt = reinterpret_cast<int*>(p.ws + WS_CNT); if (tid < 2 * N_EXPERTS) cnt[tid] = 0; }
    if (bid == (1 % nb)) {
        float* lb = reinterpret_cast<float*>(p.ws + WS_LB);
        for (int i = tid; i < HG_KW; i += NT) {
            float a0 = p.hgrn_lower_bounds[i], a1 = p.hgrn_lower_bounds[HG_KW + i], a2 = p.hgrn_lower_bounds[2 * HG_KW + i];
            float m = fmaxf(a0, fmaxf(a1, a2));
            float e0 = fexp(a0 - m), e1 = fexp(a1 - m), e2 = fexp(a2 - m);
            lb[i] = e0 / (e0 + e1 + e2);
        }
    }
    {
        float* mod = reinterpret_cast<float*>(p.ws + WS_MOD);
        float* sc = reinterpret_cast<float*>(smem);
        for (int i = tid; i < (BATCH + 1) * D_MODEL; i += NT) {
            int bb = i / D_MODEL, d = i - bb * D_MODEL;
            float v = bb < BATCH ? p.c[bb * D_MODEL + d] : p.c_ctx[d];
            sc[i] = siluf_(v);
        }
        __syncthreads();
        constexpr int NCOL = DEPTH * N_MOD * D_MODEL, KS = D_MODEL / 8;
        float* part = sc + (BATCH + 1) * D_MODEL;
        const int w8 = tid >> 6, ln = tid & 63;
        for (int u = bid; u < NCOL / 64; u += nb) {
            const int col = u * 64 + ln, l = col / (N_MOD * D_MODEL), j = col - l * (N_MOD * D_MODEL);
            const float* w = p.ada_w + (size_t)l * D_MODEL * N_MOD * D_MODEL + j;
            float acc[BATCH + 1];
#pragma unroll
            for (int bb = 0; bb <= BATCH; ++bb) acc[bb] = 0.f;
            constexpr int GB = 32;
            static_assert(KS % GB == 0, "mod GEMV batch");
#pragma unroll 1
            for (int i0 = w8 * KS; i0 < (w8 + 1) * KS; i0 += GB) {
                float wv[GB];
#pragma unroll
                for (int t = 0; t < GB; ++t) wv[t] = w[(size_t)(i0 + t) * (N_MOD * D_MODEL)];
#ifndef EMU
                __builtin_amdgcn_sched_barrier(0);
#endif
#pragma unroll
                for (int t = 0; t < GB; ++t)
#pragma unroll
                    for (int bb = 0; bb <= BATCH; ++bb) acc[bb] += sc[bb * D_MODEL + i0 + t] * wv[t];
            }
#pragma unroll
            for (int bb = 0; bb <= BATCH; ++bb) part[(w8 * (BATCH + 1) + bb) * 64 + ln] = acc[bb];
            __syncthreads();
            for (int o = tid; o < (BATCH + 1) * 64; o += NT) {
                const int bb = o >> 6, c = o & 63, cc = u * 64 + c, ll = cc / (N_MOD * D_MODEL), jj = cc - ll * (N_MOD * D_MODEL);
                float t = p.ada_b[ll * N_MOD * D_MODEL + jj];
#pragma unroll
                for (int q = 0; q < 8; ++q) t += part[(q * (BATCH + 1) + bb) * 64 + c];
                mod[((size_t)ll * (BATCH + 1) + bb) * (N_MOD * D_MODEL) + jj] = t;
            }
            __syncthreads();
        }
        __syncthreads();
    }
    {
        bf16_t* lrw = reinterpret_cast<bf16_t*>(p.ws + WS_LRW);
        constexpr int TOT = RWKV_W * (2 * RWKV_DR + 2 * RWKV_AR + RWKV_GR);
        for (int i = bid * NT + tid; i < TOT; i += nb * NT) {
            int kind, rem;
            if (i < 2 * RWKV_W * RWKV_DR) { kind = i / (RWKV_W * RWKV_DR); rem = i - kind * RWKV_W * RWKV_DR; }
            else if (i < 2 * RWKV_W * RWKV_DR + 2 * RWKV_W * RWKV_AR) { const int q = i - 2 * RWKV_W * RWKV_DR; kind = 2 + q / (RWKV_W * RWKV_AR); rem = q - (kind - 2) * RWKV_W * RWKV_AR; }
            else { kind = 4; rem = i - 2 * RWKV_W * RWKV_DR - 2 * RWKV_W * RWKV_AR; }
            const int rank = kind < 2 ? RWKV_DR : (kind < 4 ? RWKV_AR : RWKV_GR);
            const int c = rem / rank, r = rem - c * rank;
            const float* src = kind < 2 ? p.rwkv_w2 + (size_t)kind * RWKV_DR * RWKV_W : (kind < 4 ? p.rwkv_a2 + (size_t)(kind - 2) * RWKV_AR * RWKV_W : p.rwkv_g2);
            lrw[i] = f2bf(src[(size_t)r * RWKV_W + c]);
        }
    }
    {
        constexpr int KT = D_MODEL / 64;
        constexpr int U0 = KT * (EVEN_PROJ_PAD / 64), U1 = KT * (ODD_PROJ_PAD / 64);
        constexpr int U2 = (EVEN_OUT / 64) * (D_MODEL / 64), U3 = (ODD_OUT / 64) * (D_MODEL / 64);
        for (int u = bid; u < U0 + U1 + U2 + U3; u += nb) {
            if (u < U0) { int kt = u % KT, nt_ = u / KT; cvt_tile(p.even_w_in, EVEN_PROJ, D_MODEL, kt * 64, nt_ * 64, reinterpret_cast<bf16_t*>(p.ws + WS_WIN0), [](int n) { return n; }, EVEN_PROJ); }
            else if (u < U0 + U1) { int v = u - U0; int kt = v % KT, nt_ = v / KT; cvt_tile(p.odd_w_in, ODD_PROJ, D_MODEL, kt * 64, nt_ * 64, reinterpret_cast<bf16_t*>(p.ws + WS_WIN1), [](int n) { return n; }, ODD_PROJ); }
            else if (u < U0 + U1 + U2) { int v = u - U0 - U1; int kt = v % (EVEN_OUT / 64), nt_ = v / (EVEN_OUT / 64); cvt_tile(p.even_w_out, D_MODEL, EVEN_OUT, kt * 64, nt_ * 64, reinterpret_cast<bf16_t*>(p.ws + WS_WOUT0), [](int n) { return n; }, D_MODEL); }
            else { int v = u - U0 - U1 - U2; int kt = v % (ODD_OUT / 64), nt_ = v / (ODD_OUT / 64); cvt_tile(p.odd_w_out, D_MODEL, ODD_OUT, kt * 64, nt_ * 64, reinterpret_cast<bf16_t*>(p.ws + WS_WOUT1), [](int n) { return n; }, D_MODEL); }
        }
    }
}

template <int LAYER> __device__ void phase_norm1(const Params& p) {
    const int tid = opaque_tid(), lane = tid & 63, wv = (blockIdx.x * NT + tid) >> 6, nwv = gridDim.x * (NT / 64);
    const float* mod = reinterpret_cast<const float*>(p.ws + WS_MOD) + (size_t)LAYER * (BATCH + 1) * N_MOD * D_MODEL;
    const float* xc = LAYER == 0 ? p.ctx : reinterpret_cast<const float*>(p.ws + WS_XC);
    const float* xl = LAYER == 0 ? p.x : p.out;
    bf16_t* h = reinterpret_cast<bf16_t*>(p.ws + WS_H);
    const float* g = p.norm1_w + LAYER * D_MODEL;
    constexpr int NV = D_MODEL / 256;
    for (int row = wv; row < T_ALL; row += nwv) {
        const int b = row / LSEQ, s = row - b * LSEQ;
        const float* src; const float* md;
        if (s < CTX_LEN) { src = xc + ((size_t)b * CTX_LEN + s) * D_MODEL; md = mod + (size_t)BATCH * N_MOD * D_MODEL; }
        else { src = xl + ((size_t)b * SEQ + lat_nat<LAYER>(s - CTX_LEN)) * D_MODEL; md = mod + (size_t)b * N_MOD * D_MODEL; }
        F4 v[NV]; float ss = 0.f;
#pragma unroll
        for (int i = 0; i < NV; ++i) { v[i] = ldf4(src + i * 256 + lane * 4); ss += v[i].x * v[i].x + v[i].y * v[i].y + v[i].z * v[i].z + v[i].w * v[i].w; }
        ss = wave_sum(ss);
        const float rs = rsqrtf(ss * (1.0f / D_MODEL) + EPS);
#pragma unroll
        for (int i = 0; i < NV; ++i) {
            const int c = i * 256 + lane * 4;
            F4 gg = ldf4(g + c), m0 = ldf4(md + c), m1 = ldf4(md + D_MODEL + c);
            float o0 = v[i].x * rs * gg.x * (1.f + m1.x) + m0.x, o1 = v[i].y * rs * gg.y * (1.f + m1.y) + m0.y;
            float o2 = v[i].z * rs * gg.z * (1.f + m1.z) + m0.z, o3 = v[i].w * rs * gg.w * (1.f + m1.w) + m0.w;
            unsigned* dst = reinterpret_cast<unsigned*>(h + (size_t)row * D_MODEL + c);
            dst[0] = pack2(o0, o1); dst[1] = pack2(o2, o3);
        }
    }
}

constexpr int PREP_TOK = 64;
constexpr int LR_K[5] = {RWKV_DR, RWKV_DR, RWKV_AR, RWKV_AR, RWKV_GR};
constexpr int LR_OFF[5] = {0, RWKV_DR, 2 * RWKV_DR, 2 * RWKV_DR + RWKV_AR, 2 * RWKV_DR + 2 * RWKV_AR};
constexpr int LR_WOFF[5] = {0, RWKV_W * RWKV_DR, 2 * RWKV_W * RWKV_DR, 2 * RWKV_W * RWKV_DR + RWKV_W * RWKV_AR, 2 * RWKV_W * RWKV_DR + 2 * RWKV_W * RWKV_AR};
__device__ void hgrn_unit(const Params& p, unsigned char* smem, int u);
__device__ void phase_prep0(const Params& p, unsigned char* smem) {
    constexpr int NU_H = 2 * BATCH * HGRN_HEADS;
    const int nb = gridDim.x, bid = blockIdx.x;
    const bool split = nb > NU_H;
    const int hu_first = bid, hu_stride = split ? nb : nb, hu_end = split ? (bid < NU_H ? bid + 1 : 0) : NU_H;
    const int u_first = split ? (bid < NU_H ? (T_ALL / PREP_TOK) : bid - NU_H) : bid, u_stride = split ? nb - NU_H : nb;
#pragma unroll 1
    for (int u = hu_first; u < hu_end; u += hu_stride) { for (int rep = 0; rep < PROBE_REPS_B; ++rep) { hgrn_unit(p, smem, u); __syncthreads(); } }
    constexpr int W = RWKV_W, NP = EVEN_PROJ_PAD, NACT = 2 * RWKV_DR + 2 * RWKV_AR + RWKV_GR;
    constexpr int ALD = NACT + 8;
    constexpr int NG = RWKV_PROJ / 8;
    static_assert(RWKV_PROJ % 8 == 0 && W % 64 == 0, "prep0 layout");
    const bf16_t* P = reinterpret_cast<const bf16_t*>(p.ws + WS_P);
    bf16_t* AUX = reinterpret_cast<bf16_t*>(p.ws + WS_AUX0);
    const bf16_t* LRW = reinterpret_cast<const bf16_t*>(p.ws + WS_LRW);
    bf16_t* act = reinterpret_cast<bf16_t*>(smem);
    const int tid = opaque_tid(), wid = tid >> 6, lane = tid & 63, fr = lane & 15, fq = lane >> 4;
    for (int rep0 = 0; rep0 < PROBE_PREP0; ++rep0)
    for (int u = u_first; u < T_ALL / PREP_TOK; u += u_stride) {
        const int row0 = u * PREP_TOK;
        constexpr int PF = 5, NITEM = PREP_TOK * NG;
        static_assert(NITEM % (NT * PF) == 0 || true, "");
#pragma unroll 1
        for (int base = tid; base < NITEM; base += NT * PF) {
            U4 cu[PF], pv[PF], nx[PF]; F4 m0[PF], m1[PF];
#pragma unroll
            for (int k = 0; k < PF; ++k) {
                const int idx = base + k * NT;
                cu[k] = U4{0u, 0u, 0u, 0u}; pv[k] = cu[k]; nx[k] = cu[k]; m0[k] = F4{0.f, 0.f, 0.f, 0.f}; m1[k] = m0[k];
                if (idx < NITEM) {
                    const int t = idx / NG, col = (idx - t * NG) * 8, row = row0 + t;
                    const int sq = row % LSEQ;
                    const bool has_prev = (sq != 0) && (sq != CTX_LEN), has_next = (sq != CTX_LEN - 1) && (sq != LSEQ - 1);
                    cu[k] = ld16(P + (size_t)row * NP + col);
                    if (has_prev) pv[k] = ld16(P + (size_t)(row - 1) * NP + col);
                    if (has_next) nx[k] = ld16(P + (size_t)(row + 1) * NP + col);
                    m0[k] = ldf4(p.rwkv_mu + col); m1[k] = ldf4(p.rwkv_mu + col + 4);
                }
            }
#pragma unroll
            for (int k = 0; k < PF; ++k) {
                const int idx = base + k * NT;
                if (idx < NITEM) {
                    const int t = idx / NG, col = (idx - t * NG) * 8, row = row0 + t;
                    const unsigned cw[4] = {cu[k].x, cu[k].y, cu[k].z, cu[k].w}, pw[4] = {pv[k].x, pv[k].y, pv[k].z, pv[k].w}, nw[4] = {nx[k].x, nx[k].y, nx[k].z, nx[k].w};
                    const float mu[8] = {m0[k].x, m0[k].y, m0[k].z, m0[k].w, m1[k].x, m1[k].y, m1[k].z, m1[k].w};
                    float mx[8];
#pragma unroll
                    for (int q = 0; q < 4; ++q) {
                        const float c0 = lo2f(cw[q]), c1 = hi2f(cw[q]);
                        mx[2 * q] = c0 + (0.5f * (lo2f(pw[q]) + lo2f(nw[q])) - c0) * mu[2 * q];
                        mx[2 * q + 1] = c1 + (0.5f * (hi2f(pw[q]) + hi2f(nw[q])) - c1) * mu[2 * q + 1];
                    }
                    if (col < 3 * W) {
                        st16(AUX + (size_t)row * AUX0_W + col, pack8f(mx));
                    } else {
                        const int a = col - 3 * W;
#pragma unroll
                        for (int q = 0; q < 8; ++q) {
                            if (a < 2 * RWKV_DR) mx[q] = 2.f * sigmoidf_(2.f * mx[q]) - 1.f;
                            else if (a >= 2 * RWKV_DR + 2 * RWKV_AR) mx[q] = sigmoidf_(mx[q]);
                        }
                        st16(act + t * ALD + a, pack8f(mx));
                    }
                }
            }
        }
        __syncthreads();
#pragma unroll 1
        for (int ct = wid; ct < W / 16; ct += NT / 64) {
#pragma unroll
            for (int kind = 0; kind < 5; ++kind) {
#ifndef EMU
                __builtin_amdgcn_sched_barrier(0);
#endif
                f32x4 acc[4];
#pragma unroll
                for (int m = 0; m < 4; ++m) acc[m] = f32x4{0.f, 0.f, 0.f, 0.f};
#pragma unroll
                for (int ks = 0; ks < LR_K[kind] / 32; ++ks) {
                    const bf16x8 wf = *reinterpret_cast<const bf16x8*>(LRW + LR_WOFF[kind] + (size_t)(ct * 16 + fr) * LR_K[kind] + ks * 32 + fq * 8);
#pragma unroll
                    for (int m = 0; m < 4; ++m) {
                        const bf16x8 af = *reinterpret_cast<const bf16x8*>(act + (m * 16 + fr) * ALD + LR_OFF[kind] + ks * 32 + fq * 8);
                        acc[m] = mfma16(wf, af, acc[m]);
                    }
                }
                const int c0 = ct * 16 + fq * 4;
                float bias[4] = {0.f, 0.f, 0.f, 0.f};
                if (kind < 2) { const F4 b = ldf4(p.rwkv_w0 + kind * W + c0); bias[0] = b.x; bias[1] = b.y; bias[2] = b.z; bias[3] = b.w; }
                else if (kind < 4) { const F4 b = ldf4(p.rwkv_a0 + (kind - 2) * W + c0); bias[0] = b.x; bias[1] = b.y; bias[2] = b.z; bias[3] = b.w; }
#pragma unroll
                for (int m = 0; m < 4; ++m) {
                    float o[4];
#pragma unroll
                    for (int j = 0; j < 4; ++j) {
                        const float v = acc[m][j] + bias[j];
                        if (kind < 2) o[j] = -0.6065306597126334f * sigmoidf_(v);
                        else if (kind < 4) o[j] = sigmoidf_(v);
                        else o[j] = v;
                    }
                    unsigned* dst = reinterpret_cast<unsigned*>(AUX + (size_t)(row0 + m * 16 + fr) * AUX0_W + (3 + kind) * W + c0);
                    dst[0] = pack2(o[0], o[1]); dst[1] = pack2(o[2], o[3]);
                }
            }
        }
        __syncthreads();
    }
    if (split) { if (bid >= NU_H) convert_expert_weights<0>(p, bid - NU_H, nb - NU_H, smem, 0, CVT_NTOT); }
    else convert_expert_weights<0>(p, bid, nb, smem, 0, CVT_NTOT);
}


__device__ __forceinline__ U4 scale8(U4 v, float s) {
    U4 o; o.x = pack2(lo2f(v.x) * s, hi2f(v.x) * s); o.y = pack2(lo2f(v.y) * s, hi2f(v.y) * s);
    o.z = pack2(lo2f(v.z) * s, hi2f(v.z) * s); o.w = pack2(lo2f(v.w) * s, hi2f(v.w) * s); return o;
}
__device__ __forceinline__ U4 gather8(const bf16_t* base, int ld) {
    unsigned v[8];
#pragma unroll
    for (int i = 0; i < 8; ++i) v[i] = base[i * ld];
    U4 o; o.x = v[0] | (v[1] << 16); o.y = v[2] | (v[3] << 16); o.z = v[4] | (v[5] << 16); o.w = v[6] | (v[7] << 16); return o;
}
template <int CTRL> __device__ __forceinline__ float dpp_f(float v) {
#ifdef EMU
    auto r = emu_wave_exchange(&v, 4); const int l = emu_cur->lane; int s;
    if (CTRL == 0xB1) s = l ^ 1; else if (CTRL == 0x4E) s = l ^ 2; else if (CTRL == 0x1B) s = l ^ 3; else if (CTRL == 0x141) s = (l & ~7) | (7 - (l & 7));
    else if (CTRL == 0x128) s = l ^ 8; else s = (l & ~15) | (15 - (l & 15));
    float o; memcpy(&o, r[s], 4); return o;
#else
    return __builtin_bit_cast(float, __builtin_amdgcn_update_dpp(0, __builtin_bit_cast(int, v), CTRL, 0xF, 0xF, true));
#endif
}
__device__ __forceinline__ float sum8(float v) { v += dpp_f<0xB1>(v); v += dpp_f<0x4E>(v); v += dpp_f<0x141>(v); return v; }
__device__ __forceinline__ float sum16(float v) {
    const float q = (v + dpp_f<0xB1>(v)) + (dpp_f<0x4E>(v) + dpp_f<0x1B>(v));
    return (q + dpp_f<0x141>(q)) + (dpp_f<0x140>(q) + dpp_f<0x128>(q));
}

template <int GV> __device__ __forceinline__ float group_sum_v(float v) {
    static_assert(GV == 8 || GV == 16 || GV == 32 || GV == 64, "group size");
    if (GV == 8) return sum8(v);
    v = sum16(v);
    if (GV >= 32) v += __shfl_xor(v, 16, 64);
    if (GV >= 64) v += __shfl_xor(v, 32, 64);
    return v;
}
template <bool DRY> __device__ __forceinline__ void finish0_hgrn_row(const Params& p, int row, int lane) {
    constexpr int W = RWKV_W, NP = EVEN_PROJ_PAD, NVH = HG_VW / 8;
    const bf16_t* P = reinterpret_cast<const bf16_t*>(p.ws + WS_P);
    bf16_t* O0 = reinterpret_cast<bf16_t*>(p.ws + WS_O0);
    const bf16_t* O1 = O0 + (size_t)T_ALL * OW0;
    const bool acth = lane < NVH; const int ch = (acth ? lane : 0) * 8;
    float hw[8]; ldf8(p.hgrn_norm_w + ch, hw);
    bf16_t* o0 = O0 + (size_t)row * OW0; const bf16_t* o1 = O1 + (size_t)row * OW0;
    const U4 h0 = ld16(o0 + W + ch), h1 = ld16(o1 + W + ch), hg = ld16(P + (size_t)row * NP + RWKV_PROJ + 3 * HG_KW + HG_VW + ch);
    float x0[8], x1[8], g[8], o[8];
    unpack8(h0, x0); unpack8(h1, x1); unpack8(hg, g);
    float ss = 0.f;
#pragma unroll
    for (int i = 0; i < 8; ++i) { o[i] = x0[i] + x1[i]; ss += o[i] * o[i]; }
    ss = group_sum_v<HG_DV / 8>(acth ? ss : 0.f) * (1.f / HG_DV);
    const float rs = rsqrtf(ss + EPS);
    float y[8];
#pragma unroll
    for (int i = 0; i < 8; ++i) y[i] = o[i] * rs * hw[i] * siluf_(g[i]);
    if (acth) { if (DRY) { sink(y[0]); sink(y[7]); } else st16(o0 + W + ch, pack8f(y)); }
}
constexpr int RW_NB = LSEQ / 64;
constexpr int RW_NU = 2 * BATCH * RWKV_HEADS * 2;
constexpr int FIN_RPS = (T_ALL + RW_NB * RW_NU * 4 - 1) / (RW_NB * RW_NU * 4);

typedef float f32x2 __attribute__((ext_vector_type(2)));
struct V2x4 { f32x2 v[4]; };
__device__ __forceinline__ V2x4 ldv8(const float* p) {
    const F4 a = *reinterpret_cast<const F4*>(p), b = *reinterpret_cast<const F4*>(p + 4);
    V2x4 r; r.v[0] = f32x2{a.x, a.y}; r.v[1] = f32x2{a.z, a.w}; r.v[2] = f32x2{b.x, b.y}; r.v[3] = f32x2{b.z, b.w}; return r;
}
constexpr int RW_TB = 64;
__device__ void rwkv_unit(const Params& p, unsigned char* smem, int u) {
    constexpr int W = RWKV_W;
    const int half = u & 1, uu = u >> 1;
    const int dir = uu / (BATCH * RWKV_HEADS), b = (uu / RWKV_HEADS) % BATCH, h = uu % RWKV_HEADS;
    const int tid = opaque_tid(), rl = (tid >> 3) & 31, kq = tid & 7;
    const int si = tid >> 3, part = tid & 7;
    const bf16_t* AUX = reinterpret_cast<const bf16_t*>(p.ws + WS_AUX0);
    bf16_t* O = reinterpret_cast<bf16_t*>(p.ws + WS_O0) + (size_t)dir * T_ALL * OW0;
    float* srec = reinterpret_cast<float*>(smem);
    float* sv = srec + RW_TB * 320; float* so = sv + RW_TB * 64;
    float* sdummy = so + RW_TB * 64; const int t2d = tid & 255;
    f32x2 S2[4];
#pragma unroll
    for (int j = 0; j < 4; ++j) S2[j] = f32x2{0.f, 0.f};
    const int ch0 = h * 64 + part * 8;
    float kkg[8], kag[8];
    { const F4 a = ldf4(p.rwkv_k_k + ch0), c = ldf4(p.rwkv_k_k + ch0 + 4), d = ldf4(p.rwkv_k_a + ch0), e = ldf4(p.rwkv_k_a + ch0 + 4);
      kkg[0] = a.x; kkg[1] = a.y; kkg[2] = a.z; kkg[3] = a.w; kkg[4] = c.x; kkg[5] = c.y; kkg[6] = c.z; kkg[7] = c.w;
      kag[0] = d.x; kag[1] = d.y; kag[2] = d.z; kag[3] = d.w; kag[4] = e.x; kag[5] = e.y; kag[6] = e.z; kag[7] = e.w; }
    U4 raw[5];
    {
        const bf16_t* a = AUX + ((size_t)b * LSEQ + step_pos(dir, si)) * AUX0_W + ch0;
        raw[0] = ld16(a); raw[1] = ld16(a + W); raw[2] = ld16(a + 2 * W); raw[3] = ld16(a + (3 + dir) * W); raw[4] = ld16(a + (5 + dir) * W);
    }
    for (int j0 = 0; j0 < LSEQ; j0 += RW_TB) {
        {
            const unsigned rr[4] = {raw[0].x, raw[0].y, raw[0].z, raw[0].w}, kr[4] = {raw[1].x, raw[1].y, raw[1].z, raw[1].w}, vr[4] = {raw[2].x, raw[2].y, raw[2].z, raw[2].w};
            const unsigned wr_[4] = {raw[3].x, raw[3].y, raw[3].z, raw[3].w}, ar[4] = {raw[4].x, raw[4].y, raw[4].z, raw[4].w};
            float r[8], k[8], v[8], lw[8], av[8], kk[8];
            float nrm = 0.f;
#pragma unroll
            for (int q = 0; q < 4; ++q) {
                r[2 * q] = lo2f(rr[q]); r[2 * q + 1] = hi2f(rr[q]); k[2 * q] = lo2f(kr[q]); k[2 * q + 1] = hi2f(kr[q]);
                v[2 * q] = lo2f(vr[q]); v[2 * q + 1] = hi2f(vr[q]); lw[2 * q] = lo2f(wr_[q]); lw[2 * q + 1] = hi2f(wr_[q]);
                av[2 * q] = lo2f(ar[q]); av[2 * q + 1] = hi2f(ar[q]);
            }
#pragma unroll
            for (int j = 0; j < 8; ++j) { kk[j] = k[j] * kkg[j]; nrm += kk[j] * kk[j]; }
            nrm = sum8(nrm);
            const float rn = rsqrtf(nrm + 1e-12f);
            const int o = si * 320 + part * 8, ov = si * 64 + part * 8;
#pragma unroll
            for (int hq = 0; hq < 2; ++hq) {
                F4 t;
                t.x = fexp(lw[4 * hq]); t.y = fexp(lw[4 * hq + 1]); t.z = fexp(lw[4 * hq + 2]); t.w = fexp(lw[4 * hq + 3]);
                *reinterpret_cast<F4*>(srec + o + 4 * hq) = t;
                t.x = k[4 * hq] * (1.f + (av[4 * hq] - 1.f) * kag[4 * hq]); t.y = k[4 * hq + 1] * (1.f + (av[4 * hq + 1] - 1.f) * kag[4 * hq + 1]);
                t.z = k[4 * hq + 2] * (1.f + (av[4 * hq + 2] - 1.f) * kag[4 * hq + 2]); t.w = k[4 * hq + 3] * (1.f + (av[4 * hq + 3] - 1.f) * kag[4 * hq + 3]);
                *reinterpret_cast<F4*>(srec + o + 64 + 4 * hq) = t;
                F4 kn; kn.x = kk[4 * hq] * rn; kn.y = kk[4 * hq + 1] * rn; kn.z = kk[4 * hq + 2] * rn; kn.w = kk[4 * hq + 3] * rn;
                *reinterpret_cast<F4*>(srec + o + 128 + 4 * hq) = kn;
                t.x = kn.x * av[4 * hq]; t.y = kn.y * av[4 * hq + 1]; t.z = kn.z * av[4 * hq + 2]; t.w = kn.w * av[4 * hq + 3];
                *reinterpret_cast<F4*>(srec + o + 192 + 4 * hq) = t;
                t.x = r[4 * hq]; t.y = r[4 * hq + 1]; t.z = r[4 * hq + 2]; t.w = r[4 * hq + 3];
                *reinterpret_cast<F4*>(srec + o + 256 + 4 * hq) = t;
                t.x = v[4 * hq]; t.y = v[4 * hq + 1]; t.z = v[4 * hq + 2]; t.w = v[4 * hq + 3];
                *reinterpret_cast<F4*>(sv + ov + 4 * hq) = t;
            }
        }
        lds_barrier();
        if (j0 + RW_TB < LSEQ) {
            const bf16_t* a = AUX + ((size_t)b * LSEQ + step_pos(dir, j0 + RW_TB + si)) * AUX0_W + ch0;
            raw[0] = ld16(a); raw[1] = ld16(a + W); raw[2] = ld16(a + 2 * W); raw[3] = ld16(a + (3 + dir) * W); raw[4] = ld16(a + (5 + dir) * W);
        }
        if (tid < 256) {
            const int base0 = kq * 8;
            V2x4 kkc = ldv8(srec + base0 + 128), wc = ldv8(srec + base0), bc = ldv8(srec + base0 + 192), kc = ldv8(srec + base0 + 64), rc = ldv8(srec + base0 + 256);
            float v0 = sv[32 * half + rl];
#pragma unroll 2
            for (int i = 0; i < RW_TB; ++i) {
                const int i1 = (i + 1 < RW_TB ? i + 1 : i);
                const float* rn_ = srec + i1 * 320 + base0;
                const V2x4 nkk = ldv8(rn_ + 128), nw = ldv8(rn_), nbb = ldv8(rn_ + 192), nk = ldv8(rn_ + 64), nr = ldv8(rn_ + 256);
                const float nv0 = sv[i1 * 64 + 32 * half + rl];
                f32x2 t = S2[0] * kkc.v[0]; t = S2[1] * kkc.v[1] + t; t = S2[2] * kkc.v[2] + t; t = S2[3] * kkc.v[3] + t;
                const float sa = sum8(t.x + t.y);
                const f32x2 sav = f32x2{sa, sa}, vv = f32x2{v0, v0};
#pragma unroll
                for (int q = 0; q < 4; ++q) { f32x2 u2 = S2[q] * wc.v[q]; u2 = u2 - sav * bc.v[q]; S2[q] = vv * kc.v[q] + u2; }
                f32x2 o2 = S2[0] * rc.v[0]; o2 = S2[1] * rc.v[1] + o2; o2 = S2[2] * rc.v[2] + o2; o2 = S2[3] * rc.v[3] + o2;
                const float o0 = sum8(o2.x + o2.y);
                *((kq == 0) ? (so + i * 32 + rl) : (sdummy + t2d)) = o0;
                kkc = nkk; wc = nw; bc = nbb; kc = nk; rc = nr; v0 = nv0;
            }
        } else {
            const int slot = ((j0 / RW_TB) * RW_NU + u) * 4 + ((tid >> 6) - 4);
#pragma unroll 1
            for (int q = 0; q < FIN_RPS; ++q) { const int row = slot * FIN_RPS + q; if (row < T_ALL) finish0_hgrn_row<false>(p, row, tid & 63); }
        }
        lds_barrier();
        if (part < 4) {
            const size_t rowg = (size_t)b * LSEQ + step_pos(dir, j0 + si);
            const F4 a = *reinterpret_cast<const F4*>(so + si * 32 + part * 8), c = *reinterpret_cast<const F4*>(so + si * 32 + part * 8 + 4);
            U4 o; o.x = pack2(a.x, a.y); o.y = pack2(a.z, a.w); o.z = pack2(c.x, c.y); o.w = pack2(c.z, c.w);
            st16(O + rowg * OW0 + h * 64 + 32 * half + part * 8, o);
        }
    }
    lds_barrier();
}

__device__ void hgrn_unit(const Params& p, unsigned char* smem, int u) {
    constexpr int NP = EVEN_PROJ_PAD, CH = HG_CH, LDK = 136, LDC = 40;
    const int dir = u / (BATCH * HGRN_HEADS), b = (u / HGRN_HEADS) % BATCH, h = u % HGRN_HEADS;
    const int tid = opaque_tid(), wid = tid >> 6, lane = tid & 63, fr = lane & 15, fq = lane >> 4;
    const bf16_t* P = reinterpret_cast<const bf16_t*>(p.ws + WS_P);
    const float* lb = reinterpret_cast<const float*>(p.ws + WS_LB);
    bf16_t* O = reinterpret_cast<bf16_t*>(p.ws + WS_O0) + (size_t)dir * T_ALL * OW0;
    float* lfS = reinterpret_cast<float*>(smem);
    bf16_t* qsS = reinterpret_cast<bf16_t*>(lfS + CH * 128);
    bf16_t* kfS = qsS + CH * LDK;
    bf16_t* vS = kfS + CH * LDK;
    bf16_t* qin = vS + CH * LDK;
    bf16_t* kin = qin + CH * LDK;
    bf16_t* kendT = kin + CH * LDK;
    bf16_t* vT = kendT + 128 * LDC;
    float* eblast = reinterpret_cast<float*>(vT + 128 * LDC);
    f32x4 S[8];
#pragma unroll
    for (int n = 0; n < 8; ++n) S[n] = f32x4{0.f, 0.f, 0.f, 0.f};
    const int lt = tid >> 4, lc = (tid & 15) * 8;
    float lbv[8];
    { const F4 a = ldf4(lb + h * 128 + lc), c = ldf4(lb + h * 128 + lc + 4); lbv[0] = a.x; lbv[1] = a.y; lbv[2] = a.z; lbv[3] = a.w; lbv[4] = c.x; lbv[5] = c.y; lbv[6] = c.z; lbv[7] = c.w; }
    struct Regs { U4 rq, rf, rv; };
    Regs setA, setB;
    auto issue = [&](Regs& r, int j0) {
        const bf16_t* pr = P + ((size_t)b * LSEQ + step_pos(dir, j0 + lt)) * NP + RWKV_PROJ + h * 128 + lc;
        r.rq = ld16(pr); r.rf = ld16(pr + HG_KW + dir * HG_KW); r.rv = ld16(pr + 3 * HG_KW);
    };
    issue(setA, 0); issue(setB, CH);
    const int g = tid >> 7, d = tid & 127;
    static_assert((LSEQ / HG_CH) % 2 == 0, "even chunk count");
    auto chunk = [&](Regs& r, int j0) {
        const U4 rq = r.rq, rf = r.rf, rv = r.rv;
        for (int repA = 0; repA < PROBE_HG_A; ++repA) {
            #ifndef EMU
            if (PROBE_HG_A > 1) { asm volatile("" ::: "memory"); }
#endif
            const unsigned qw[4] = {rq.x, rq.y, rq.z, rq.w}, fw[4] = {rf.x, rf.y, rf.z, rf.w};
            float lf[8], kf[8], qs[8];
#pragma unroll
            for (int q = 0; q < 4; ++q) {
#pragma unroll
                for (int e = 0; e < 2; ++e) {
                    const int i = 2 * q + e;
                    const float fv = e ? hi2f(fw[q]) : lo2f(fw[q]), qv = e ? hi2f(qw[q]) : lo2f(qw[q]);
                    const float sg = sigmoidf_(fv);
                    lf[i] = flog(lbv[i] + (1.f - lbv[i]) * sg); kf[i] = (1.f - lbv[i]) * (1.f - sg);
                    qs[i] = siluf_(qv) * 0.08838834764831845f;
                }
            }
            F4 t0, t1; t0.x = lf[0]; t0.y = lf[1]; t0.z = lf[2]; t0.w = lf[3]; t1.x = lf[4]; t1.y = lf[5]; t1.z = lf[6]; t1.w = lf[7];
            *reinterpret_cast<F4*>(lfS + lt * 128 + lc) = t0; *reinterpret_cast<F4*>(lfS + lt * 128 + lc + 4) = t1;
            U4 o; o.x = pack2(qs[0], qs[1]); o.y = pack2(qs[2], qs[3]); o.z = pack2(qs[4], qs[5]); o.w = pack2(qs[6], qs[7]);
            st16(qsS + lt * LDK + lc, o);
            o.x = pack2(kf[0], kf[1]); o.y = pack2(kf[2], kf[3]); o.z = pack2(kf[4], kf[5]); o.w = pack2(kf[6], kf[7]);
            st16(kfS + lt * LDK + lc, o);
            st16(vS + lt * LDK + lc, rv);
        }
        lds_barrier();
        if (j0 + 2 * CH < LSEQ) issue(r, j0 + 2 * CH);
        for (int repB = 0; repB < PROBE_HG_B; ++repB) {
            float off = 0.f, bl = 0.f, cs[8];
#pragma unroll
            for (int t = 0; t < CH; ++t) {
                const float v = lfS[t * 128 + d];
                if (t < 8 * g) off += v;
                bl += v;
            }
            float run = off;
#pragma unroll
            for (int tt = 0; tt < 8; ++tt) { run += lfS[(8 * g + tt) * 128 + d]; cs[tt] = run; }
            const U4 kf8 = gather8(kfS + (8 * g) * LDK + d, LDK), qs8 = gather8(qsS + (8 * g) * LDK + d, LDK), v8 = gather8(vS + (8 * g) * LDK + d, LDK);
            const unsigned kw[4] = {kf8.x, kf8.y, kf8.z, kf8.w}, qw[4] = {qs8.x, qs8.y, qs8.z, qs8.w};
            float ke[8];
#pragma unroll
            for (int tt = 0; tt < 8; ++tt) {
                const float kfv = (tt & 1) ? hi2f(kw[tt >> 1]) : lo2f(kw[tt >> 1]), qsv = (tt & 1) ? hi2f(qw[tt >> 1]) : lo2f(qw[tt >> 1]);
                qin[(8 * g + tt) * LDK + d] = f2bf(qsv * fexp(cs[tt]));
                kin[(8 * g + tt) * LDK + d] = f2bf(kfv * fexp(-cs[tt]));
                ke[tt] = kfv * fexp(bl - cs[tt]);
            }
            U4 o; o.x = pack2(ke[0], ke[1]); o.y = pack2(ke[2], ke[3]); o.z = pack2(ke[4], ke[5]); o.w = pack2(ke[6], ke[7]);
            st16(kendT + d * LDC + 8 * g, o);
            st16(vT + d * LDC + 8 * g, v8);
            if (g == 0) eblast[d] = fexp(bl);
        }
        lds_barrier();
        bf16x8 fk0[4], fk1[4];
#pragma unroll
        for (int ks = 0; ks < 4; ++ks) {
            fk0[ks] = *reinterpret_cast<const bf16x8*>(kin + (fr) * LDK + ks * 32 + fq * 8);
            fk1[ks] = *reinterpret_cast<const bf16x8*>(kin + (16 + fr) * LDK + ks * 32 + fq * 8);
        }
        for (int repC = 0; repC < PROBE_HG_C; ++repC)
#pragma unroll
        for (int ti = 0; ti < 2; ++ti) {
#ifndef EMU
            if (PROBE_HG_C > 1) { asm volatile("" ::: "memory"); }
#endif
            f32x4 a0 = f32x4{0.f, 0.f, 0.f, 0.f}, a1 = f32x4{0.f, 0.f, 0.f, 0.f};
#pragma unroll
            for (int ks = 0; ks < 4; ++ks) {
                const bf16x8 fq_ = *reinterpret_cast<const bf16x8*>(qin + (ti * 16 + fr) * LDK + ks * 32 + fq * 8);
                a0 = mfma16(fk0[ks], fq_, a0);
                a1 = mfma16(fk1[ks], fq_, a1);
            }
            const int t = ti * 16 + fr, s0 = fq * 4;
            U4 au;
            au.x = pack2(s0 <= t ? a0[0] : 0.f, s0 + 1 <= t ? a0[1] : 0.f); au.y = pack2(s0 + 2 <= t ? a0[2] : 0.f, s0 + 3 <= t ? a0[3] : 0.f);
            au.z = pack2(s0 + 16 <= t ? a1[0] : 0.f, s0 + 17 <= t ? a1[1] : 0.f); au.w = pack2(s0 + 18 <= t ? a1[2] : 0.f, s0 + 19 <= t ? a1[3] : 0.f);
            const bf16x8 af = __builtin_bit_cast(bf16x8, au);
            const unsigned long long v0 = *reinterpret_cast<const unsigned long long*>(vT + (wid * 16 + fr) * LDC + 4 * fq);
            const unsigned long long v1 = *reinterpret_cast<const unsigned long long*>(vT + (wid * 16 + fr) * LDC + 16 + 4 * fq);
            U4 vu; vu.x = (unsigned)v0; vu.y = (unsigned)(v0 >> 32); vu.z = (unsigned)v1; vu.w = (unsigned)(v1 >> 32);
            f32x4 oa = f32x4{0.f, 0.f, 0.f, 0.f};
            oa = mfma16(__builtin_bit_cast(bf16x8, vu), af, oa);
#pragma unroll
            for (int ks = 0; ks < 4; ++ks) {
                U4 su; su.x = pack2(S[2 * ks][0], S[2 * ks][1]); su.y = pack2(S[2 * ks][2], S[2 * ks][3]);
                su.z = pack2(S[2 * ks + 1][0], S[2 * ks + 1][1]); su.w = pack2(S[2 * ks + 1][2], S[2 * ks + 1][3]);
                const unsigned long long q0 = *reinterpret_cast<const unsigned long long*>(qin + (ti * 16 + fr) * LDK + ks * 32 + 4 * fq);
                const unsigned long long q1 = *reinterpret_cast<const unsigned long long*>(qin + (ti * 16 + fr) * LDK + ks * 32 + 16 + 4 * fq);
                U4 qu; qu.x = (unsigned)q0; qu.y = (unsigned)(q0 >> 32); qu.z = (unsigned)q1; qu.w = (unsigned)(q1 >> 32);
                oa = mfma16(__builtin_bit_cast(bf16x8, su), __builtin_bit_cast(bf16x8, qu), oa);
            }
            const size_t rowg = (size_t)b * LSEQ + step_pos(dir, j0 + t);
            unsigned* dst = reinterpret_cast<unsigned*>(O + rowg * OW0 + RWKV_W + h * 128 + wid * 16 + fq * 4);
            dst[0] = pack2(oa[0], oa[1]); dst[1] = pack2(oa[2], oa[3]);
        }
        {
            bf16x8 fv = *reinterpret_cast<const bf16x8*>(vT + (wid * 16 + fr) * LDC + fq * 8);
#pragma unroll
            for (int n = 0; n < 8; ++n) {
                const F4 e = ldf4(eblast + n * 16 + fq * 4);
                f32x4 c = S[n]; c[0] *= e.x; c[1] *= e.y; c[2] *= e.z; c[3] *= e.w;
                bf16x8 fk = *reinterpret_cast<const bf16x8*>(kendT + (n * 16 + fr) * LDC + fq * 8);
                S[n] = mfma16(fk, fv, c);
            }
        }
        lds_barrier();
    };
#pragma unroll 1
    for (int j0 = 0; j0 < LSEQ; j0 += 2 * CH) { chunk(setA, j0); chunk(setB, j0 + CH); }
}

template <int MODE = 0> __device__ void phase_scan0(const Params& p, unsigned char* smem) {
    constexpr int NU_R = 2 * BATCH * RWKV_HEADS * 2;
    for (int u = blockIdx.x; u < NU_R; u += gridDim.x) { for (int rep = 0; rep < PROBE_REPS_A; ++rep) { rwkv_unit(p, smem, u); __syncthreads(); } }
}

template <bool DRY> __device__ void phase_finish0(const Params& p) {
    constexpr int W = RWKV_W, NP = EVEN_PROJ_PAD;
    constexpr int NVR = W / 8, NVH = HG_VW / 8;
    static_assert(NVR <= 64 && NVH <= 64, "finish0 layout");
    const int tid = opaque_tid(), lane = tid & 63, wv = (blockIdx.x * NT + tid) >> 6, nwv = gridDim.x * (NT / 64);
    const bf16_t* P = reinterpret_cast<const bf16_t*>(p.ws + WS_P);
    const bf16_t* AUX = reinterpret_cast<const bf16_t*>(p.ws + WS_AUX0);
    bf16_t* O0 = reinterpret_cast<bf16_t*>(p.ws + WS_O0);
    const bf16_t* O1 = O0 + (size_t)T_ALL * OW0;
    const bool actr = lane < NVR, acth = lane < NVH;
    const int c = (actr ? lane : 0) * 8, ch = (acth ? lane : 0) * 8;
    float ka[8], rk[8], lw[8], lbv[8], hw[8];
    ldf8(p.rwkv_k_a + c, ka); ldf8(p.rwkv_r_k + c, rk); ldf8(p.rwkv_ln_w + c, lw); ldf8(p.rwkv_ln_b + c, lbv);
    for (int row = wv; row < T_ALL; row += nwv) {
        bf16_t* o0 = O0 + (size_t)row * OW0; const bf16_t* o1 = O1 + (size_t)row * OW0;
        const bf16_t* a = AUX + (size_t)row * AUX0_W;
        const U4 u0 = ld16(o0 + c), u1 = ld16(o1 + c), ur = ld16(a + c), uk = ld16(a + W + c), uv = ld16(a + 2 * W + c);
        const U4 ua0 = ld16(a + 5 * W + c), ua1 = ld16(a + 6 * W + c), ug = ld16(a + 7 * W + c);
        {
            float x0[8], x1[8], r[8], k[8], v[8], a0[8], a1[8], g[8], o[8];
            unpack8(u0, x0); unpack8(u1, x1); unpack8(ur, r); unpack8(uk, k); unpack8(uv, v); unpack8(ua0, a0); unpack8(ua1, a1); unpack8(ug, g);
            float sum = 0.f, bon = 0.f;
#pragma unroll
            for (int i = 0; i < 8; ++i) {
                o[i] = x0[i] + x1[i]; sum += o[i];
                const float km = k[i] * (1.f + (a0[i] - 1.f) * ka[i]) + k[i] * (1.f + (a1[i] - 1.f) * ka[i]);
                bon += r[i] * km * rk[i];
            }
            if (!actr) { sum = 0.f; bon = 0.f; }
            const float mu = sum8(sum) * (1.f / 64.f);
            bon = sum8(bon);
            float var = 0.f;
#pragma unroll
            for (int i = 0; i < 8; ++i) { const float dd = o[i] - mu; var += dd * dd; }
            var = sum8(actr ? var : 0.f) * (1.f / 64.f);
            const float rs = rsqrtf(var + RWKV_GN_EPS);
            float y[8];
#pragma unroll
            for (int i = 0; i < 8; ++i) y[i] = ((o[i] - mu) * rs * lw[i] + lbv[i] + bon * v[i]) * g[i];
            if (actr) { if (DRY) { sink(y[0]); sink(y[7]); } else st16(o0 + c, pack8f(y)); }
        }
    }
}

__device__ __forceinline__ U4 pack8(const f32x4& a, const f32x4& b) { U4 o; o.x = pack2(a[0], a[1]); o.y = pack2(a[2], a[3]); o.z = pack2(b[0], b[1]); o.w = pack2(b[2], b[3]); return o; }

template <int LAYER> struct ProbInproj {
    static constexpr int K = D_MODEL; static constexpr bool PERM = true;
    static constexpr int NP = LAYER == 0 ? EVEN_PROJ_PAD : ODD_PROJ_PAD;
    const char* A; const char* Bt; bf16_t* P;
    __device__ __forceinline__ int nM() const { return T_ALL / 256; }
    __device__ __forceinline__ int nN() const { return NP / 256; }
    __device__ __forceinline__ const char* a_base() const { return A; }
    __device__ __forceinline__ unsigned a_off(int pm, int r) const { return (unsigned)(pm * 256 + r) * (unsigned)(K * 2); }
    __device__ __forceinline__ const char* b_base(int, int pn) const { return Bt + (size_t)pn * 256 * K * 2; }
    __device__ __forceinline__ void epi(const f32x4 (&acc)[2][2][4][2], int pm, int pn, int wr, int wc, int fr, int fq) const {
#pragma unroll
        for (int ai = 0; ai < 2; ++ai)
#pragma unroll
            for (int m = 0; m < 4; ++m) {
                bf16_t* rowp = P + (size_t)(pm * 256 + ai * 128 + wr * 64 + m * 16 + fr) * NP + pn * 256 + wc * 32 + fq * 8;
#pragma unroll
                for (int bj = 0; bj < 2; ++bj) st16(rowp + bj * 128, pack8(acc[ai][bj][m][0], acc[ai][bj][m][1]));
            }
    }
};
template <int LAYER> __device__ void phase_inproj(const Params& p, unsigned char* smem) {
    ProbInproj<LAYER> pr;
    pr.A = reinterpret_cast<const char*>(p.ws + WS_H); pr.Bt = reinterpret_cast<const char*>(p.ws + (LAYER == 0 ? WS_WIN0 : WS_WIN1));
    pr.P = reinterpret_cast<bf16_t*>(p.ws + WS_P);
    g8::gemm_phase(smem, pr);
}

template <int LAYER> struct ProbOutproj {
    static constexpr int K = LAYER == 0 ? EVEN_OUT : ODD_OUT; static constexpr bool PERM = false;
    static constexpr int OWL = LAYER == 0 ? OW0 : OW1, MROWS = LAYER == 0 ? T_ALL : T_LAT;
    const char* A; const char* Bt; const float* mod; const float* x_in; const float* ctx_in; float* xl; float* xc;
    __device__ __forceinline__ int nM() const { return MROWS / 256; }
    __device__ __forceinline__ int nN() const { return D_MODEL / 256; }
    __device__ __forceinline__ const char* a_base() const { return A; }
    __device__ __forceinline__ unsigned a_off(int pm, int r) const {
        const int m = pm * 256 + r;
        if (LAYER == 0) return (unsigned)m * (unsigned)(OWL * 2);
        const int b = m / SEQ, j = m - b * SEQ; return (unsigned)(b * LSEQ + CTX_LEN + j) * (unsigned)(OWL * 2);
    }
    __device__ __forceinline__ const char* b_base(int, int pn) const { return Bt + (size_t)pn * 256 * K * 2; }
    __device__ __forceinline__ void epi(const f32x4 (&acc)[2][2][4][2], int pm, int pn, int wr, int wc, int fr, int fq) const {
#pragma unroll
        for (int ai = 0; ai < 2; ++ai)
#pragma unroll
            for (int m = 0; m < 4; ++m) {
                const int row = pm * 256 + ai * 128 + wr * 64 + m * 16 + fr;
                const float* src; float* dst; const float* md;
                if (LAYER == 0) {
                    const int b = row / LSEQ, s = row - b * LSEQ;
                    if (s < CTX_LEN) { const size_t o = ((size_t)b * CTX_LEN + s) * D_MODEL; src = ctx_in + o; dst = xc + o; md = mod + ((size_t)BATCH * N_MOD + 2) * D_MODEL; }
                    else { const size_t o = ((size_t)b * SEQ + (s - CTX_LEN)) * D_MODEL; src = x_in + o; dst = xl + o; md = mod + ((size_t)b * N_MOD + 2) * D_MODEL; }
                } else {
                    const int b = row / SEQ, jj = row - b * SEQ;
                    const size_t o = ((size_t)b * SEQ + lat_nat<1>(jj)) * D_MODEL; src = xl + o; dst = xl + o; md = mod + ((size_t)b * N_MOD + 2) * D_MODEL;
                }
#pragma unroll
                for (int bj = 0; bj < 2; ++bj)
#pragma unroll
                    for (int n = 0; n < 2; ++n) {
                        const int col = pn * 256 + bj * 128 + wc * 32 + n * 16 + fq * 4;
                        const F4 sv = ldf4(src + col), mv = ldf4(md + col);
                        F4 o; o.x = sv.x + mv.x * acc[ai][bj][m][n][0]; o.y = sv.y + mv.y * acc[ai][bj][m][n][1];
                        o.z = sv.z + mv.z * acc[ai][bj][m][n][2]; o.w = sv.w + mv.w * acc[ai][bj][m][n][3];
                        *reinterpret_cast<F4*>(dst + col) = o;
                    }
            }
    }
};
template <int LAYER> __device__ void phase_outproj(const Params& p, unsigned char* smem) {
    ProbOutproj<LAYER> pr;
    pr.A = reinterpret_cast<const char*>(p.ws + (LAYER == 0 ? WS_O0 : WS_O1)); pr.Bt = reinterpret_cast<const char*>(p.ws + (LAYER == 0 ? WS_WOUT0 : WS_WOUT1));
    pr.mod = reinterpret_cast<const float*>(p.ws + WS_MOD) + (size_t)LAYER * (BATCH + 1) * N_MOD * D_MODEL;
    pr.x_in = p.x; pr.ctx_in = p.ctx; pr.xl = p.out; pr.xc = reinterpret_cast<float*>(p.ws + WS_XC);
    g8::gemm_phase(smem, pr);
}

template <int CTRL> __device__ __forceinline__ int dpp_i(int v) {
#ifdef EMU
    auto r = emu_wave_exchange(&v, 4); const int l = emu_cur->lane; int s;
    if (CTRL == 0xB1) s = l ^ 1; else if (CTRL == 0x4E) s = l ^ 2; else if (CTRL == 0x141) s = (l & ~7) | (7 - (l & 7)); else s = (l & ~15) | (15 - (l & 15));
    int o; memcpy(&o, r[s], 4); return o;
#else
    return __builtin_amdgcn_update_dpp(0, v, CTRL, 0xF, 0xF, true);
#endif
}
template <int LAYER, bool DRY> __device__ void phase_router(const Params& p, unsigned char* smem) {
    constexpr int TM = LAYER == 0 ? T_MOE0 : T_MOE1;
    constexpr int EPL = 4, LPG = N_EXPERTS / EPL, NG = 64 / LPG, DG = D_MODEL / NG;
    constexpr int TB4 = 4;
    constexpr int ROWF = D_MODEL + NG * 4;
    static_assert(N_EXPERTS % EPL == 0 && LPG <= 8 && 64 % LPG == 0 && D_MODEL % NG == 0, "router layout");
    const int tid = opaque_tid(), lane = tid & 63, wl = tid >> 6, wv = (blockIdx.x * NT + tid) >> 6, nwv = gridDim.x * (NT / 64);
    const float* mod = reinterpret_cast<const float*>(p.ws + WS_MOD) + (size_t)LAYER * (BATCH + 1) * N_MOD * D_MODEL;
    const float* xcw = reinterpret_cast<const float*>(p.ws + WS_XC);
    bf16_t* h2 = reinterpret_cast<bf16_t*>(p.ws + WS_H);
    int* tope = reinterpret_cast<int*>(p.ws + WS_TOPE); float* topp = reinterpret_cast<float*>(p.ws + WS_TOPP);
    int* rank = reinterpret_cast<int*>(p.ws + WS_RANK); int* cnt = reinterpret_cast<int*>(p.ws + WS_CNT) + LAYER * N_EXPERTS;
    float* hrow = reinterpret_cast<float*>(smem) + wl * (TB4 * ROWF);
    constexpr int RT_MAXTOK = 1024;
    int* lcount = reinterpret_cast<int*>(smem + 8 * TB4 * ROWF * sizeof(float));
    int* lbase = lcount + N_EXPERTS;
    short* lrec = reinterpret_cast<short*>(lbase + N_EXPERTS);
    if (tid < N_EXPERTS) lcount[tid] = 0;
    __syncthreads();
    const float* g = p.norm2_w + LAYER * D_MODEL;
    const float* rw = p.router_w + (size_t)LAYER * D_MODEL * N_EXPERTS;
    constexpr int NV = D_MODEL / 256;
    const int eg = lane % LPG, dg = lane / LPG;
    const F4 rb = ldf4(p.router_b + LAYER * N_EXPERTS + eg * EPL);
    int itg = 0;
    for (int tok0 = wv; tok0 < TM; tok0 += TB4 * nwv, ++itg) {
#pragma unroll
        for (int q = 0; q < TB4; ++q) {
            const int tok = tok0 + q * nwv;
            if (tok < TM) {
                const float* src; const float* md;
                if (LAYER == 0 && tok < T_CTX) { src = xcw + (size_t)tok * D_MODEL; md = mod + (size_t)BATCH * N_MOD * D_MODEL; }
                else { const int n = LAYER == 0 ? tok - T_CTX : tok; src = p.out + (size_t)n * D_MODEL; md = mod + (size_t)(n / SEQ) * N_MOD * D_MODEL; }
                F4 v[NV]; float ss = 0.f;
#pragma unroll
                for (int i = 0; i < NV; ++i) { v[i] = ldf4(src + i * 256 + lane * 4); ss += v[i].x * v[i].x + v[i].y * v[i].y + v[i].z * v[i].z + v[i].w * v[i].w; }
                ss = wave_sum(ss);
                const float rs = rsqrtf(ss * (1.0f / D_MODEL) + EPS);
#pragma unroll
                for (int i = 0; i < NV; ++i) {
                    const int c = i * 256 + lane * 4;
                    F4 gg = ldf4(g + c), m3 = ldf4(md + 3 * D_MODEL + c), m4 = ldf4(md + 4 * D_MODEL + c);
                    F4 o; o.x = v[i].x * rs * gg.x * (1.f + m4.x) + m3.x; o.y = v[i].y * rs * gg.y * (1.f + m4.y) + m3.y;
                    o.z = v[i].z * rs * gg.z * (1.f + m4.z) + m3.z; o.w = v[i].w * rs * gg.w * (1.f + m4.w) + m3.w;
                    unsigned* dst = reinterpret_cast<unsigned*>(h2 + (size_t)tok * D_MODEL + c);
                    if (!DRY) { dst[0] = pack2(o.x, o.y); dst[1] = pack2(o.z, o.w); }
                    *reinterpret_cast<F4*>(hrow + q * ROWF + c + (c / DG) * 4) = o;
                }
            }
        }
        wave_sync();
        float lg[TB4][EPL];
#pragma unroll
        for (int q = 0; q < TB4; ++q)
#pragma unroll
            for (int e = 0; e < EPL; ++e) lg[q][e] = 0.f;
        const float* rwp = rw + (size_t)dg * DG * N_EXPERTS + eg * EPL; const float* hp = hrow + dg * (DG + 4);
        constexpr int WB = DG >= 16 ? 16 : DG;
        static_assert(DG % WB == 0, "router batch");
#pragma unroll 1
        for (int d0 = 0; d0 < DG; d0 += WB) {
            F4 w[WB];
#pragma unroll
            for (int u = 0; u < WB; ++u) w[u] = ldf4(rwp + (size_t)(d0 + u) * N_EXPERTS);
#ifndef EMU
            __builtin_amdgcn_sched_barrier(0);
#endif
#pragma unroll
            for (int u = 0; u < WB; ++u) {
#pragma unroll
                for (int q = 0; q < TB4; ++q) {
                    const float hv = hp[q * ROWF + d0 + u];
                    lg[q][0] += hv * w[u].x; lg[q][1] += hv * w[u].y; lg[q][2] += hv * w[u].z; lg[q][3] += hv * w[u].w;
                }
            }
        }
#pragma unroll
        for (int q = 0; q < TB4; ++q) {
#pragma unroll
            for (int m = LPG; m < 64; m <<= 1) {
#pragma unroll
                for (int e = 0; e < EPL; ++e) lg[q][e] += __shfl_xor(lg[q][e], m, 64);
            }
            lg[q][0] += rb.x; lg[q][1] += rb.y; lg[q][2] += rb.z; lg[q][3] += rb.w;
            float tv[TOP_K]; int ti[TOP_K];
#pragma unroll
            for (int k = 0; k < TOP_K; ++k) {
                float bv = lg[q][0]; int bi = eg * EPL;
#pragma unroll
                for (int e = 1; e < EPL; ++e) if (lg[q][e] > bv) { bv = lg[q][e]; bi = eg * EPL + e; }
                if (LPG > 1) { const float ov = dpp_f<0xB1>(bv); const int oi = dpp_i<0xB1>(bi); if (ov > bv || (ov == bv && oi < bi)) { bv = ov; bi = oi; } }
                if (LPG > 2) { const float ov = dpp_f<0x4E>(bv); const int oi = dpp_i<0x4E>(bi); if (ov > bv || (ov == bv && oi < bi)) { bv = ov; bi = oi; } }
                if (LPG > 4) { const float ov = dpp_f<0x141>(bv); const int oi = dpp_i<0x141>(bi); if (ov > bv || (ov == bv && oi < bi)) { bv = ov; bi = oi; } }
                tv[k] = bv; ti[k] = bi;
#pragma unroll
                for (int e = 0; e < EPL; ++e) if (eg * EPL + e == bi) lg[q][e] = -INFINITY;
            }
            const int tok = tok0 + q * nwv;
            if (lane == 0 && tok < TM) {
                float s = 0.f, pe[TOP_K];
#pragma unroll
                for (int k = 0; k < TOP_K; ++k) { pe[k] = fexp(tv[k] - tv[0]); s += pe[k]; }
                const int itk = itg * TB4 + q;
#pragma unroll
                for (int k = 0; k < TOP_K; ++k) {
                    if (DRY) { sink(ti[k]); sink(pe[k] / s); }
                    else {
                        tope[(size_t)tok * TOP_K + k] = ti[k]; topp[(size_t)tok * TOP_K + k] = pe[k] / s;
                        const int lr = atomicAdd(&lcount[ti[k]], 1);
                        const int slot = ((itk * (NT / 64) + wl) * TOP_K + k) * 2;
                        lrec[slot] = (short)ti[k]; lrec[slot + 1] = (short)lr;
                    }
                }
            }
        }
        wave_sync();
    }
    if (!DRY) {
        __syncthreads();
        if (tid < N_EXPERTS) lbase[tid] = atomicAdd(&cnt[tid], lcount[tid]);
        __syncthreads();
        const int wv0 = (blockIdx.x * NT) >> 6;
        const int itmax = wv0 < TM ? (TM - 1 - wv0) / nwv + 1 : 0;
        for (int q = tid; q < itmax * (NT / 64) * TOP_K; q += NT) {
            const int itq = q / ((NT / 64) * TOP_K), rem = q - itq * ((NT / 64) * TOP_K), wq = rem / TOP_K, kq2 = rem - wq * TOP_K;
            const int tokq = wv0 + wq + itq * nwv;
            if (tokq < TM) rank[(size_t)tokq * TOP_K + kq2] = lbase[lrec[q * 2]] + lrec[q * 2 + 1];
        }
    }
}

struct MoeTab { int poff[N_EXPERTS + 1]; int cnt[N_EXPERTS]; int tile_e[MAX_MTILES]; int ntiles; };
template <int LAYER> __device__ __forceinline__ void build_moe_tab(const Params& p, MoeTab* tab) {
    const int* cnt = reinterpret_cast<const int*>(p.ws + WS_CNT) + LAYER * N_EXPERTS;
    const int tid = opaque_tid();
    if (tid < N_EXPERTS) tab->cnt[tid] = cnt[tid];
    __syncthreads();
    if (tid == 0) {
        int off = 0, nt = 0;
        for (int e = 0; e < N_EXPERTS; ++e) { tab->poff[e] = off; const int tl = (tab->cnt[e] + BM - 1) / BM; off += tl * BM; nt += tl; }
        tab->poff[N_EXPERTS] = off; tab->ntiles = nt;
    }
    __syncthreads();
    if (tid < N_EXPERTS) {
        const int t0 = tab->poff[tid] / BM, t1 = tab->poff[tid + 1] / BM;
        for (int t = t0; t < t1; ++t) tab->tile_e[t] = tid;
    }
    __syncthreads();
}

template <int LAYER> __device__ void phase_scatter(const Params& p, unsigned char* smem) {
    constexpr int TM = LAYER == 0 ? T_MOE0 : T_MOE1;
    MoeTab* tab = reinterpret_cast<MoeTab*>(smem);
    build_moe_tab<LAYER>(p, tab);
    const int* tope = reinterpret_cast<const int*>(p.ws + WS_TOPE); const int* rank = reinterpret_cast<const int*>(p.ws + WS_RANK);
    int* posof = reinterpret_cast<int*>(p.ws + WS_POSOF); int* tokof = reinterpret_cast<int*>(p.ws + WS_TOKOF);
    for (int i = blockIdx.x * NT + opaque_tid(); i < TM * TOP_K; i += gridDim.x * NT) {
        const int pos = tab->poff[tope[i]] + rank[i];
        posof[i] = pos; tokof[pos] = i / TOP_K;
    }
    __syncthreads();
    if (LAYER == 1) convert_expert_weights<1>(p, blockIdx.x, gridDim.x, smem, (int)gridDim.x > SCAN1_UNITS ? CVT_NDN : 0, CVT_NTOT);
}

constexpr int MOE1_MAX_UNITS = 24;
template <int LAYER, bool DRYE = false> struct ProbMoe1 {
    static constexpr int K = D_MODEL; static constexpr bool PERM = true;
    const MoeTab* tab; const char* A; const char* W; const int* toklds; bf16_t* H1; const float* bg; const float* bu; int G, c, nNv;
    __device__ __forceinline__ int nM() const { return tab->ntiles; }
    __device__ __forceinline__ int nN() const { return 2 * D_FF / 256; }
    __device__ __forceinline__ const char* a_base() const { return A; }
    __device__ __forceinline__ unsigned a_off(int pm, int r) const {
        int slot = 0;
        for (int i = 0; i < MOE1_MAX_UNITS; ++i) { if (toklds[MOE1_MAX_UNITS * 256 + i] == pm) { slot = i; break; } }
        return (unsigned)toklds[slot * 256 + r] * (unsigned)(K * 2);
    }
    __device__ __forceinline__ const char* b_base(int pm, int pn) const { return W + ((size_t)tab->tile_e[pm] * 2 * D_FF + (size_t)pn * 256) * K * 2; }
    __device__ __forceinline__ void epi(const f32x4 (&acc)[2][2][4][2], int pm, int pn, int wr, int wc, int fr, int fq) const {
        if (DRYE) { float t = 0.f; for (int a = 0; a < 2; ++a) for (int b = 0; b < 2; ++b) for (int m = 0; m < 4; ++m) for (int n = 0; n < 2; ++n) t += acc[a][b][m][n][0] + acc[a][b][m][n][1] + acc[a][b][m][n][2] + acc[a][b][m][n][3]; sink(t); return; }
        const int e = tab->tile_e[pm], col = pn * 128 + wc * 32 + fq * 8;
        const float* bgp = bg + (size_t)e * D_FF + col; const float* bup = bu + (size_t)e * D_FF + col;
        float bgv[8], buv[8];
#pragma unroll
        for (int i = 0; i < 2; ++i) { const F4 a = ldf4(bgp + 4 * i), b = ldf4(bup + 4 * i); bgv[4 * i] = a.x; bgv[4 * i + 1] = a.y; bgv[4 * i + 2] = a.z; bgv[4 * i + 3] = a.w; buv[4 * i] = b.x; buv[4 * i + 1] = b.y; buv[4 * i + 2] = b.z; buv[4 * i + 3] = b.w; }
#pragma unroll
        for (int ai = 0; ai < 2; ++ai)
#pragma unroll
            for (int m = 0; m < 4; ++m) {
                const int row = pm * 256 + ai * 128 + wr * 64 + m * 16 + fr;
                f32x4 hv[2];
#pragma unroll
                for (int n = 0; n < 2; ++n)
#pragma unroll
                    for (int j = 0; j < 4; ++j) {
                        const float gv = fminf(acc[ai][0][m][n][j] + bgv[4 * n + j], SWIGLU_LIMIT);
                        const float uv = fminf(fmaxf(acc[ai][1][m][n][j] + buv[4 * n + j], -SWIGLU_LIMIT), SWIGLU_LIMIT);
                        hv[n][j] = gv * sigmoidf_(SWIGLU_ALPHA * gv) * (uv + 1.f);
                    }
                st16(H1 + (size_t)row * D_FF + col, pack8(hv[0], hv[1]));
            }
    }
};
template <int LAYER, bool DRYE = false> __device__ void phase_moe1(const Params& p, unsigned char* smem) {
    MoeTab* tab = reinterpret_cast<MoeTab*>(smem + g8::STAGE_BYTES);
    build_moe_tab<LAYER>(p, tab);
    ProbMoe1<LAYER, DRYE> pr;
    pr.tab = tab; pr.A = reinterpret_cast<const char*>(p.ws + WS_H); pr.W = reinterpret_cast<const char*>(p.ws + WS_WGU);
    pr.H1 = reinterpret_cast<bf16_t*>(p.ws + WS_H1);
    {
        int* toklds = reinterpret_cast<int*>(smem + g8::STAGE_BYTES + 4096);
        int* slot_pm = toklds + MOE1_MAX_UNITS * 256;
        const int* tokof = reinterpret_cast<const int*>(p.ws + WS_TOKOF);
        const int tid = opaque_tid(), nM = tab->ntiles, nN = 2 * D_FF / 256;
        if (tid < MOE1_MAX_UNITS) slot_pm[tid] = -1;
        __syncthreads();
        if (tid == 0) {
            int nslot = 0;
            for (int i = 0; i < MOE1_MAX_UNITS * 4; ++i) {
                int pm, pn; if (!g8::unit_of(i * (int)gridDim.x + (int)blockIdx.x, nM, nN, pm, pn)) break;
                bool seen = false;
                for (int q = 0; q < nslot; ++q) seen = seen || (slot_pm[q] == pm);
                if (!seen && nslot < MOE1_MAX_UNITS) slot_pm[nslot++] = pm;
            }
            slot_pm[MOE1_MAX_UNITS] = nslot;
        }
        __syncthreads();
        const int nslot = slot_pm[MOE1_MAX_UNITS];
        for (int idx = tid; idx < nslot * 256; idx += NT) {
            const int pm = slot_pm[idx >> 8], e = tab->tile_e[pm], pbase = tab->poff[e], pos = pm * 256 + (idx & 255);
            toklds[idx] = tokof[(pos - pbase < tab->cnt[e]) ? pos : pbase];
        }
        __syncthreads();
        pr.toklds = toklds;
    }
    pr.bg = p.exp_b_gate + (size_t)LAYER * N_EXPERTS * D_FF; pr.bu = p.exp_b_up + (size_t)LAYER * N_EXPERTS * D_FF;
    g8::gemm_phase(smem, pr);
}

template <int LAYER, bool DRYE = false> struct ProbMoe2 {
    static constexpr int K = D_FF; static constexpr bool PERM = true;
    const MoeTab* tab; const char* A; const char* W; bf16_t* Y; const float* bd;
    __device__ __forceinline__ int nM() const { return tab->ntiles; }
    __device__ __forceinline__ int nN() const { return D_MODEL / 256; }
    __device__ __forceinline__ const char* a_base() const { return A; }
    __device__ __forceinline__ unsigned a_off(int pm, int r) const { return (unsigned)(pm * 256 + r) * (unsigned)(K * 2); }
    __device__ __forceinline__ const char* b_base(int pm, int pn) const { return W + ((size_t)tab->tile_e[pm] * D_MODEL + (size_t)pn * 256) * K * 2; }
    __device__ __forceinline__ void epi(const f32x4 (&acc)[2][2][4][2], int pm, int pn, int wr, int wc, int fr, int fq) const {
        if (DRYE) { float t = 0.f; for (int a = 0; a < 2; ++a) for (int b = 0; b < 2; ++b) for (int m = 0; m < 4; ++m) for (int n = 0; n < 2; ++n) t += acc[a][b][m][n][0] + acc[a][b][m][n][1] + acc[a][b][m][n][2] + acc[a][b][m][n][3]; sink(t); return; }
        const int e = tab->tile_e[pm];
#pragma unroll
        for (int bj = 0; bj < 2; ++bj) {
            const int col = pn * 256 + bj * 128 + wc * 32 + fq * 8;
            const F4 b0 = ldf4(bd + (size_t)e * D_MODEL + col), b1 = ldf4(bd + (size_t)e * D_MODEL + col + 4);
#pragma unroll
            for (int ai = 0; ai < 2; ++ai)
#pragma unroll
                for (int m = 0; m < 4; ++m) {
                    const int row = pm * 256 + ai * 128 + wr * 64 + m * 16 + fr;
                    f32x4 v0 = acc[ai][bj][m][0], v1 = acc[ai][bj][m][1];
                    v0[0] += b0.x; v0[1] += b0.y; v0[2] += b0.z; v0[3] += b0.w; v1[0] += b1.x; v1[1] += b1.y; v1[2] += b1.z; v1[3] += b1.w;
                    st16(Y + (size_t)row * D_MODEL + col, pack8(v0, v1));
                }
        }
    }
};
template <int LAYER, bool DRYE = false> __device__ void phase_moe2(const Params& p, unsigned char* smem) {
    MoeTab* tab = reinterpret_cast<MoeTab*>(smem + g8::STAGE_BYTES);
    build_moe_tab<LAYER>(p, tab);
    ProbMoe2<LAYER, DRYE> pr;
    pr.tab = tab; pr.A = reinterpret_cast<const char*>(p.ws + WS_H1); pr.W = reinterpret_cast<const char*>(p.ws + WS_WDN);
    pr.Y = reinterpret_cast<bf16_t*>(p.ws + WS_Y); pr.bd = p.exp_b_down + (size_t)LAYER * N_EXPERTS * D_MODEL;
    g8::gemm_phase(smem, pr);
}

template <int LAYER, bool DRY> __device__ void phase_combine(const Params& p) {
    constexpr int TM = LAYER == 0 ? T_MOE0 : T_MOE1;
    const int tid = opaque_tid(), lane = tid & 63, wv = (blockIdx.x * NT + tid) >> 6, nwv = gridDim.x * (NT / 64);
    const float* mod = reinterpret_cast<const float*>(p.ws + WS_MOD) + (size_t)LAYER * (BATCH + 1) * N_MOD * D_MODEL;
    float* xcw = reinterpret_cast<float*>(p.ws + WS_XC);
    const bf16_t* Y = reinterpret_cast<const bf16_t*>(p.ws + WS_Y);
    const int* posof = reinterpret_cast<const int*>(p.ws + WS_POSOF); const float* topp = reinterpret_cast<const float*>(p.ws + WS_TOPP);
    constexpr int NV = D_MODEL / 256;
    for (int tok = wv; tok < TM; tok += nwv) {
        float* xr; const float* md;
        if (LAYER == 0 && tok < T_CTX) { xr = xcw + (size_t)tok * D_MODEL; md = mod + ((size_t)BATCH * N_MOD + 5) * D_MODEL; }
        else { const int n = LAYER == 0 ? tok - T_CTX : tok; xr = p.out + (size_t)n * D_MODEL; md = mod + ((size_t)(n / SEQ) * N_MOD + 5) * D_MODEL; }
        int pos[TOP_K]; float pr[TOP_K];
#pragma unroll
        for (int k = 0; k < TOP_K; ++k) { pos[k] = posof[(size_t)tok * TOP_K + k]; pr[k] = topp[(size_t)tok * TOP_K + k]; }
        F4 xo[NV]; float ss = 0.f;
#pragma unroll
        for (int i = 0; i < NV; ++i) {
            const int c = i * 256 + lane * 4;
            float f0 = 0.f, f1 = 0.f, f2 = 0.f, f3 = 0.f;
#pragma unroll
            for (int k = 0; k < TOP_K; ++k) {
                const unsigned* yp = reinterpret_cast<const unsigned*>(Y + (size_t)pos[k] * D_MODEL + c);
                const unsigned u0 = yp[0], u1 = yp[1];
                f0 += pr[k] * lo2f(u0); f1 += pr[k] * hi2f(u0); f2 += pr[k] * lo2f(u1); f3 += pr[k] * hi2f(u1);
            }
            F4 xv = ldf4(xr + c), m5 = ldf4(md + c);
            xv.x += m5.x * f0; xv.y += m5.y * f1; xv.z += m5.z * f2; xv.w += m5.w * f3;
            xo[i] = xv; ss += xv.x * xv.x + xv.y * xv.y + xv.z * xv.z + xv.w * xv.w;
        }
        if (LAYER == 0 && !DRY) {
            const float rs1 = rsqrtf(wave_sum(ss) * (1.0f / D_MODEL) + EPS);
            const float* mod1 = reinterpret_cast<const float*>(p.ws + WS_MOD) + (size_t)(BATCH + 1) * N_MOD * D_MODEL;
            const float* md1; size_t drow;
            if (tok < T_CTX) { md1 = mod1 + (size_t)BATCH * N_MOD * D_MODEL; drow = (size_t)(tok / CTX_LEN) * LSEQ + tok % CTX_LEN; }
            else {
                const int n = tok - T_CTX, bb = n / SEQ, nn = n - bb * SEQ, r = nn / GRID_W, w = nn - r * GRID_W;
                md1 = mod1 + (size_t)bb * N_MOD * D_MODEL; drow = (size_t)bb * LSEQ + CTX_LEN + w * GRID_ROWS + r;
            }
            bf16_t* hrow1 = reinterpret_cast<bf16_t*>(p.ws + WS_H) + drow * D_MODEL;
#pragma unroll
            for (int i = 0; i < NV; ++i) {
                const int c = i * 256 + lane * 4;
                const F4 gg = ldf4(p.norm1_w + D_MODEL + c), m0 = ldf4(md1 + c), m1 = ldf4(md1 + D_MODEL + c);
                unsigned* dst = reinterpret_cast<unsigned*>(hrow1 + c);
                dst[0] = pack2(xo[i].x * rs1 * gg.x * (1.f + m1.x) + m0.x, xo[i].y * rs1 * gg.y * (1.f + m1.y) + m0.y);
                dst[1] = pack2(xo[i].z * rs1 * gg.z * (1.f + m1.z) + m0.z, xo[i].w * rs1 * gg.w * (1.f + m1.w) + m0.w);
            }
        }
        if (LAYER == 1) {
            ss = wave_sum(ss);
            const float rs = rsqrtf(ss * (1.0f / D_MODEL) + EPS);
#pragma unroll
            for (int i = 0; i < NV; ++i) {
                const int c = i * 256 + lane * 4; F4 gg = ldf4(p.final_norm_w + c);
                xo[i].x *= rs * gg.x; xo[i].y *= rs * gg.y; xo[i].z *= rs * gg.z; xo[i].w *= rs * gg.w;
            }
        }
#pragma unroll
        for (int i = 0; i < NV; ++i) { if (DRY) { sink(xo[i].x); sink(xo[i].y); sink(xo[i].z); sink(xo[i].w); } else *reinterpret_cast<F4*>(xr + i * 256 + lane * 4) = xo[i]; }
    }
}
__device__ void phase_prep1(const Params& p) {
    constexpr int NP = ODD_PROJ_PAD, RB = 32;
    constexpr int NCG = XC_W / 8;
    static_assert(SSD_CONV_CH % 8 == 0 && XC_W % 8 == 0 && SSD_INNER % 8 == 0 && SSD_PROJ % 8 == 0, "prep1 alignment");
    const bf16_t* P = reinterpret_cast<const bf16_t*>(p.ws + WS_P);
    bf16_t* XC = reinterpret_cast<bf16_t*>(p.ws + WS_AUX1);
    const int tid = opaque_tid();
    for (int task = blockIdx.x * NT + tid; task < (T_ALL / RB) * NCG; task += gridDim.x * NT) {
        const int rb = task / NCG, cg = task - rb * NCG, c = cg * 8, row0 = rb * RB;
        const int s0 = row0 % LSEQ;
        const int lo = s0 < CTX_LEN ? 0 : CTX_LEN, hi = s0 < CTX_LEN ? CTX_LEN : LSEQ;
        int pc; const float* cw; const float* cb; int cc, cwid;
        if (c < SSD_CONV_CH) { pc = SSD_INNER + c; cw = p.ssd_conv_w; cb = p.ssd_conv_b; cc = c; cwid = SSD_CONV_CH; }
        else { cc = c - SSD_CONV_CH; pc = SSD_PROJ + cc; cw = p.mlstm_conv_w; cb = p.mlstm_conv_b; cwid = 2 * ML_QKW; }
        float w[5][8], bias[8];
#pragma unroll
        for (int j = 0; j < 5; ++j) { const F4 a = ldf4(cw + j * cwid + cc), b = ldf4(cw + j * cwid + cc + 4); w[j][0] = a.x; w[j][1] = a.y; w[j][2] = a.z; w[j][3] = a.w; w[j][4] = b.x; w[j][5] = b.y; w[j][6] = b.z; w[j][7] = b.w; }
        { const F4 a = ldf4(cb + cc), b = ldf4(cb + cc + 4); bias[0] = a.x; bias[1] = a.y; bias[2] = a.z; bias[3] = a.w; bias[4] = b.x; bias[5] = b.y; bias[6] = b.z; bias[7] = b.w; }
        const bf16_t* src = P + (size_t)row0 * NP + pc;
        U4 win[5];
        const U4 zero = U4{0u, 0u, 0u, 0u};
        win[0] = zero; win[1] = zero;
        if (s0 - 2 >= lo) win[0] = ld16(src - 2 * (size_t)NP);
        if (s0 - 1 >= lo) win[1] = ld16(src - (size_t)NP);
        win[2] = ld16(src); win[3] = ld16(src + NP);
#pragma unroll 4
        for (int r = 0; r < RB; ++r) {
            win[4] = (s0 + r + 2 < hi) ? ld16(src + (size_t)(r + 2) * NP) : zero;
            float acc[8];
#pragma unroll
            for (int q = 0; q < 8; ++q) acc[q] = bias[q];
#pragma unroll
            for (int j = 0; j < 5; ++j) {
                const unsigned uu[4] = {win[j].x, win[j].y, win[j].z, win[j].w};
#pragma unroll
                for (int q = 0; q < 4; ++q) { acc[2 * q] += lo2f(uu[q]) * w[j][2 * q]; acc[2 * q + 1] += hi2f(uu[q]) * w[j][2 * q + 1]; }
            }
            U4 o; o.x = pack2(siluf_(acc[0]), siluf_(acc[1])); o.y = pack2(siluf_(acc[2]), siluf_(acc[3]));
            o.z = pack2(siluf_(acc[4]), siluf_(acc[5])); o.w = pack2(siluf_(acc[6]), siluf_(acc[7]));
            st16(XC + (size_t)(row0 + r) * XC_W + c, o);
            win[0] = win[1]; win[1] = win[2]; win[2] = win[3]; win[3] = win[4];
        }
    }
}

#ifdef EMU
__device__ __forceinline__ float wave_incl_scan_add(float v, int lane) {
#pragma unroll
    for (int d = 1; d < 64; d <<= 1) { const float o = __shfl_up(v, d, 64); if (lane >= d) v += o; }
    return v;
}
__device__ __forceinline__ float wave_incl_scan_max(float v, int lane) {
#pragma unroll
    for (int d = 1; d < 64; d <<= 1) { const float o = __shfl_up(v, d, 64); if (lane >= d) v = fmaxf(v, o); }
    return v;
}
__device__ __forceinline__ float wave_last(float v) { return __shfl(v, 63, 64); }
#else
template <int CTRL, int ROWMASK> __device__ __forceinline__ float dpp_or(float oldv, float v) {
    return __builtin_bit_cast(float, __builtin_amdgcn_update_dpp(__builtin_bit_cast(int, oldv), __builtin_bit_cast(int, v), CTRL, ROWMASK, 0xF, false));
}
__device__ __forceinline__ float wave_incl_scan_add(float v, int) {
    v += dpp_or<0x111, 0xF>(0.f, v); v += dpp_or<0x112, 0xF>(0.f, v); v += dpp_or<0x114, 0xF>(0.f, v); v += dpp_or<0x118, 0xF>(0.f, v);
    v += dpp_or<0x142, 0xA>(0.f, v); v += dpp_or<0x143, 0xC>(0.f, v);
    return v;
}
__device__ __forceinline__ float wave_incl_scan_max(float v, int) {
    const float ninf = -INFINITY;
    v = fmaxf(v, dpp_or<0x111, 0xF>(ninf, v)); v = fmaxf(v, dpp_or<0x112, 0xF>(ninf, v)); v = fmaxf(v, dpp_or<0x114, 0xF>(ninf, v)); v = fmaxf(v, dpp_or<0x118, 0xF>(ninf, v));
    v = fmaxf(v, dpp_or<0x142, 0xA>(ninf, v)); v = fmaxf(v, dpp_or<0x143, 0xC>(ninf, v));
    return v;
}
__device__ __forceinline__ float wave_last(float v) { return __builtin_bit_cast(float, __builtin_amdgcn_readlane(__builtin_bit_cast(int, v), 63)); }
#endif

__device__ void ssd_unit(const Params& p, unsigned char* smem, int u) {
    constexpr int NP = ODD_PROJ_PAD, CH = SSD_CH, HP = SSD_HG / 2, LDN = 136, LDS_ = 72;
    const int dir = u / (BATCH * SSD_G * HP), b = (u / (SSD_G * HP)) % BATCH, g = (u / HP) % SSD_G, hp = u % HP;
    const int tid = opaque_tid(), wid = tid >> 6, lane = tid & 63, fr = lane & 15, fq = lane >> 4;
    const int hh = wid >> 2, wq = wid & 3, head0 = g * SSD_HG + hp * 2, head = head0 + hh;
    const bf16_t* P = reinterpret_cast<const bf16_t*>(p.ws + WS_P);
    const bf16_t* XC = reinterpret_cast<const bf16_t*>(p.ws + WS_AUX1);
    bf16_t* O = reinterpret_cast<bf16_t*>(p.ws + WS_O1) + (size_t)dir * T_ALL * OW1;
    bf16_t* Cm = reinterpret_cast<bf16_t*>(smem);
    bf16_t* Bm = Cm + CH * LDN;
    bf16_t* BT = Bm + CH * LDN;
    bf16_t* xL = BT + 128 * LDS_;
    bf16_t* Gb = xL + CH * 128;
    bf16_t* xdtTb = Gb + 2 * CH * LDS_;
    bf16_t* xdtETb = xdtTb + 2 * 64 * LDS_;
    float* acumb = reinterpret_cast<float*>(xdtETb + 2 * 64 * LDS_);
    f32x4 hs[8];
#pragma unroll
    for (int n = 0; n < 8; ++n) hs[n] = f32x4{0.f, 0.f, 0.f, 0.f};
    const float dtb = p.ssd_dt_bias[dir * SSD_HEADS + head], aneg = -fexp(p.ssd_a_log[dir * SSD_HEADS + head]);
    const int lt = tid >> 4, lc = (tid & 15) * 8;
    U4 rB[2], rC[2], rX[2]; float rdt = 0.f;
    auto issue = [&](int j0) {
#pragma unroll
        for (int i = 0; i < 2; ++i) {
            const bf16_t* xr = XC + ((size_t)b * LSEQ + step_pos(dir, j0 + lt + 32 * i)) * XC_W;
            rB[i] = ld16(xr + SSD_INNER + g * SSD_N + lc); rC[i] = ld16(xr + SSD_INNER + SSD_G * SSD_N + g * SSD_N + lc);
            rX[i] = ld16(xr + head0 * SSD_P + lc);
        }
        if (wq == 0) rdt = bf2f(P[((size_t)b * LSEQ + step_pos(dir, j0 + lane)) * NP + SSD_INNER + SSD_CONV_CH + dir * SSD_HEADS + head]);
    };
    issue(0);
    for (int j0 = 0; j0 < LSEQ; j0 += CH) {
#pragma unroll
        for (int i = 0; i < 2; ++i) {
            const int t = lt + 32 * i;
            st16(Bm + t * LDN + lc, rB[i]); st16(Cm + t * LDN + lc, rC[i]); st16(xL + t * 128 + lc, rX[i]);
        }
        if (wq == 0) {
            const float dt = softplusf_(rdt + dtb);
            const float ac = wave_incl_scan_add(dt * aneg, lane);
            acumb[hh * 128 + lane] = ac; acumb[hh * 128 + 64 + lane] = dt;
        }
        lds_barrier();
        if (j0 + CH < LSEQ) issue(j0 + CH);
#pragma unroll
        for (int i = 0; i < 2; ++i) {
            const int it = tid + 512 * i;
            { const int sg = it >> 7, n = it & 127; st16(BT + n * LDS_ + 8 * sg, gather8(Bm + (8 * sg) * LDN + n, LDN)); }
            {
                const int h2 = it >> 9, sg = (it >> 6) & 7, pp = it & 63;
                const U4 x8 = gather8(xL + (8 * sg) * 128 + h2 * 64 + pp, 128);
                const float* ac = acumb + h2 * 128;
                const F4 a0 = ldf4(ac + 8 * sg), a1 = ldf4(ac + 8 * sg + 4), d0 = ldf4(ac + 64 + 8 * sg), d1 = ldf4(ac + 64 + 8 * sg + 4);
                const float al = ac[63];
                const float xv[8] = {lo2f(x8.x) * d0.x, hi2f(x8.x) * d0.y, lo2f(x8.y) * d0.z, hi2f(x8.y) * d0.w, lo2f(x8.z) * d1.x, hi2f(x8.z) * d1.y, lo2f(x8.w) * d1.z, hi2f(x8.w) * d1.w};
                const float ev[8] = {fexp(al - a0.x), fexp(al - a0.y), fexp(al - a0.z), fexp(al - a0.w), fexp(al - a1.x), fexp(al - a1.y), fexp(al - a1.z), fexp(al - a1.w)};
                U4 o; o.x = pack2(xv[0], xv[1]); o.y = pack2(xv[2], xv[3]); o.z = pack2(xv[4], xv[5]); o.w = pack2(xv[6], xv[7]);
                st16(xdtTb + h2 * (64 * LDS_) + pp * LDS_ + 8 * sg, o);
                o.x = pack2(xv[0] * ev[0], xv[1] * ev[1]); o.y = pack2(xv[2] * ev[2], xv[3] * ev[3]); o.z = pack2(xv[4] * ev[4], xv[5] * ev[5]); o.w = pack2(xv[6] * ev[6], xv[7] * ev[7]);
                st16(xdtETb + h2 * (64 * LDS_) + pp * LDS_ + 8 * sg, o);
            }
        }
#pragma unroll
        for (int q = 0; q < 2; ++q) {
            const int tile = wid * 2 + q, ti = tile >> 2, si = tile & 3;
            f32x4 a = f32x4{0.f, 0.f, 0.f, 0.f};
#pragma unroll
            for (int ks = 0; ks < 4; ++ks) {
                bf16x8 fa = *reinterpret_cast<const bf16x8*>(Cm + (ti * 16 + fr) * LDN + ks * 32 + fq * 8);
                bf16x8 fb = *reinterpret_cast<const bf16x8*>(Bm + (si * 16 + fr) * LDN + ks * 32 + fq * 8);
                a = mfma16(fb, fa, a);
            }
            const int t = ti * 16 + fr, s0 = si * 16 + fq * 4;
#pragma unroll
            for (int h2 = 0; h2 < 2; ++h2) {
                const float* ac = acumb + h2 * 128;
                const float at = ac[t]; const F4 as = ldf4(ac + s0);
                const float e0 = s0 <= t ? a[0] * fexp(at - as.x) : 0.f, e1 = s0 + 1 <= t ? a[1] * fexp(at - as.y) : 0.f;
                const float e2 = s0 + 2 <= t ? a[2] * fexp(at - as.z) : 0.f, e3 = s0 + 3 <= t ? a[3] * fexp(at - as.w) : 0.f;
                unsigned* dst = reinterpret_cast<unsigned*>(Gb + h2 * (CH * LDS_) + t * LDS_ + s0);
                dst[0] = pack2(e0, e1); dst[1] = pack2(e2, e3);
            }
        }
        lds_barrier();
        {
            const bf16_t* Gm = Gb + hh * (CH * LDS_); const bf16_t* xdtT = xdtTb + hh * (64 * LDS_); const bf16_t* xdtET = xdtETb + hh * (64 * LDS_);
            const float* ac = acumb + hh * 128;
            const bool lat = step_pos(dir, j0) >= CTX_LEN;
#pragma unroll
            for (int ti = 0; ti < 4; ++ti) {
                f32x4 a1 = f32x4{0.f, 0.f, 0.f, 0.f}, a2 = f32x4{0.f, 0.f, 0.f, 0.f};
#pragma unroll
                for (int ks = 0; ks < 2; ++ks) {
                    bf16x8 fa = *reinterpret_cast<const bf16x8*>(Gm + (ti * 16 + fr) * LDS_ + ks * 32 + fq * 8);
                    bf16x8 fb = *reinterpret_cast<const bf16x8*>(xdtT + (wq * 16 + fr) * LDS_ + ks * 32 + fq * 8);
                    a1 = mfma16(fb, fa, a1);
                }
#pragma unroll
                for (int ks = 0; ks < 4; ++ks) {
                    U4 su; su.x = pack2(hs[2 * ks][0], hs[2 * ks][1]); su.y = pack2(hs[2 * ks][2], hs[2 * ks][3]);
                    su.z = pack2(hs[2 * ks + 1][0], hs[2 * ks + 1][1]); su.w = pack2(hs[2 * ks + 1][2], hs[2 * ks + 1][3]);
                    const unsigned long long c0 = *reinterpret_cast<const unsigned long long*>(Cm + (ti * 16 + fr) * LDN + ks * 32 + 4 * fq);
                    const unsigned long long c1 = *reinterpret_cast<const unsigned long long*>(Cm + (ti * 16 + fr) * LDN + ks * 32 + 16 + 4 * fq);
                    U4 cu; cu.x = (unsigned)c0; cu.y = (unsigned)(c0 >> 32); cu.z = (unsigned)c1; cu.w = (unsigned)(c1 >> 32);
                    a2 = mfma16(__builtin_bit_cast(bf16x8, su), __builtin_bit_cast(bf16x8, cu), a2);
                }
                if (lat) {
                    const int t = ti * 16 + fr;
                    const float ea = fexp(ac[t]);
                    const size_t rowg = (size_t)b * LSEQ + step_pos(dir, j0 + t);
                    unsigned* dst = reinterpret_cast<unsigned*>(O + rowg * OW1 + head * SSD_P + wq * 16 + fq * 4);
                    dst[0] = pack2(a1[0] + ea * a2[0], a1[1] + ea * a2[1]); dst[1] = pack2(a1[2] + ea * a2[2], a1[3] + ea * a2[3]);
                }
            }
            const float ea = fexp(ac[63]);
            bf16x8 fa0 = *reinterpret_cast<const bf16x8*>(xdtET + (wq * 16 + fr) * LDS_ + fq * 8);
            bf16x8 fa1 = *reinterpret_cast<const bf16x8*>(xdtET + (wq * 16 + fr) * LDS_ + 32 + fq * 8);
#pragma unroll
            for (int n = 0; n < 8; ++n) {
                f32x4 c = hs[n]; c[0] *= ea; c[1] *= ea; c[2] *= ea; c[3] *= ea;
                bf16x8 fb0 = *reinterpret_cast<const bf16x8*>(BT + (n * 16 + fr) * LDS_ + fq * 8);
                bf16x8 fb1 = *reinterpret_cast<const bf16x8*>(BT + (n * 16 + fr) * LDS_ + 32 + fq * 8);
                c = mfma16(fb0, fa0, c);
                hs[n] = mfma16(fb1, fa1, c);
            }
        }
        lds_barrier();
    }
}

__device__ void mlstm_unit(const Params& p, unsigned char* smem, int u) {
    constexpr int NP = ODD_PROJ_PAD, CH = ML_CH, VH = ML_DV / 2, LDD = 136, LDS_ = 72;
    const int dir = u / (BATCH * MLSTM_HEADS * 2), b = (u / (MLSTM_HEADS * 2)) % BATCH, h = (u >> 1) % MLSTM_HEADS, half = u & 1;
    const int tid = opaque_tid(), wid = tid >> 6, lane = tid & 63, fr = lane & 15, fq = lane >> 4;
    const bf16_t* P = reinterpret_cast<const bf16_t*>(p.ws + WS_P);
    const bf16_t* XC = reinterpret_cast<const bf16_t*>(p.ws + WS_AUX1);
    bf16_t* O = reinterpret_cast<bf16_t*>(p.ws + WS_O1) + (size_t)dir * T_ALL * OW1;
    bf16_t* qL = reinterpret_cast<bf16_t*>(smem);
    bf16_t* kL = qL + CH * LDD;
    bf16_t* vL = kL + CH * LDD;
    bf16_t* vT = vL + CH * LDD;
    bf16_t* kET = vT + VH * LDS_;
    bf16_t* Sc = kET + 128 * LDS_;
    float* Fv = reinterpret_cast<float*>(Sc + CH * LDS_);
    float* gv = Fv + 64; float* Mv = gv + 64; float* wint = Mv + 64; float* coef = wint + 64; float* den = coef + 64;
    float* nsv = den + 64;
    float* scal = nsv + 128;
    f32x4 Ct[8];
#pragma unroll
    for (int n = 0; n < 8; ++n) Ct[n] = f32x4{0.f, 0.f, 0.f, 0.f};
    if (tid < 128) nsv[tid] = 0.f;
    if (tid == 0) scal[0] = ML_M_INIT;
    const float ib = p.mlstm_i_bias[dir * MLSTM_HEADS + h], fb_ = p.mlstm_f_bias[dir * MLSTM_HEADS + h];
    const int lt = tid >> 4, lc = (tid & 15) * 8;
    U4 rq[2], rk[2], rv[2]; float rli = 0.f, rfg = 0.f;
    auto issue = [&](int j0) {
#pragma unroll
        for (int i = 0; i < 2; ++i) {
            const size_t rowg = (size_t)b * LSEQ + step_pos(dir, j0 + lt + 32 * i);
            const bf16_t* xr = XC + rowg * XC_W + SSD_CONV_CH + h * ML_DK + lc;
            rq[i] = ld16(xr); rk[i] = ld16(xr + ML_QKW);
            rv[i] = ld16(P + rowg * NP + SSD_PROJ + 2 * ML_QKW + h * ML_DV + half * VH + lc);
        }
        if (wid == 0) {
            const bf16_t* gr = P + ((size_t)b * LSEQ + step_pos(dir, j0 + lane)) * NP + SSD_PROJ + 2 * ML_QKW + 2 * ML_VW;
            rli = bf2f(gr[dir * MLSTM_HEADS + h]); rfg = bf2f(gr[2 * MLSTM_HEADS + dir * MLSTM_HEADS + h]);
        }
    };
    issue(0);
    lds_barrier();
    for (int j0 = 0; j0 < LSEQ; j0 += CH) {
#pragma unroll
        for (int i = 0; i < 2; ++i) {
            const int t = lt + 32 * i;
            st16(qL + t * LDD + lc, rq[i]); st16(kL + t * LDD + lc, scale8(rk[i], 0.08838834764831845f)); st16(vL + t * LDD + lc, rv[i]);
        }
        if (wid == 0) {
            const float li = rli + ib, fx = rfg + fb_;
            const float lf = -softplusf_(-fx);
            const float F = wave_incl_scan_add(lf, lane);
            const float gg = li - F;
            const float pm = wave_incl_scan_max(gg, lane);
            const float mc = scal[0];
            const float M = fmaxf(pm, mc);
            const float F63 = wave_last(F), pm63 = wave_last(pm);
            const float m_end = F63 + pm63, m_new = fmaxf(F63 + mc, m_end);
            Fv[lane] = F; gv[lane] = gg; Mv[lane] = M; wint[lane] = fexp(mc - M);
            coef[lane] = fexp(gg + F63 - m_new);
            if (lane == 0) { scal[1] = fexp(F63 + mc - m_new); scal[2] = m_new; }
        }
        lds_barrier();
        if (j0 + CH < LSEQ) issue(j0 + CH);
#pragma unroll
        for (int i = 0; i < 2; ++i) {
            const int it = tid + 512 * i, sg = it >> 7, d = it & 127;
            U4 kk = gather8(kL + (8 * sg) * LDD + d, LDD);
            const F4 c0 = ldf4(coef + 8 * sg), c1 = ldf4(coef + 8 * sg + 4);
            U4 ke; ke.x = pack2(lo2f(kk.x) * c0.x, hi2f(kk.x) * c0.y); ke.y = pack2(lo2f(kk.y) * c0.z, hi2f(kk.y) * c0.w);
            ke.z = pack2(lo2f(kk.z) * c1.x, hi2f(kk.z) * c1.y); ke.w = pack2(lo2f(kk.w) * c1.z, hi2f(kk.w) * c1.w);
            st16(kET + d * LDS_ + 8 * sg, ke);
            st16(vT + d * LDS_ + 8 * sg, gather8(vL + (8 * sg) * LDD + d, LDD));
        }
#pragma unroll
        for (int q = 0; q < 2; ++q) {
            const int tile = wid * 2 + q, ti = tile >> 2, si = tile & 3;
            f32x4 a = f32x4{0.f, 0.f, 0.f, 0.f};
#pragma unroll
            for (int ks = 0; ks < 4; ++ks) {
                bf16x8 fa = *reinterpret_cast<const bf16x8*>(qL + (ti * 16 + fr) * LDD + ks * 32 + fq * 8);
                bf16x8 fb = *reinterpret_cast<const bf16x8*>(kL + (si * 16 + fr) * LDD + ks * 32 + fq * 8);
                a = mfma16(fb, fa, a);
            }
            const int t = ti * 16 + fr, s0 = si * 16 + fq * 4;
            const float mt = Mv[t]; const F4 g4 = ldf4(gv + s0);
            const float e0 = s0 <= t ? a[0] * fexp(g4.x - mt) : 0.f, e1 = s0 + 1 <= t ? a[1] * fexp(g4.y - mt) : 0.f;
            const float e2 = s0 + 2 <= t ? a[2] * fexp(g4.z - mt) : 0.f, e3 = s0 + 3 <= t ? a[3] * fexp(g4.w - mt) : 0.f;
            unsigned* dst = reinterpret_cast<unsigned*>(Sc + t * LDS_ + s0);
            dst[0] = pack2(e0, e1); dst[1] = pack2(e2, e3);
        }
        lds_barrier();
        {
            const int t = tid >> 3, part = tid & 7;
            const U4 sv = ld16(Sc + t * LDS_ + part * 8);
            float rsum = (lo2f(sv.x) + hi2f(sv.x)) + (lo2f(sv.y) + hi2f(sv.y)) + (lo2f(sv.z) + hi2f(sv.z)) + (lo2f(sv.w) + hi2f(sv.w));
            const U4 q0 = ld16(qL + t * LDD + part * 16), q1 = ld16(qL + t * LDD + part * 16 + 8);
            const F4 n0 = ldf4(nsv + part * 16), n1 = ldf4(nsv + part * 16 + 4), n2 = ldf4(nsv + part * 16 + 8), n3 = ldf4(nsv + part * 16 + 12);
            float qn = lo2f(q0.x) * n0.x + hi2f(q0.x) * n0.y + lo2f(q0.y) * n0.z + hi2f(q0.y) * n0.w + lo2f(q0.z) * n1.x + hi2f(q0.z) * n1.y + lo2f(q0.w) * n1.z + hi2f(q0.w) * n1.w
                     + lo2f(q1.x) * n2.x + hi2f(q1.x) * n2.y + lo2f(q1.y) * n2.z + hi2f(q1.y) * n2.w + lo2f(q1.z) * n3.x + hi2f(q1.z) * n3.y + lo2f(q1.w) * n3.z + hi2f(q1.w) * n3.w;
            const float dsum = sum8(rsum + wint[t] * qn);
            if (part == 0) den[t] = dsum;
        }
        float nsnew;
        {
            const int d = tid >> 2, part = tid & 3;
            const U4 k0 = ld16(kET + d * LDS_ + part * 16), k1 = ld16(kET + d * LDS_ + part * 16 + 8);
            float acc = (lo2f(k0.x) + hi2f(k0.x)) + (lo2f(k0.y) + hi2f(k0.y)) + (lo2f(k0.z) + hi2f(k0.z)) + (lo2f(k0.w) + hi2f(k0.w))
                      + (lo2f(k1.x) + hi2f(k1.x)) + (lo2f(k1.y) + hi2f(k1.y)) + (lo2f(k1.z) + hi2f(k1.z)) + (lo2f(k1.w) + hi2f(k1.w));
            acc += dpp_f<0xB1>(acc); acc += dpp_f<0x4E>(acc);
            nsnew = scal[1] * nsv[d] + acc;
        }
        f32x4 num[4];
#pragma unroll
        for (int ti = 0; ti < 4; ++ti) {
            f32x4 a1 = f32x4{0.f, 0.f, 0.f, 0.f}, a2 = f32x4{0.f, 0.f, 0.f, 0.f};
#pragma unroll
            for (int ks = 0; ks < 2; ++ks) {
                bf16x8 fa = *reinterpret_cast<const bf16x8*>(Sc + (ti * 16 + fr) * LDS_ + ks * 32 + fq * 8);
                bf16x8 fb = *reinterpret_cast<const bf16x8*>(vT + (wid * 16 + fr) * LDS_ + ks * 32 + fq * 8);
                a1 = mfma16(fb, fa, a1);
            }
#pragma unroll
            for (int ks = 0; ks < 4; ++ks) {
                U4 su; su.x = pack2(Ct[2 * ks][0], Ct[2 * ks][1]); su.y = pack2(Ct[2 * ks][2], Ct[2 * ks][3]);
                su.z = pack2(Ct[2 * ks + 1][0], Ct[2 * ks + 1][1]); su.w = pack2(Ct[2 * ks + 1][2], Ct[2 * ks + 1][3]);
                const unsigned long long q0 = *reinterpret_cast<const unsigned long long*>(qL + (ti * 16 + fr) * LDD + ks * 32 + 4 * fq);
                const unsigned long long q1 = *reinterpret_cast<const unsigned long long*>(qL + (ti * 16 + fr) * LDD + ks * 32 + 16 + 4 * fq);
                U4 qu; qu.x = (unsigned)q0; qu.y = (unsigned)(q0 >> 32); qu.z = (unsigned)q1; qu.w = (unsigned)(q1 >> 32);
                a2 = mfma16(__builtin_bit_cast(bf16x8, su), __builtin_bit_cast(bf16x8, qu), a2);
            }
            const float wi = wint[ti * 16 + fr];
#pragma unroll
            for (int j = 0; j < 4; ++j) num[ti][j] = a1[j] + wi * a2[j];
        }
        lds_barrier();
        if ((tid & 3) == 0) nsv[tid >> 2] = nsnew;
        if (tid == 0) scal[0] = scal[2];
        if (step_pos(dir, j0) >= CTX_LEN) {
#pragma unroll
            for (int ti = 0; ti < 4; ++ti) {
                const int t = ti * 16 + fr;
                const size_t rowg = (size_t)b * LSEQ + step_pos(dir, j0 + t);
                const float inv = 1.0f / fmaxf(fabsf(den[t]), fexp(-(Mv[t] + Fv[t])));
                unsigned* dst = reinterpret_cast<unsigned*>(O + rowg * OW1 + SSD_INNER + h * ML_DV + half * VH + wid * 16 + fq * 4);
                dst[0] = pack2(num[ti][0] * inv, num[ti][1] * inv); dst[1] = pack2(num[ti][2] * inv, num[ti][3] * inv);
            }
        }
        {
            const float so = scal[1];
            bf16x8 fa0 = *reinterpret_cast<const bf16x8*>(vT + (wid * 16 + fr) * LDS_ + fq * 8);
            bf16x8 fa1 = *reinterpret_cast<const bf16x8*>(vT + (wid * 16 + fr) * LDS_ + 32 + fq * 8);
#pragma unroll
            for (int n = 0; n < 8; ++n) {
                f32x4 c = Ct[n]; c[0] *= so; c[1] *= so; c[2] *= so; c[3] *= so;
                bf16x8 fb0 = *reinterpret_cast<const bf16x8*>(kET + (n * 16 + fr) * LDS_ + fq * 8);
                bf16x8 fb1 = *reinterpret_cast<const bf16x8*>(kET + (n * 16 + fr) * LDS_ + 32 + fq * 8);
                c = mfma16(fb0, fa0, c);
                Ct[n] = mfma16(fb1, fa1, c);
            }
        }
        lds_barrier();
    }
}

template <int MODE = 0> __device__ void phase_scan1(const Params& p, unsigned char* smem) {
    constexpr int NU_S = 2 * BATCH * SSD_G * (SSD_HG / 2), NU_M = 2 * BATCH * MLSTM_HEADS * 2;
    static_assert(NU_S + NU_M == SCAN1_UNITS, "scan-1 units");
    if ((int)gridDim.x > SCAN1_UNITS && (int)blockIdx.x >= SCAN1_UNITS) convert_expert_weights<1>(p, blockIdx.x - SCAN1_UNITS, gridDim.x - SCAN1_UNITS, smem, 0, CVT_NDN);
    for (int u = blockIdx.x; u < NU_S + NU_M; u += gridDim.x) {
#ifndef PROBE_REPS_C
#define PROBE_REPS_C 1
#define PROBE_REPS_D 1
#endif
        if (u < NU_M) { for (int rep = 0; rep < PROBE_REPS_C; ++rep) mlstm_unit(p, smem, u); } else { for (int rep = 0; rep < PROBE_REPS_D; ++rep) ssd_unit(p, smem, u - NU_M); }
        __syncthreads();
    }
}

template <bool DRY> __device__ void phase_finish1(const Params& p) {
    constexpr int NP = ODD_PROJ_PAD;
    constexpr int NVS = SSD_INNER / 8, NIS = (NVS + 63) / 64, GVS = (SSD_INNER / SSD_G) / 8;
    constexpr int NVM = ML_VW / 8, NIM = (NVM + 63) / 64, GVM = ML_DV / 8;
    static_assert(GVS <= 64 && GVM <= 64 && (NVS % 64 == 0 || NVS < 64) && (NVM % 64 == 0 || NVM < 64), "finish1 layout");
    const int tid = opaque_tid(), lane = tid & 63, wv = (blockIdx.x * NT + tid) >> 6, nwv = gridDim.x * (NT / 64);
    const bf16_t* P = reinterpret_cast<const bf16_t*>(p.ws + WS_P);
    const bf16_t* XC = reinterpret_cast<const bf16_t*>(p.ws + WS_AUX1);
    bf16_t* O0 = reinterpret_cast<bf16_t*>(p.ws + WS_O1);
    const bf16_t* O1 = O0 + (size_t)T_ALL * OW1;
    for (int m = wv; m < T_LAT; m += nwv) {
        const int b = m / SEQ, j = m - b * SEQ;
        const size_t row = (size_t)b * LSEQ + CTX_LEN + j;
        bf16_t* o0 = O0 + row * OW1; const bf16_t* o1 = O1 + row * OW1;
        const bf16_t* pr = P + row * NP; const bf16_t* xr = XC + row * XC_W;
#pragma unroll
        for (int it = 0; it < NIS; ++it) {
            const int vi = lane + 64 * it; const bool act = vi < NVS; const int c = (act ? vi : 0) * 8;
            float x0[8], x1[8], xs[8], zg[8], nw[8], y[8];
            unpack8(ld16(o0 + c), x0); unpack8(ld16(o1 + c), x1); unpack8(ld16(xr + c), xs); unpack8(ld16(pr + c), zg); ldf8(p.ssd_norm_w + c, nw);
            const float dsk = p.ssd_d[c / SSD_P];
            float ss = 0.f;
#pragma unroll
            for (int i = 0; i < 8; ++i) { y[i] = (x0[i] + x1[i] + dsk * xs[i]) * siluf_(zg[i]); ss += y[i] * y[i]; }
            ss = group_sum_v<GVS>(act ? ss : 0.f) * (1.f / (SSD_INNER / SSD_G));
            const float rs = rsqrtf(ss + EPS);
#pragma unroll
            for (int i = 0; i < 8; ++i) y[i] *= rs * nw[i];
            if (act) { if (DRY) { sink(y[0]); sink(y[7]); } else st16(o0 + c, pack8f(y)); }
        }
#pragma unroll
        for (int it = 0; it < NIM; ++it) {
            const int vi = lane + 64 * it; const bool act = vi < NVM; const int c = (act ? vi : 0) * 8;
            float x0[8], x1[8], og[8], nw[8], y[8];
            unpack8(ld16(o0 + SSD_INNER + c), x0); unpack8(ld16(o1 + SSD_INNER + c), x1); unpack8(ld16(pr + SSD_PROJ + 2 * ML_QKW + ML_VW + c), og); ldf8(p.mlstm_norm_w + c, nw);
            float ss = 0.f;
#pragma unroll
            for (int i = 0; i < 8; ++i) { y[i] = x0[i] + x1[i]; ss += y[i] * y[i]; }
            ss = group_sum_v<GVM>(act ? ss : 0.f) * (1.f / ML_DV);
            const float rs = rsqrtf(ss + EPS);
#pragma unroll
            for (int i = 0; i < 8; ++i) y[i] *= rs * nw[i] * sigmoidf_(og[i]);
            if (act) { if (DRY) { sink(y[0]); sink(y[7]); } else st16(o0 + SSD_INNER + c, pack8f(y)); }
        }
    }
}

enum { PH_PRO = 0,
       PH_NORM1_0, PH_INPROJ_0, PH_PREP_0, PH_SCAN_0, PH_FIN_0, PH_OUTPROJ_0, PH_ROUTER_0, PH_SCATTER_0, PH_MOE1_0, PH_MOE2_0, PH_COMBINE_0,
       PH_INPROJ_1, PH_PREP_1, PH_SCAN_1, PH_FIN_1, PH_OUTPROJ_1, PH_ROUTER_1, PH_SCATTER_1, PH_MOE1_1, PH_MOE2_1, PH_COMBINE_1,
       PH_COUNT };

template <int PH, bool DRY = false> __device__ __forceinline__ void run_phase(const Params& p, unsigned char* smem) {
    if (PH == PH_PRO) phase_prologue(p, smem);
    else if (PH == PH_NORM1_0) phase_norm1<0>(p);
    else if (PH == PH_INPROJ_0) phase_inproj<0>(p, smem);
    else if (PH == PH_PREP_0) phase_prep0(p, smem);
#ifndef PROBE_SCAN_MODE
#define PROBE_SCAN_MODE 0
#endif
    else if (PH == PH_SCAN_0) { if (DRY) phase_scan0<PROBE_SCAN_MODE>(p, smem); else phase_scan0<0>(p, smem); }
    else if (PH == PH_FIN_0) phase_finish0<DRY>(p);
    else if (PH == PH_OUTPROJ_0) phase_outproj<0>(p, smem);
    else if (PH == PH_ROUTER_0) phase_router<0, DRY>(p, smem);
    else if (PH == PH_SCATTER_0) phase_scatter<0>(p, smem);
    else if (PH == PH_MOE1_0) phase_moe1<0, DRY>(p, smem);
    else if (PH == PH_MOE2_0) phase_moe2<0, DRY>(p, smem);
    else if (PH == PH_COMBINE_0) phase_combine<0, DRY>(p);
    else if (PH == PH_INPROJ_1) phase_inproj<1>(p, smem);
    else if (PH == PH_PREP_1) phase_prep1(p);
    else if (PH == PH_SCAN_1) { if (DRY) phase_scan1<PROBE_SCAN_MODE>(p, smem); else phase_scan1<0>(p, smem); }
    else if (PH == PH_FIN_1) phase_finish1<DRY>(p);
    else if (PH == PH_OUTPROJ_1) phase_outproj<1>(p, smem);
    else if (PH == PH_ROUTER_1) phase_router<1, DRY>(p, smem);
    else if (PH == PH_SCATTER_1) phase_scatter<1>(p, smem);
    else if (PH == PH_MOE1_1) phase_moe1<1>(p, smem);
    else if (PH == PH_MOE2_1) phase_moe2<1>(p, smem);
    else if (PH == PH_COMBINE_1) phase_combine<1, DRY>(p);
}

template <int PH> __global__ void __launch_bounds__(NT, 2) k_phase(Params p) {
    SMEM_DECL;
    run_phase<PH>(p, smem);
}

constexpr int SMEM_BYTES = 160 * 1024;

#ifdef EMU
struct GridBar { int dummy; };
__device__ __forceinline__ void grid_sync(const GridBar&) { emu_grid_barrier(); }
#else
typedef XcdBarrier GridBar;
__device__ __forceinline__ void grid_sync(const GridBar& b) { xcd_barrier(b); }
#endif
#ifndef PROBE_MASK
#define PROBE_MASK 0u
#endif
#ifndef PROBE_DRY_MASK
#define PROBE_DRY_MASK 0u
#endif
#ifndef PROBE_BAR2
#define PROBE_BAR2 0
#endif
template <int PH> __device__ __forceinline__ void run_from(const Params& p, unsigned char* smem, const GridBar& bar) {
    if constexpr ((PROBE_DRY_MASK >> PH) & 1u) { run_phase<PH, true>(p, smem); grid_sync(bar); }
    run_phase<PH>(p, smem);
    if constexpr ((PROBE_MASK >> PH) & 1u) { grid_sync(bar); run_phase<PH>(p, smem); }
    if constexpr (PH + 1 < PH_COUNT) { grid_sync(bar); if (PROBE_BAR2) grid_sync(bar); run_from<PH + 1>(p, smem, bar); }
}
__global__ void __launch_bounds__(NT, 2) k_mega(Params p) {
    SMEM_DECL;
#ifdef EMU
    GridBar bar{0};
#else
    if (threadIdx.x == 0) *reinterpret_cast<U4*>(smem + SMEM_BYTES - 16) = U4{0u, 0u, 0u, 0u};
    __syncthreads();
    GridBar bar = xcd_barrier_post(reinterpret_cast<unsigned*>(p.ws + WS_BAR), (volatile LAS unsigned*)(smem + SMEM_BYTES - 16));
#endif
    run_from<0>(p, smem, bar);
}

static Params make_params(void* const* d_in, void* d_out, void* d_ws) {
    Params p{};
    const float** f = reinterpret_cast<const float**>(&p);
    for (int i = 0; i < 45; ++i) f[i] = (const float*)d_in[i];
    p.out = (float*)d_out; p.ws = (unsigned char*)d_ws;
    return p;
}

#ifdef EMU
int emu_last_phase = PH_COUNT;
#endif
template <int PH> static void launch_phases(const Params& p, int grid, hipStream_t stream) {
    if constexpr (PH < PH_COUNT) {
#ifdef EMU
        if (PH >= emu_last_phase) return;
#else
        (void)hipFuncSetAttribute((const void*)k_phase<PH>, hipFuncAttributeMaxDynamicSharedMemorySize, SMEM_BYTES);
#endif
        hipLaunchKernelGGL(k_phase<PH>, dim3(grid), dim3(NT), SMEM_BYTES, stream, p);
        launch_phases<PH + 1>(p, grid, stream);
    }
}

#ifndef MK_MULTI
#define MK_MULTI 0
#endif
extern "C" void kernel_launch(void* const* d_in, const int* in_sizes, int n_in, void* d_out, int out_size, void* d_ws, size_t ws_size,
                              hipStream_t stream) {
    Params p = make_params(d_in, d_out, d_ws);
#ifdef EMU
    int grid = getenv("EMU_GRID") ? atoi(getenv("EMU_GRID")) : 4;
    if (emu_last_phase < PH_COUNT) { launch_phases<0>(p, grid, stream); return; }
    hipLaunchKernelGGL(k_mega, dim3(grid), dim3(NT), SMEM_BYTES, stream, p);
#else
    static int grid = 0;
    if (!grid) {
        int dev = 0, cus = 0, per_cu = 0;
        (void)hipGetDevice(&dev);
        (void)hipDeviceGetAttribute(&cus, hipDeviceAttributeMultiprocessorCount, dev);
        (void)hipFuncSetAttribute((const void*)k_mega, hipFuncAttributeMaxDynamicSharedMemorySize, SMEM_BYTES);
        (void)hipOccupancyMaxActiveBlocksPerMultiprocessor(&per_cu, k_mega, NT, SMEM_BYTES);
        grid = (per_cu >= 1) ? cus : 0;
        if (grid > 256) grid = 256;
    }
    if (MK_MULTI || grid == 0) { launch_phases<0>(p, 256, stream); return; }
    (void)hipMemsetAsync((unsigned char*)d_ws + WS_BAR, 0, XCD_BAR_WORDS * sizeof(unsigned), stream);
    hipLaunchKernelGGL(k_mega, dim3(grid), dim3(NT), SMEM_BYTES, stream, p);
#endif
}
```
